# Optimizing an MI355X kernel written in HIP

```python
import math
import jax, jax.numpy as jnp
from jax import lax
import numpy as np

D_MODEL = 1024
BATCH = 8
SEQ = 4096
DEPTH = 2

D_HEAD = 64
GRID_W = 64
Q_BLOCK = 128
RMS_EPS = 1e-6
H_A = D_MODEL // (2 * D_HEAD)
WIN_R = 8
WIN_C = 16
H_B = D_MODEL // (2 * D_HEAD)
H_B_KV = H_B // 4
AXIAL_THETA = 10000.0
H_C = D_MODEL // (2 * D_HEAD)
Q_LORA = D_MODEL // 4
KV_LORA = D_MODEL // 8
C_NOPE = 64
C_ROPE = 32
C_V = 64
MLA_THETA = 10000.0
H_D = D_MODEL // (4 * D_HEAD)
D_V = 2 * D_HEAD
ROPE_THETA = 500000.0
ROT_DIM = D_HEAD // 4
GATE_E = (H_A + H_B) * D_HEAD
SPLIT_E = [H_A * D_HEAD, H_A * D_HEAD, H_A * D_HEAD,
           H_B * D_HEAD, H_B_KV * D_HEAD, H_B_KV * D_HEAD, GATE_E]
GATE_O = H_C * C_V + H_D * D_V
SPLIT_O = [Q_LORA, KV_LORA, C_ROPE, 2 * H_D * D_HEAD, 2 * H_D * D_HEAD,
           H_D * D_V, GATE_O]
IN_E = sum(SPLIT_E)
IN_O = sum(SPLIT_O)
N_EVEN = (DEPTH + 1) // 2
N_ODD = DEPTH // 2

kernel_name = "hybrid_natten_gqa_mla_diff_encoder"


def _split(x, sizes):
    idx = [int(v) for v in np.cumsum(sizes)[:-1]]
    return jnp.split(x, idx, axis=-1)


def rmsnorm(x, g):
    xf = x.astype(jnp.float32)
    y = xf * lax.rsqrt(jnp.mean(xf * xf, axis=-1, keepdims=True) + RMS_EPS)
    return (y * g.astype(jnp.float32)).astype(x.dtype)


def rope_angles(pos, dim, theta):
    inv = jnp.power(theta, -jnp.arange(0, dim, 2, dtype=jnp.float32) / dim)
    return pos[:, None] * inv[None, :]


def rotate(x, ang):
    shp = (ang.shape[0],) + (1,) * (x.ndim - 3) + (ang.shape[1],)
    c = jnp.cos(ang).reshape(shp).astype(x.dtype)
    s = jnp.sin(ang).reshape(shp).astype(x.dtype)
    x1, x2 = jnp.split(x, 2, axis=-1)
    return jnp.concatenate([x1 * c - x2 * s, x2 * c + x1 * s], axis=-1)


def attend_blocks(q, k, v, scale):
    B, S, Hq, dq = q.shape
    Hk, dv = k.shape[2], v.shape[3]
    G = Hq // Hk
    nb = S // Q_BLOCK
    qb = q.reshape(B, nb, Q_BLOCK, Hk, G, dq).transpose(1, 0, 2, 3, 4, 5)

    def one(qi):
        s = jnp.einsum('bqhgd,bkhd->bhgqk', qi, k).astype(jnp.float32) * scale
        p = jax.nn.softmax(s, axis=-1).astype(v.dtype)
        return jnp.einsum('bhgqk,bkhd->bqhgd', p, v)

    o = lax.map(one, qb)
    return o.transpose(1, 0, 2, 3, 4, 5).reshape(B, S, Hq, dv)


def diff_attend_blocks(q1, q2, k1, k2, v, lam, scale):
    B, S, H, d = q1.shape
    nb = S // Q_BLOCK
    q1b = q1.reshape(B, nb, Q_BLOCK, H, d).transpose(1, 0, 2, 3, 4)
    q2b = q2.reshape(B, nb, Q_BLOCK, H, d).transpose(1, 0, 2, 3, 4)

    def one(args):
        a, b = args
        s1 = jnp.einsum('bqhd,bkhd->bhqk', a, k1).astype(jnp.float32) * scale
        s2 = jnp.einsum('bqhd,bkhd->bhqk', b, k2).astype(jnp.float32) * scale
        p = jax.nn.softmax(s1, axis=-1) - lam * jax.nn.softmax(s2, axis=-1)
        return jnp.einsum('bhqk,bkhd->bqhd', p.astype(v.dtype), v)

    o = lax.map(one, (q1b, q2b))
    return o.transpose(1, 0, 2, 3, 4).reshape(B, S, H, v.shape[-1])


def neighbourhood_attention(q, k, v, rpb):
    B, S, H, d = q.shape
    rows = S // GRID_W
    wr = min(WIN_R, rows)
    wc = WIN_C
    qg = q.reshape(B, rows, GRID_W, H, d)
    kg = k.reshape(B, rows, GRID_W, H, d)
    vg = v.reshape(B, rows, GRID_W, H, d)
    col = jnp.arange(GRID_W)
    c0 = jnp.clip(col - wc // 2, 0, GRID_W - wc)
    cidx = c0[:, None] + jnp.arange(wc)[None, :]
    cb = (cidx - col[:, None] + (WIN_C - 1))[:, None, :]
    scale = d ** -0.5

    def one(r):
        r0 = jnp.clip(r - wr // 2, 0, rows - wr)
        kr = lax.dynamic_slice_in_dim(kg, r0, wr, axis=1)
        vr = lax.dynamic_slice_in_dim(vg, r0, wr, axis=1)
        kw = kr[:, :, cidx]
        vw = vr[:, :, cidx]
        qr = lax.dynamic_index_in_dim(qg, r, axis=1, keepdims=False)
        s = jnp.einsum('bqhd,biqjhd->bhqij', qr, kw).astype(jnp.float32) * scale
        rb = (r0 + jnp.arange(wr) - r + (WIN_R - 1))[None, :, None]
        bias = rpb[:, rb, cb].astype(jnp.float32)
        s = (s + bias[None]).reshape(B, H, GRID_W, wr * wc)
        p = jax.nn.softmax(s, axis=-1).reshape(B, H, GRID_W, wr, wc).astype(v.dtype)
        return jnp.einsum('bhqij,biqjhd->bqhd', p, vw)

    o = lax.map(one, jnp.arange(rows))
    return o.transpose(1, 0, 2, 3, 4).reshape(B, S, H, d)


def even_layer(x, norm, w_in, gq_a, gk_a, rpb, gq_b, gk_b, w_out, ang_row, ang_col):
    B, S, _ = x.shape
    h = rmsnorm(x, norm)
    qa, ka, va, qb, kb, vb, gate = _split(h @ w_in, SPLIT_E)
    qa = rmsnorm(qa.reshape(B, S, H_A, D_HEAD), gq_a)
    ka = rmsnorm(ka.reshape(B, S, H_A, D_HEAD), gk_a)
    va = va.reshape(B, S, H_A, D_HEAD)
    oa = neighbourhood_attention(qa, ka, va, rpb)
    half = D_HEAD // 2
    qb = rmsnorm(qb.reshape(B, S, H_B, D_HEAD), gq_b)
    kb = rmsnorm(kb.reshape(B, S, H_B_KV, D_HEAD), gk_b)
    qb = jnp.concatenate([rotate(qb[..., :half], ang_row), rotate(qb[..., half:], ang_col)], -1)
    kb = jnp.concatenate([rotate(kb[..., :half], ang_row), rotate(kb[..., half:], ang_col)], -1)
    vb = vb.reshape(B, S, H_B_KV, D_HEAD)
    ob = attend_blocks(qb, kb, vb, D_HEAD ** -0.5)
    o = jnp.concatenate([oa.reshape(B, S, -1), ob.reshape(B, S, -1)], -1) * jax.nn.silu(gate)
    return o @ w_out


def odd_layer(x, norm, w_in, g_cq, w_cq_b, g_ckv, w_ckv_b, gq_c, gk_c, gq_d, gk_d,
              lam_q1, lam_k1, lam_q2, lam_k2, g_sub_d, w_out, ang_mla, ang_part, lam_init):
    B, S, _ = x.shape
    h = rmsnorm(x, norm)
    cq, ckv, kpe, qd, kd, vd, gate = _split(h @ w_in, SPLIT_O)
    q = (rmsnorm(cq, g_cq) @ w_cq_b).reshape(B, S, H_C, C_NOPE + C_ROPE)
    kv = (rmsnorm(ckv, g_ckv) @ w_ckv_b).reshape(B, S, H_C, C_NOPE + C_V)
    k_nope, v_c = kv[..., :C_NOPE], kv[..., C_NOPE:]
    k_pe = jnp.broadcast_to(kpe[:, :, None, :], (B, S, H_C, C_ROPE))
    qc = rmsnorm(q, gq_c)
    kc = rmsnorm(jnp.concatenate([k_nope, k_pe], -1), gk_c)
    qc = jnp.concatenate([qc[..., :C_NOPE], rotate(qc[..., C_NOPE:], ang_mla)], -1)
    kc = jnp.concatenate([kc[..., :C_NOPE], rotate(kc[..., C_NOPE:], ang_mla)], -1)
    oc = attend_blocks(qc, kc, v_c, (C_NOPE + C_ROPE) ** -0.5)
    qd = rmsnorm(qd.reshape(B, S, H_D, 2, D_HEAD), gq_d)
    kd = rmsnorm(kd.reshape(B, S, H_D, 2, D_HEAD), gk_d)
    qd = jnp.concatenate([rotate(qd[..., :ROT_DIM], ang_part), qd[..., ROT_DIM:]], -1)
    kd = jnp.concatenate([rotate(kd[..., :ROT_DIM], ang_part), kd[..., ROT_DIM:]], -1)
    vd = vd.reshape(B, S, H_D, D_V)
    f32 = jnp.float32
    lam = (jnp.exp(jnp.sum(lam_q1.astype(f32) * lam_k1.astype(f32)))
           - jnp.exp(jnp.sum(lam_q2.astype(f32) * lam_k2.astype(f32))) + lam_init)
    od = diff_attend_blocks(qd[:, :, :, 0], qd[:, :, :, 1], kd[:, :, :, 0], kd[:, :, :, 1],
                            vd, lam, D_HEAD ** -0.5)
    od = rmsnorm(od, g_sub_d) * (1.0 - lam_init)
    o = jnp.concatenate([oc.reshape(B, S, -1), od.reshape(B, S, -1)], -1) * jax.nn.silu(gate)
    return o @ w_out


def setup_inputs(seed: int = 0) -> dict:
    key = jax.random.key(seed)
    ks = iter(jax.random.split(key, 32))
    f32 = jnp.float32

    def w(shape, fan_in):
        return jax.random.normal(next(ks), shape, f32) * (fan_in ** -0.5)

    def gain(shape):
        return 1.0 + 0.1 * jax.random.normal(next(ks), shape, f32)

    def small(shape, s):
        return s * jax.random.normal(next(ks), shape, f32)

    NE, NO = N_EVEN, N_ODD
    return {
        "x": jax.random.normal(next(ks), (BATCH, SEQ, D_MODEL), f32),
        "norm_e": gain((NE, D_MODEL)),
        "w_in_e": w((NE, D_MODEL, IN_E), D_MODEL),
        "gq_a": gain((NE, D_HEAD)),
        "gk_a": gain((NE, D_HEAD)),
        "rpb_a": small((NE, H_A, 2 * WIN_R - 1, 2 * WIN_C - 1), 0.2),
        "gq_b": gain((NE, D_HEAD)),
        "gk_b": gain((NE, D_HEAD)),
        "w_out_e": w((NE, GATE_E, D_MODEL), GATE_E),
        "norm_o": gain((NO, D_MODEL)),
        "w_in_o": w((NO, D_MODEL, IN_O), D_MODEL),
        "g_cq": gain((NO, Q_LORA)),
        "w_cq_b": w((NO, Q_LORA, H_C * (C_NOPE + C_ROPE)), Q_LORA),
        "g_ckv": gain((NO, KV_LORA)),
        "w_ckv_b": w((NO, KV_LORA, H_C * (C_NOPE + C_V)), KV_LORA),
        "gq_c": gain((NO, C_NOPE + C_ROPE)),
        "gk_c": gain((NO, C_NOPE + C_ROPE)),
        "gq_d": gain((NO, D_HEAD)),
        "gk_d": gain((NO, D_HEAD)),
        "lam_q1": small((NO, D_HEAD), 0.1),
        "lam_k1": small((NO, D_HEAD), 0.1),
        "lam_q2": small((NO, D_HEAD), 0.1),
        "lam_k2": small((NO, D_HEAD), 0.1),
        "g_sub_d": gain((NO, D_V)),
        "w_out_o": w((NO, GATE_O, D_MODEL), GATE_O),
    }


def reference(x, norm_e, w_in_e, gq_a, gk_a, rpb_a, gq_b, gk_b, w_out_e,
              norm_o, w_in_o, g_cq, w_cq_b, g_ckv, w_ckv_b, gq_c, gk_c, gq_d, gk_d,
              lam_q1, lam_k1, lam_q2, lam_k2, g_sub_d, w_out_o):
    S = x.shape[1]
    t = jnp.arange(S)
    pos = t.astype(jnp.float32)
    row = (t // GRID_W).astype(jnp.float32)
    col = (t % GRID_W).astype(jnp.float32)
    half = D_HEAD // 2
    ang_row = rope_angles(row, half, AXIAL_THETA)
    ang_col = rope_angles(col, half, AXIAL_THETA)
    ang_mla = rope_angles(pos, C_ROPE, MLA_THETA)
    ang_part = rope_angles(pos, ROT_DIM, ROPE_THETA)
    for l in range(DEPTH):
        i = l // 2
        if l % 2 == 0:
            x = x + even_layer(x, norm_e[i], w_in_e[i], gq_a[i], gk_a[i], rpb_a[i],
                               gq_b[i], gk_b[i], w_out_e[i], ang_row, ang_col)
        else:
            lam_init = 0.8 - 0.6 * math.exp(-0.3 * l)
            x = x + odd_layer(x, norm_o[i], w_in_o[i], g_cq[i], w_cq_b[i], g_ckv[i],
                              w_ckv_b[i], gq_c[i], gk_c[i], gq_d[i], gk_d[i],
                              lam_q1[i], lam_k1[i], lam_q2[i], lam_k2[i], g_sub_d[i],
                              w_out_o[i], ang_mla, ang_part, lam_init)
    return x
```

```cpp
#include <hip/hip_runtime.h>
#include <hip/hip_cooperative_groups.h>
#include <cstdio>
#include <cstdint>
#include <cmath>
#include <cstring>
namespace cg = cooperative_groups;

typedef unsigned short u16;
using bf16x8 = __attribute__((ext_vector_type(8))) short;
using s16x4  = __attribute__((ext_vector_type(4))) short;
using f32x16 = __attribute__((ext_vector_type(16))) float;
using f32x4  = __attribute__((ext_vector_type(4))) float;
using u32x4  = __attribute__((ext_vector_type(4))) unsigned;
using u32x2  = __attribute__((ext_vector_type(2))) unsigned;

#define DI __device__ __forceinline__
#define MFMA32(a, b, c) __builtin_amdgcn_mfma_f32_32x32x16_bf16((a), (b), (c), 0, 0, 0)
#define SBAR() __builtin_amdgcn_sched_barrier(0)

constexpr int NTOK = 32768, SEQ = 4096, DM = 1024, NE = 3328, NO = 3072;
constexpr int NTHR = 512, NWAVE = 8;
constexpr int LDX = 1088;
constexpr float EPS = 1e-6f, LOG2E = 1.4426950408889634f;
constexpr float LAM_INIT = 0.35550906759096930f;

struct Params {
  const float *x, *norm_e, *w_in_e, *gq_a, *gk_a, *rpb_a, *gq_b, *gk_b, *w_out_e,
      *norm_o, *w_in_o, *g_cq, *w_cq_b, *g_ckv, *w_ckv_b, *gq_c, *gk_c, *gq_d, *gk_d,
      *lam_q1, *lam_k1, *lam_q2, *lam_k2, *g_sub_d, *w_out_o;
  float* out;
  u16 *xb, *proj, *ob, *qc, *kc, *vc, *wt_ine, *wt_oute, *wt_ino, *wt_cq, *wt_ckv, *wt_outo;
  float *rs0, *ss1, *sscq, *ssckv, *lam;
  unsigned* bar;
  float2 *tab_ax, *tab_mla, *tab_part;
  float inv16[16];
  float inv8[8];
  int phase_lo, phase_hi;
};

DI int my_tid() { int t = threadIdx.x; asm volatile("" : "+v"(t)); return t; }
DI int crow(int r, int hi) { return (r & 3) + 8 * (r >> 2) + 4 * hi; }
DI unsigned cvtpk(float lo, float hi) { unsigned r; asm volatile("v_cvt_pk_bf16_f32 %0, %1, %2" : "=v"(r) : "v"(lo), "v"(hi)); return r; }
DI float bflo(unsigned w) { return __uint_as_float(w << 16); }
DI float bfhi(unsigned w) { return __uint_as_float(w & 0xffff0000u); }
DI float half_sum(float v) {
  auto rr = __builtin_amdgcn_permlane32_swap(__float_as_uint(v), __float_as_uint(v), false, false);
  return __uint_as_float(rr[0]) + __uint_as_float(rr[1]);
}
DI float half_max(float v) {
  auto rr = __builtin_amdgcn_permlane32_swap(__float_as_uint(v), __float_as_uint(v), false, false);
  return fmaxf(__uint_as_float(rr[0]), __uint_as_float(rr[1]));
}
DI float wave_sum(float v) {
  v += __shfl_xor(v, 32); v += __shfl_xor(v, 16); v += __shfl_xor(v, 8); v += __shfl_xor(v, 4); v += __shfl_xor(v, 2); v += __shfl_xor(v, 1);
  return v;
}
DI void store_blk_bf16(u16* rowp, const f32x16& v, int hi) {
#pragma unroll
  for (int q = 0; q < 4; ++q) { u32x2 w; w.x = cvtpk(v[4 * q], v[4 * q + 1]); w.y = cvtpk(v[4 * q + 2], v[4 * q + 3]); *(u32x2*)(rowp + 8 * q + 4 * hi) = w; }
}
DI void load_blk_f32(const float* g, int hi, f32x16& o) {
#pragma unroll
  for (int q = 0; q < 4; ++q) { f32x4 t = *(const f32x4*)(g + 8 * q + 4 * hi); o[4 * q] = t[0]; o[4 * q + 1] = t[1]; o[4 * q + 2] = t[2]; o[4 * q + 3] = t[3]; }
}
DI void load_blk_bf16(const u16* g, int hi, f32x16& o) {
#pragma unroll
  for (int q = 0; q < 4; ++q) { u32x2 w = *(const u32x2*)(g + 8 * q + 4 * hi); o[4 * q] = bflo(w.x); o[4 * q + 1] = bfhi(w.x); o[4 * q + 2] = bflo(w.y); o[4 * q + 3] = bfhi(w.y); }
}
DI float sumsq16(const f32x16& v) { float s = 0;
#pragma unroll
  for (int r = 0; r < 16; ++r) s = fmaf(v[r], v[r], s); return s; }
DI void rot16(f32x16& v, const float2* tab, int hi) {
#pragma unroll
  for (int r = 0; r < 8; ++r) { const float2 cs = tab[crow(r, hi)]; const float a = v[r], b = v[r + 8]; v[r] = a * cs.x - b * cs.y; v[r + 8] = b * cs.x + a * cs.y; }
}
DI void rot8(f32x16& v, const float2* tab, int hi) {
#pragma unroll
  for (int r = 0; r < 4; ++r) { const float2 cs = tab[r + 4 * hi]; const float a = v[r], b = v[r + 4]; v[r] = a * cs.x - b * cs.y; v[r + 4] = b * cs.x + a * cs.y; }
}
DI float silu(float v) { return v / (1.f + __expf(-v)); }

DI void sincos_rev(double f, float& c, float& s) {
  const double q = floor(4.0 * f + 0.5), y = f - 0.25 * q, th = 6.283185307179586 * y, t2 = th * th;
  const double sn = th * (1.0 + t2 * (-1.0 / 6 + t2 * (1.0 / 120 + t2 * (-1.0 / 5040 + t2 * (1.0 / 362880 + t2 * (-1.0 / 39916800 + t2 * (1.0 / 6227020800.0)))))));
  const double cs = 1.0 + t2 * (-0.5 + t2 * (1.0 / 24 + t2 * (-1.0 / 720 + t2 * (1.0 / 40320 + t2 * (-1.0 / 3628800 + t2 * (1.0 / 479001600.0 + t2 * (-1.0 / 87178291200.0)))))));
  const int qi = ((int)q) & 3;
  const double cc = qi == 0 ? cs : qi == 1 ? -sn : qi == 2 ? -cs : sn;
  const double ss = qi == 0 ? sn : qi == 1 ? cs : qi == 2 ? -sn : -cs;
  c = (float)cc; s = (float)ss;
}
DI float2 angle_cs(float pos, float inv) {
  const float ang = __fmul_rn(pos, inv);
  double rev = (double)ang * 0.15915494309189535; rev -= floor(rev);
  float2 r; sincos_rev(rev, r.x, r.y); return r;
}
template <int MODE>
DI void wtrans(const float* __restrict__ W, int K, int N, int Npad, const float* __restrict__ gain, u16* __restrict__ Wt, int ldw, int gt, int gn) {
  const int total = (K / 8) * Npad;
  for (int idx = gt; idx < total; idx += gn) {
    const int n = idx % Npad, kc = idx / Npad;
    int src = n;
    if (MODE == 1) src = n < 384 ? n : (n < 2944 ? n + 32 : (n < 2976 ? n - 2944 + 384 : -1));
    u32x4 w;
#pragma unroll
    for (int j = 0; j < 4; ++j) {
      const int k = kc * 8 + 2 * j; float a = 0.f, b = 0.f;
      if (src >= 0) { a = W[(size_t)k * N + src]; b = W[(size_t)(k + 1) * N + src]; if (gain) { a *= gain[k]; b *= gain[k + 1]; } }
      w[j] = cvtpk(a, b);
    }
    *(u32x4*)(Wt + (size_t)n * ldw + kc * 8) = w;
  }
}
DI void phase0(const Params& p) {
  const int tid = my_tid(), gt = blockIdx.x * NTHR + tid, gn = gridDim.x * NTHR, wave = tid >> 6, lane = tid & 63;
  for (int i = gt; i < NTOK; i += gn) { p.ss1[i] = 0.f; p.sscq[i] = 0.f; p.ssckv[i] = 0.f; }
  for (int row = blockIdx.x * NWAVE + wave; row < NTOK; row += gridDim.x * NWAVE) {
    const float* xr = p.x + (size_t)row * DM; f32x4 v[4]; float ss = 0.f;
#pragma unroll
    for (int i = 0; i < 4; ++i) { v[i] = *(const f32x4*)(xr + i * 256 + lane * 4); ss += v[i][0] * v[i][0] + v[i][1] * v[i][1] + v[i][2] * v[i][2] + v[i][3] * v[i][3]; }
    ss = wave_sum(ss);
    if (lane == 0) p.rs0[row] = rsqrtf(ss * (1.f / DM) + EPS);
#pragma unroll
    for (int i = 0; i < 4; ++i) { u32x2 w; w.x = cvtpk(v[i][0], v[i][1]); w.y = cvtpk(v[i][2], v[i][3]); *(u32x2*)(p.xb + (size_t)row * LDX + i * 256 + lane * 4) = w; }
  }
  wtrans<0>(p.w_in_e, 1024, NE, NE, p.norm_e, p.wt_ine, LDX, gt, gn);
  wtrans<0>(p.w_out_e, 1024, 1024, 1024, nullptr, p.wt_oute, LDX, gt, gn);
  wtrans<1>(p.w_in_o, 1024, 2976, NO, p.norm_o, p.wt_ino, LDX, gt, gn);
  wtrans<0>(p.w_cq_b, 256, 768, 768, p.g_cq, p.wt_cq, 256, gt, gn);
  wtrans<0>(p.w_ckv_b, 128, 1024, 1024, p.g_ckv, p.wt_ckv, 128, gt, gn);
  wtrans<0>(p.w_out_o, 1024, 1024, 1024, nullptr, p.wt_outo, LDX, gt, gn);
  for (int idx = gt; idx < 4096 * 16; idx += gn) p.tab_mla[idx] = angle_cs((float)(idx >> 4), p.inv16[idx & 15]);
  for (int idx = gt; idx < 4096 * 8; idx += gn) p.tab_part[idx] = angle_cs((float)(idx >> 3), p.inv8[idx & 7]);
  for (int idx = gt; idx < 64 * 16; idx += gn) p.tab_ax[idx] = angle_cs((float)(idx >> 4), p.inv16[idx & 15]);
  if (blockIdx.x == 0 && wave == 0) {
    float a = wave_sum(p.lam_q1[lane] * p.lam_k1[lane]), b = wave_sum(p.lam_q2[lane] * p.lam_k2[lane]);
    if (lane == 0) p.lam[0] = expf(a) - expf(b) + LAM_INIT;
    if (lane == 0) __hip_atomic_store(p.bar, 0u, __ATOMIC_RELAXED, __HIP_MEMORY_SCOPE_AGENT);
    float gq = fabsf(p.gq_b[lane]), gk = fabsf(p.gk_b[lane]);
    float gcq = fmaxf(fabsf(p.gq_c[lane]), lane < 32 ? fabsf(p.gq_c[64 + lane]) : 0.f), gck = fmaxf(fabsf(p.gk_c[lane]), lane < 32 ? fabsf(p.gk_c[64 + lane]) : 0.f);
    float gdq = fabsf(p.gq_d[lane]), gdk = fabsf(p.gk_d[lane]);
#pragma unroll
    for (int s = 32; s >= 1; s >>= 1) { gq = fmaxf(gq, __shfl_xor(gq, s)); gk = fmaxf(gk, __shfl_xor(gk, s)); gcq = fmaxf(gcq, __shfl_xor(gcq, s)); gck = fmaxf(gck, __shfl_xor(gck, s));
      gdq = fmaxf(gdq, __shfl_xor(gdq, s)); gdk = fmaxf(gdk, __shfl_xor(gdk, s)); }
    if (lane == 0) { p.lam[1] = 8.f * gq * gk; p.lam[2] = 9.797958971132712f * gcq * gck; p.lam[3] = 8.f * gdq * gdk; }
  }
}

#define LAS3 __attribute__((address_space(3)))
DI void dma16(const void* g, char* lds_uniform) {
  __builtin_amdgcn_global_load_lds((const unsigned*)g, (LAS3 unsigned*)(LAS3 char*)lds_uniform, 16, 0, 0);
}
template <int WM, int WN, int MI, int NI>
DI void gemm_mainloop(const u16* __restrict__ A, const int lda, const u16* __restrict__ Bt, const int ldb, const int K, char* lds, f32x16 (&acc)[MI][NI]) {
  constexpr int BM = WM * MI * 32, BN = WN * NI * 32, BNS = (BN + 63) / 64 * 64, ACH = BM / 64, BCH = BNS / 64, ABYTES = BM * 128, BUF = (BM + BNS) * 128;
  const int tid = my_tid(), wave = __builtin_amdgcn_readfirstlane(tid >> 6), lane = tid & 63, r32 = lane & 31, hi = lane >> 5;
  const int wr = wave / WN, wc = wave % WN;
  const int srow = wave * 8 + (lane >> 3), spos = lane & 7, schunk = spos ^ ((srow >> 1) & 7);
  const u16* ag = A + (size_t)srow * lda + schunk * 8;
  const u16* bg = Bt + (size_t)srow * ldb + schunk * 8;
  const int sw = (r32 >> 1) & 7;
  const int abase = (wr * MI * 32 + r32) * 128, bbase = ABYTES + (wc * NI * 32 + r32) * 128;
#pragma unroll
  for (int mi = 0; mi < MI; ++mi)
#pragma unroll
    for (int ni = 0; ni < NI; ++ni)
#pragma unroll
      for (int r = 0; r < 16; ++r) acc[mi][ni][r] = 0.f;
#define G_DMA(BUFP, KT) do { _Pragma("unroll") for (int i = 0; i < ACH; ++i) dma16(ag + (size_t)i * 64 * lda + (KT) * 64, (BUFP) + i * 8192 + wave * 1024); \
    _Pragma("unroll") for (int i = 0; i < BCH; ++i) dma16(bg + (size_t)i * 64 * ldb + (KT) * 64, (BUFP) + ABYTES + i * 8192 + wave * 1024); } while (0)
#define G_COMPUTE(CUR) do { _Pragma("unroll") for (int kk = 0; kk < 4; ++kk) { const int xk = ((kk * 2 + hi) ^ sw) << 4; bf16x8 af[MI], bfr[NI]; \
    _Pragma("unroll") for (int mi = 0; mi < MI; ++mi) af[mi] = *(const bf16x8*)((CUR) + abase + mi * 4096 + xk); \
    _Pragma("unroll") for (int ni = 0; ni < NI; ++ni) bfr[ni] = *(const bf16x8*)((CUR) + bbase + ni * 4096 + xk); \
    _Pragma("unroll") for (int mi = 0; mi < MI; ++mi) _Pragma("unroll") for (int ni = 0; ni < NI; ++ni) acc[mi][ni] = MFMA32(bfr[ni], af[mi], acc[mi][ni]); } } while (0)
  const int nk = K >> 6;
  G_DMA(lds, 0);
  for (int kt = 0; kt < nk; ++kt) {
    asm volatile("s_waitcnt vmcnt(0)" ::: "memory");
    __syncthreads();
    char* cur = lds + (kt & 1) * BUF;
    if (kt + 1 < nk) G_DMA(lds + ((kt + 1) & 1) * BUF, kt + 1);
    G_COMPUTE(cur);
  }
  __syncthreads();
#undef G_DMA
#undef G_COMPUTE
}

template <int WM, int WN, int MI, int NI>
DI void gemm_mainloop3(const u16* __restrict__ A, const int lda, const u16* __restrict__ Bt, const int ldb, const int K, char* lds, f32x16 (&acc)[MI][NI]) {
  constexpr int BM = WM * MI * 32, BN = WN * NI * 32, BNS = (BN + 63) / 64 * 64, ACH = BM / 64, BCH = BNS / 64, NDMA = ACH + BCH, ABYTES = BM * 128, BUF = (BM + BNS) * 128;
  const int tid = my_tid(), wave = __builtin_amdgcn_readfirstlane(tid >> 6), lane = tid & 63, r32 = lane & 31, hi = lane >> 5;
  const int wr = wave / WN, wc = wave % WN;
  const int srow = wave * 8 + (lane >> 3), spos = lane & 7, schunk = spos ^ ((srow >> 1) & 7);
  const u16* ag = A + (size_t)srow * lda + schunk * 8;
  const u16* bg = Bt + (size_t)srow * ldb + schunk * 8;
  const int sw = (r32 >> 1) & 7;
  const int abase = (wr * MI * 32 + r32) * 128, bbase = ABYTES + (wc * NI * 32 + r32) * 128;
#pragma unroll
  for (int mi = 0; mi < MI; ++mi)
#pragma unroll
    for (int ni = 0; ni < NI; ++ni)
#pragma unroll
      for (int r = 0; r < 16; ++r) acc[mi][ni][r] = 0.f;
#define G3_DMA(BUFP, KT) do { _Pragma("unroll") for (int i = 0; i < ACH; ++i) dma16(ag + (size_t)i * 64 * lda + (KT) * 64, (BUFP) + i * 8192 + wave * 1024); \
    _Pragma("unroll") for (int i = 0; i < BCH; ++i) dma16(bg + (size_t)i * 64 * ldb + (KT) * 64, (BUFP) + ABYTES + i * 8192 + wave * 1024); } while (0)
#define G3_COMPUTE(CUR) do { _Pragma("unroll") for (int kk = 0; kk < 4; ++kk) { const int xk = ((kk * 2 + hi) ^ sw) << 4; bf16x8 af[MI], bfr[NI]; \
    _Pragma("unroll") for (int mi = 0; mi < MI; ++mi) af[mi] = *(const bf16x8*)((CUR) + abase + mi * 4096 + xk); \
    _Pragma("unroll") for (int ni = 0; ni < NI; ++ni) bfr[ni] = *(const bf16x8*)((CUR) + bbase + ni * 4096 + xk); \
    _Pragma("unroll") for (int mi = 0; mi < MI; ++mi) _Pragma("unroll") for (int ni = 0; ni < NI; ++ni) acc[mi][ni] = MFMA32(bfr[ni], af[mi], acc[mi][ni]); } } while (0)
  const int nk = K >> 6;
  int s0 = 0, s1 = BUF, s2 = 2 * BUF;
  G3_DMA(lds, 0); G3_DMA(lds + BUF, 1);
  for (int kt = 0; kt < nk; ++kt) {
    if (kt + 1 < nk) asm volatile("s_waitcnt vmcnt(%0)" :: "n"(NDMA) : "memory"); else asm volatile("s_waitcnt vmcnt(0)" ::: "memory");
    __builtin_amdgcn_s_barrier();
    asm volatile("" ::: "memory");
    if (kt + 2 < nk) G3_DMA(lds + s2, kt + 2);
    G3_COMPUTE(lds + s0);
    { const int t_ = s0; s0 = s1; s1 = s2; s2 = t_; }
  }
  __syncthreads();
#undef G3_DMA
#undef G3_COMPUTE
}

DI void tile_of(int t, int NT, int& mt, int& nt) {
  const int xcd = t & 7, idx = t >> 3, g = idx / (8 * NT), rem = idx % (8 * NT);
  mt = xcd * 16 + g * 8 + (rem & 7); nt = rem >> 3;
}

DI void epi_in_e(const Params& p, f32x16& a00, f32x16& a01, f32x16& a10, f32x16& a11, int mrow0, int cb, int r32, int hi) {
  int type; const float* g = nullptr;
  if (cb < 512) { type = 1; g = p.gq_a; } else if (cb < 1024) { type = 1; g = p.gk_a; } else if (cb < 1536) type = 0;
  else if (cb < 2048) { type = 2; g = p.gq_b; } else if (cb < 2176) { type = 2; g = p.gk_b; } else if (cb < 2304) type = 0; else type = 3;
#pragma unroll
  for (int mi = 0; mi < 2; ++mi) {
    f32x16& r0 = mi ? a10 : a00; f32x16& r1 = mi ? a11 : a01;
    const int T = mrow0 + mi * 32 + r32; const float rs = p.rs0[T];
    f32x16 v0 = r0 * rs, v1 = r1 * rs;
    if (type == 1 || type == 2) {
      const float ss = half_sum(sumsq16(v0) + sumsq16(v1)); const float ri = rsqrtf(ss * (1.f / 64) + EPS);
      { f32x16 gg; load_blk_f32(g, hi, gg); v0 = v0 * ri * gg; load_blk_f32(g + 32, hi, gg); v1 = v1 * ri * gg; }
      if (type == 2) { const int t = T & 4095; rot16(v0, p.tab_ax + (t >> 6) * 16, hi); rot16(v1, p.tab_ax + (t & 63) * 16, hi); }
      if (cb >= 1536 && cb < 2048) { v0 = v0 * (0.125f * LOG2E); v1 = v1 * (0.125f * LOG2E); }
    } else if (type == 3) {
#pragma unroll
      for (int r = 0; r < 16; ++r) { v0[r] = silu(v0[r]); v1[r] = silu(v1[r]); }
    }
    r0 = v0; r1 = v1;
  }
}
DI void epi_in_o(const Params& p, f32x16& a00, f32x16& a01, f32x16& a10, f32x16& a11, int mrow0, int cb, int r32, int hi) {
  int type; const float* g = nullptr;
  if (cb < 256) type = 4; else if (cb < 384) type = 5; else if (cb < 896) { type = 2; g = p.gq_d; } else if (cb < 1408) { type = 2; g = p.gk_d; }
  else if (cb < 1920) type = 0; else if (cb < 2944) type = 3; else type = 0;
#pragma unroll
  for (int mi = 0; mi < 2; ++mi) {
    f32x16& r0 = mi ? a10 : a00; f32x16& r1 = mi ? a11 : a01;
    const int T = mrow0 + mi * 32 + r32; const float rs = rsqrtf(p.ss1[T] * (1.f / DM) + EPS);
    f32x16 v0 = r0 * rs, v1 = r1 * rs;
    if (type == 2) {
      const float ss = half_sum(sumsq16(v0) + sumsq16(v1)); const float ri = rsqrtf(ss * (1.f / 64) + EPS);
      { f32x16 gg; load_blk_f32(g, hi, gg); v0 = v0 * ri * gg; load_blk_f32(g + 32, hi, gg); v1 = v1 * ri * gg; }
      rot8(v0, p.tab_part + (T & 4095) * 8, hi);
      if (cb < 896) { v0 = v0 * (0.125f * LOG2E); v1 = v1 * (0.125f * LOG2E); }
    } else if (type == 3) {
#pragma unroll
      for (int r = 0; r < 16; ++r) { v0[r] = silu(v0[r]); v1[r] = silu(v1[r]); }
    } else if (type >= 4) {
      const float ss = half_sum(sumsq16(v0) + sumsq16(v1));
      if (hi == 0) atomicAdd((type == 4 ? p.sscq : p.ssckv) + T, ss);
    }
    r0 = v0; r1 = v1;
  }
}
DI void stage_out_bf16(f32x16 (&acc)[2][4], u16* dst, int ld, char* lds) {
  const int tid = my_tid(), wave = tid >> 6, lane = tid & 63, r32 = lane & 31, hi = lane >> 5, wr = wave >> 1, wc = wave & 1;
#pragma unroll
  for (int half = 0; half < 2; ++half) {
    if ((wr >> 1) == half) {
#pragma unroll
      for (int mi = 0; mi < 2; ++mi) {
        u16* rowp = (u16*)(lds + ((wr & 1) * 64 + mi * 32 + r32) * 520) + wc * 128;
#pragma unroll
        for (int ni = 0; ni < 4; ++ni) store_blk_bf16(rowp + 32 * ni, acc[mi][ni], hi);
      }
    }
    __syncthreads();
#pragma unroll
    for (int i = 0; i < 8; ++i) {
      const int c = tid + i * NTHR, row = c >> 5, ch = c & 31;
      const u32x2 a = *(const u32x2*)(lds + row * 520 + ch * 16), b = *(const u32x2*)(lds + row * 520 + ch * 16 + 8);
      u32x4 w; w.x = a.x; w.y = a.y; w.z = b.x; w.w = b.y;
      *(u32x4*)(dst + (size_t)(half * 128 + row) * ld + ch * 8) = w;
    }
    __syncthreads();
  }
}
template <bool FIRST>
DI void epi_out(const Params& p, f32x16 (&acc)[2][4], int m0, int n0, char* lds) {
  const float* res = FIRST ? p.x : p.out;
  const int tid = my_tid(), wave = tid >> 6, lane = tid & 63, r32 = lane & 31, hi = lane >> 5, wr = wave >> 1, wc = wave & 1;
#pragma unroll
  for (int mi = 0; mi < 2; ++mi)
#pragma unroll
    for (int half = 0; half < 2; ++half) {
      if ((wr >> 1) == half) {
        float* rowp = (float*)(lds + ((wr & 1) * 32 + r32) * 1040) + wc * 128;
#pragma unroll
        for (int ni = 0; ni < 4; ++ni)
#pragma unroll
          for (int q = 0; q < 4; ++q) { f32x4 v; v[0] = acc[mi][ni][4 * q]; v[1] = acc[mi][ni][4 * q + 1]; v[2] = acc[mi][ni][4 * q + 2]; v[3] = acc[mi][ni][4 * q + 3]; *(f32x4*)(rowp + 32 * ni + 8 * q + 4 * hi) = v; }
      }
      __syncthreads();
#pragma unroll
      for (int i = 0; i < 8; ++i) {
        const int c = tid + i * NTHR, row = c >> 6, ch = c & 63;
        const int T = m0 + half * 128 + (row >> 5) * 64 + mi * 32 + (row & 31);
        const size_t off = (size_t)T * DM + n0 + ch * 4;
        const f32x4 a = *(const f32x4*)(lds + row * 1040 + ch * 16), rv = *(const f32x4*)(res + off);
        f32x4 ov = a + rv;
        *(f32x4*)(p.out + off) = ov;
        if (FIRST) {
          float ss = ov[0] * ov[0] + ov[1] * ov[1] + ov[2] * ov[2] + ov[3] * ov[3];
          u32x2 w; w.x = cvtpk(ov[0], ov[1]); w.y = cvtpk(ov[2], ov[3]); *(u32x2*)(p.xb + (size_t)T * LDX + n0 + ch * 4) = w;
          ss = wave_sum(ss);
          if (ch == 0) atomicAdd(p.ss1 + T, ss);
        }
      }
      __syncthreads();
    }
}
template <int WHICH>
DI void gemm_phase(const Params& p, char* lds) {
  constexpr int NT = WHICH == 0 ? NE / 256 : WHICH == 2 ? NO / 256 : 4;
  const u16* A = (WHICH == 0 || WHICH == 2) ? p.xb : p.ob;
  const u16* Bt = WHICH == 0 ? p.wt_ine : WHICH == 1 ? p.wt_oute : WHICH == 2 ? p.wt_ino : p.wt_outo;
  const int wave = my_tid() >> 6, lane = my_tid() & 63, r32 = lane & 31, hi = lane >> 5, wr = wave >> 1, wc = wave & 1;
  for (int t = blockIdx.x; t < 128 * NT; t += gridDim.x) {
    int mt, nt; tile_of(t, NT, mt, nt);
    f32x16 acc[2][4];
    gemm_mainloop<4, 2, 2, 4>(A + (size_t)mt * 256 * LDX, LDX, Bt + (size_t)nt * 256 * LDX, LDX, DM, lds, acc);
    const int mrow0 = mt * 256 + wr * 64, cb = nt * 256 + wc * 128;
    if (WHICH == 0) {
      epi_in_e(p, acc[0][0], acc[0][1], acc[1][0], acc[1][1], mrow0, cb, r32, hi);
      epi_in_e(p, acc[0][2], acc[0][3], acc[1][2], acc[1][3], mrow0, cb + 64, r32, hi);
      stage_out_bf16(acc, p.proj + (size_t)mt * 256 * NE + nt * 256, NE, lds);
    } else if (WHICH == 2) {
      epi_in_o(p, acc[0][0], acc[0][1], acc[1][0], acc[1][1], mrow0, cb, r32, hi);
      epi_in_o(p, acc[0][2], acc[0][3], acc[1][2], acc[1][3], mrow0, cb + 64, r32, hi);
      stage_out_bf16(acc, p.proj + (size_t)mt * 256 * NO + nt * 256, NO, lds);
    } else if (WHICH == 1) epi_out<true>(p, acc, mt * 256, nt * 256, lds);
    else epi_out<false>(p, acc, mt * 256, nt * 256, lds);
  }
}
template <int NCH, int STR>
DI void copy_rows_bf16(const char* lds, u16* dst, int ld) {
  const int tid = my_tid();
#pragma unroll
  for (int i = 0; i < (256 * NCH) / NTHR; ++i) {
    const int c = tid + i * NTHR, row = c / NCH, ch = c % NCH;
    const u32x2 a = *(const u32x2*)(lds + row * STR + ch * 16), b = *(const u32x2*)(lds + row * STR + ch * 16 + 8);
    u32x4 w; w.x = a.x; w.y = a.y; w.z = b.x; w.w = b.y;
    *(u32x4*)(dst + (size_t)row * ld + ch * 8) = w;
  }
}
DI void upproj_phase(const Params& p, char* lds) {
  const int wave = my_tid() >> 6, lane = my_tid() & 63, r32 = lane & 31, hi = lane >> 5;
  for (int t = blockIdx.x; t < 128 * 8; t += gridDim.x) {
    int mt, hh; tile_of(t, 8, mt, hh);
    f32x16 acc[1][3];
    gemm_mainloop3<8, 1, 1, 3>(p.proj + (size_t)mt * 256 * NO, NO, p.wt_cq + (size_t)hh * 96 * 256, 256, 256, lds, acc);
    const int T = mt * 256 + wave * 32 + r32;
    const float rcq = rsqrtf(p.sscq[T] * (1.f / 256) + EPS);
    f32x16 v0 = acc[0][0] * rcq, v1 = acc[0][1] * rcq, v2 = acc[0][2] * rcq;
    const float ss = half_sum(sumsq16(v0) + sumsq16(v1) + sumsq16(v2)); const float ri = rsqrtf(ss * (1.f / 96) + EPS);
    f32x16 g; load_blk_f32(p.gq_c, hi, g); v0 = v0 * ri * g; load_blk_f32(p.gq_c + 32, hi, g); v1 = v1 * ri * g; load_blk_f32(p.gq_c + 64, hi, g); v2 = v2 * ri * g;
    rot16(v2, p.tab_mla + (T & 4095) * 16, hi);
    { const float cs = 0.10206207261596575f * LOG2E; v0 = v0 * cs; v1 = v1 * cs; v2 = v2 * cs; }
    u16* rowp = (u16*)(lds + (wave * 32 + r32) * 200);
    store_blk_bf16(rowp, v0, hi); store_blk_bf16(rowp + 32, v1, hi); store_blk_bf16(rowp + 64, v2, hi);
    __syncthreads();
    copy_rows_bf16<12, 200>(lds, p.qc + (size_t)mt * 256 * 768 + hh * 96, 768);
    __syncthreads();
  }
  for (int t = blockIdx.x; t < 128 * 8; t += gridDim.x) {
    int mt, hh; tile_of(t, 8, mt, hh);
    f32x16 acc[1][4];
    gemm_mainloop3<8, 1, 1, 4>(p.proj + (size_t)mt * 256 * NO + 256, NO, p.wt_ckv + (size_t)hh * 128 * 128, 128, 128, lds, acc);
    const int T = mt * 256 + wave * 32 + r32;
    const float rkv = rsqrtf(p.ssckv[T] * (1.f / 128) + EPS);
    f32x16 v0 = acc[0][0] * rkv, v1 = acc[0][1] * rkv, v2 = acc[0][2] * rkv, v3 = acc[0][3] * rkv, kp;
    load_blk_bf16(p.proj + (size_t)T * NO + 2944, hi, kp);
    const float ss = half_sum(sumsq16(v0) + sumsq16(v1) + sumsq16(kp)); const float ri = rsqrtf(ss * (1.f / 96) + EPS);
    f32x16 g; load_blk_f32(p.gk_c, hi, g); v0 = v0 * ri * g; load_blk_f32(p.gk_c + 32, hi, g); v1 = v1 * ri * g; load_blk_f32(p.gk_c + 64, hi, g); kp = kp * ri * g;
    rot16(kp, p.tab_mla + (T & 4095) * 16, hi);
    u16* rowp = (u16*)(lds + (wave * 32 + r32) * 200);
    store_blk_bf16(rowp, v0, hi); store_blk_bf16(rowp + 32, v1, hi); store_blk_bf16(rowp + 64, kp, hi);
    u16* vrow = (u16*)(lds + 51200 + (wave * 32 + r32) * 136);
    store_blk_bf16(vrow, v2, hi); store_blk_bf16(vrow + 32, v3, hi);
    __syncthreads();
    copy_rows_bf16<12, 200>(lds, p.kc + (size_t)mt * 256 * 768 + hh * 96, 768);
    copy_rows_bf16<8, 136>(lds + 51200, p.vc + (size_t)mt * 256 * 512 + hh * 64, 512);
    __syncthreads();
  }
}

template <int KS> DI int kswz(int row, int chunk) { return KS == 128 ? row * 128 + ((chunk ^ ((row >> 1) & 7)) << 4) : row * 256 + ((chunk ^ (row & 7)) << 4); }
template <int DV> DI int v_st(int k, int c) { constexpr int NCS = DV / 32; const int kk = k; return ((kk >> 3) * NCS + (c >> 5)) * 512 + ((kk & 7) * 32 + (c & 31)) * 2; }
DI int v_rd_base(int lane) { return ((lane & 3) << 3) | (((lane >> 2) & 3) << 6) | (((lane >> 4) & 1) << 5) | (((lane >> 5) & 1) << 8); }
template <int OFF> DI s16x4 tr_read(int vb) { s16x4 r; asm volatile("ds_read_b64_tr_b16 %0, %1 offset:%2" : "=&v"(r) : "v"(vb), "i"(OFF) : "memory"); return r; }

template <int DQK, int KS>
DI void qkt(f32x16& p0, f32x16& p1, const char* Ks, const bf16x8* qr, int r32, int hi) {
#pragma unroll
  for (int r = 0; r < 16; ++r) { p0[r] = 0.f; p1[r] = 0.f; }
#pragma unroll
  for (int d0 = 0; d0 < DQK / 16; ++d0) {
    const bf16x8 b0 = *(const bf16x8*)(Ks + kswz<KS>(r32, d0 * 2 + hi));
    const bf16x8 b1 = *(const bf16x8*)(Ks + kswz<KS>(32 + r32, d0 * 2 + hi));
    p0 = MFMA32(b0, qr[d0], p0); p1 = MFMA32(b1, qr[d0], p1);
  }
}
template <int DV, int D0>
DI void pv_one(f32x16& od, int vb, bf16x8 pa0, bf16x8 pa1, bf16x8 pa2, bf16x8 pa3) {
  constexpr int NCS = DV / 32;
#define VOFF(ks, half) (D0 * 512 + (2 * (ks) + (half)) * NCS * 512)
  const s16x4 l0 = tr_read<VOFF(0, 0)>(vb), h0 = tr_read<VOFF(0, 1)>(vb), l1 = tr_read<VOFF(1, 0)>(vb), h1 = tr_read<VOFF(1, 1)>(vb);
  const s16x4 l2 = tr_read<VOFF(2, 0)>(vb), h2 = tr_read<VOFF(2, 1)>(vb), l3 = tr_read<VOFF(3, 0)>(vb), h3 = tr_read<VOFF(3, 1)>(vb);
#undef VOFF
  asm volatile("s_waitcnt lgkmcnt(0)" ::: "memory"); SBAR();
#define PK(L, H) (bf16x8){L[0], L[1], L[2], L[3], H[0], H[1], H[2], H[3]}
  od = MFMA32(PK(l0, h0), pa0, od); od = MFMA32(PK(l1, h1), pa1, od); od = MFMA32(PK(l2, h2), pa2, od); od = MFMA32(PK(l3, h3), pa3, od);
#undef PK
}
template <int DV>
DI void pv_all(f32x16 (&o)[DV / 32], int vb, bf16x8 pa0, bf16x8 pa1, bf16x8 pa2, bf16x8 pa3) {
  pv_one<DV, 0>(o[0], vb, pa0, pa1, pa2, pa3); pv_one<DV, 1>(o[1], vb, pa0, pa1, pa2, pa3);
  if constexpr (DV == 128) { pv_one<DV, 2>(o[2], vb, pa0, pa1, pa2, pa3); pv_one<DV, 3>(o[3], vb, pa0, pa1, pa2, pa3); }
}
#define PK4(P, BASE, OUT) do { u32x4 w = {cvtpk(P[BASE + 0], P[BASE + 1]), cvtpk(P[BASE + 2], P[BASE + 3]), cvtpk(P[BASE + 4], P[BASE + 5]), cvtpk(P[BASE + 6], P[BASE + 7])}; \
    OUT = *reinterpret_cast<bf16x8*>(&w); } while (0)

template <int ND0>
DI void softmax_step(f32x16& t0, f32x16& t1, float& m, float& l, f32x16 (&o)[ND0], bf16x8& pa0, bf16x8& pa1, bf16x8& pa2, bf16x8& pa3) {
  float pmax = t0[0];
#pragma unroll
  for (int r = 1; r < 16; ++r) pmax = fmaxf(pmax, t0[r]);
#pragma unroll
  for (int r = 0; r < 16; ++r) pmax = fmaxf(pmax, t1[r]);
  pmax = half_max(pmax);
  const float mn = fmaxf(m, pmax);
  const float alpha = __builtin_amdgcn_exp2f(m - mn);
  m = mn;
#pragma unroll
  for (int r = 0; r < 16; ++r) { t0[r] = __builtin_amdgcn_exp2f(t0[r] - mn); t1[r] = __builtin_amdgcn_exp2f(t1[r] - mn); }
  float ps = 0.f;
#pragma unroll
  for (int r = 0; r < 16; ++r) ps += t0[r] + t1[r];
  ps = half_sum(ps);
  l = l * alpha + ps;
  if (__any(alpha < 1.f)) {
#pragma unroll
    for (int d = 0; d < ND0; ++d) o[d] = o[d] * alpha;
  }
  PK4(t0, 0, pa0); PK4(t0, 8, pa1); PK4(t1, 0, pa2); PK4(t1, 8, pa3);
}

template <int DQK, int DV>
DI void flash(const u16* __restrict__ Qlane, const u16* __restrict__ Kb, const int ldk, const u16* __restrict__ Vb, const int ldv,
              const float C, const float nMc, f32x16 (&o)[DV / 32], float& l_out, char* lds) {
  constexpr int KS = DQK == 64 ? 128 : 256, KCR = DQK / 8, NKC = (KCR + 7) / 8, VCR = DV / 8, NVC = VCR / 8, ND0 = DV / 32, NQ = DQK / 16;
  constexpr int KBYTES = 64 * KS, ABUF = KBYTES + 64 * DV * 2, NTILE = SEQ / 64;
  const int tid = my_tid(), lane = tid & 63, r32 = lane & 31, hi = lane >> 5;
  bf16x8 qr[NQ];
#pragma unroll
  for (int d0 = 0; d0 < NQ; ++d0) qr[d0] = *(const bf16x8*)(Qlane + d0 * 16);
  int kg[NKC], kl[NKC], vg[NVC], vl[NVC];
#pragma unroll
  for (int i = 0; i < NKC; ++i) { const int c = min(tid + i * NTHR, 64 * KCR - 1), row = c / KCR, cc = c % KCR; kg[i] = row * ldk + cc * 8; kl[i] = kswz<KS>(row, cc); }
#pragma unroll
  for (int i = 0; i < NVC; ++i) { const int c = tid + i * NTHR, key = c / VCR, c8 = c % VCR; vg[i] = key * ldv + c8 * 8; vl[i] = KBYTES + v_st<DV>(key, c8 * 8); }
  const int vb0 = (int)(uintptr_t)lds + KBYTES + v_rd_base(lane);
  float lsum = 0.f;
#pragma unroll
  for (int d = 0; d < ND0; ++d)
#pragma unroll
    for (int r = 0; r < 16; ++r) o[d][r] = 0.f;
  bf16x8 ks[NKC], vs[NVC];
#pragma unroll
  for (int i = 0; i < NKC; ++i) ks[i] = *(const bf16x8*)(Kb + kg[i]);
#pragma unroll
  for (int i = 0; i < NVC; ++i) vs[i] = *(const bf16x8*)(Vb + vg[i]);
#pragma unroll
  for (int i = 0; i < NKC; ++i) *(bf16x8*)(lds + kl[i]) = ks[i];
#pragma unroll
  for (int i = 0; i < NVC; ++i) *(bf16x8*)(lds + vl[i]) = vs[i];
  __syncthreads();
  for (int j = 0; j < NTILE; ++j) {
    const int cur = j & 1;
    if (j + 1 < NTILE) {
      const u16* kn = Kb + (size_t)(j + 1) * 64 * ldk; const u16* vn = Vb + (size_t)(j + 1) * 64 * ldv;
#pragma unroll
      for (int i = 0; i < NKC; ++i) ks[i] = *(const bf16x8*)(kn + kg[i]);
#pragma unroll
      for (int i = 0; i < NVC; ++i) vs[i] = *(const bf16x8*)(vn + vg[i]);
    }
    f32x16 p0, p1; bf16x8 pa0, pa1, pa2, pa3;
    qkt<DQK, KS>(p0, p1, lds + cur * ABUF, qr, r32, hi);
#pragma unroll
    for (int r = 0; r < 16; ++r) { p0[r] = __builtin_amdgcn_exp2f(p0[r]); p1[r] = __builtin_amdgcn_exp2f(p1[r]); }
    { const f32x16 s_ = p0 + p1; lsum += ((s_[0] + s_[1]) + (s_[2] + s_[3])) + ((s_[4] + s_[5]) + (s_[6] + s_[7])) + ((s_[8] + s_[9]) + (s_[10] + s_[11])) + ((s_[12] + s_[13]) + (s_[14] + s_[15])); }
    PK4(p0, 0, pa0); PK4(p0, 8, pa1); PK4(p1, 0, pa2); PK4(p1, 8, pa3);
    pv_all<DV>(o, vb0 + cur * ABUF, pa0, pa1, pa2, pa3);
    if (j + 1 < NTILE) {
      char* nb = lds + (cur ^ 1) * ABUF;
#pragma unroll
      for (int i = 0; i < NKC; ++i) *(bf16x8*)(nb + kl[i]) = ks[i];
#pragma unroll
      for (int i = 0; i < NVC; ++i) *(bf16x8*)(nb + vl[i]) = vs[i];
    }
    __syncthreads();
  }
  l_out = half_sum(lsum);
}

template <int DQK, int DV>
DI void flash_pipe_v1(const u16* __restrict__ Qlane, const u16* __restrict__ Kb, const int ldk, const u16* __restrict__ Vb, const int ldv,
                   const float C, const float nMc, f32x16 (&o)[DV / 32], float& l_out, char* lds) {
  constexpr int KS = DQK == 64 ? 128 : 256, KCR = DQK / 8, NKC = (KCR + 7) / 8, VCR = DV / 8, NVC = VCR / 8, ND0 = DV / 32, NQ = DQK / 16;
  constexpr int KBYTES = 64 * KS, VBYTES = 64 * DV * 2, VOFF0 = 2 * KBYTES, NTILE = SEQ / 64;
  const int tid = my_tid(), lane = tid & 63, r32 = lane & 31, hi = lane >> 5;
  bf16x8 qr[NQ];
#pragma unroll
  for (int d0 = 0; d0 < NQ; ++d0) qr[d0] = *(const bf16x8*)(Qlane + d0 * 16);
  int kg[NKC], kl[NKC], vg[NVC], vl[NVC];
#pragma unroll
  for (int i = 0; i < NKC; ++i) { const int c = min(tid + i * NTHR, 64 * KCR - 1), row = c / KCR, cc = c % KCR; kg[i] = row * ldk + cc * 8; kl[i] = kswz<KS>(row, cc); }
#pragma unroll
  for (int i = 0; i < NVC; ++i) { const int c = tid + i * NTHR, key = c / VCR, c8 = c % VCR; vg[i] = key * ldv + c8 * 8; vl[i] = VOFF0 + v_st<DV>(key, c8 * 8); }
  const int vb0 = (int)(uintptr_t)lds + VOFF0 + v_rd_base(lane);
  float l = 0.f;
#pragma unroll
  for (int d = 0; d < ND0; ++d)
#pragma unroll
    for (int r = 0; r < 16; ++r) o[d][r] = 0.f;
  bf16x8 ks[NKC], vs[NVC];
#define FP_LOADK(J) do { const u16* kn = Kb + (size_t)(J) * 64 * ldk; _Pragma("unroll") for (int i = 0; i < NKC; ++i) ks[i] = *(const bf16x8*)(kn + kg[i]); } while (0)
#define FP_LOADV(J) do { const u16* vn = Vb + (size_t)(J) * 64 * ldv; _Pragma("unroll") for (int i = 0; i < NVC; ++i) vs[i] = *(const bf16x8*)(vn + vg[i]); } while (0)
#define FP_WRITEK(B) do { _Pragma("unroll") for (int i = 0; i < NKC; ++i) *(bf16x8*)(lds + (B) * KBYTES + kl[i]) = ks[i]; } while (0)
#define FP_WRITEV(B) do { _Pragma("unroll") for (int i = 0; i < NVC; ++i) *(bf16x8*)(lds + (B) * VBYTES + vl[i]) = vs[i]; } while (0)
#define FP_PARTIAL(P0) do { _Pragma("unroll") for (int r = 0; r < 16; ++r) P0[r] = __builtin_amdgcn_exp2f(P0[r]); } while (0)
#define FP_FINISH(P0, P1) do { _Pragma("unroll") for (int r = 0; r < 16; ++r) P1[r] = __builtin_amdgcn_exp2f(P1[r]); \
    { const f32x16 s_ = P0 + P1; lsum += ((s_[0] + s_[1]) + (s_[2] + s_[3])) + ((s_[4] + s_[5]) + (s_[6] + s_[7])) + ((s_[8] + s_[9]) + (s_[10] + s_[11])) + ((s_[12] + s_[13]) + (s_[14] + s_[15])); } \
    PK4(P0, 0, pa0); PK4(P0, 8, pa1); PK4(P1, 0, pa2); PK4(P1, 8, pa3); } while (0)
#define FP_STEP(PX0, PX1, PY0, PY1, JJ) do { \
    SBAR(); \
    if ((JJ) + 1 < NTILE) qkt<DQK, KS>(PY0, PY1, lds + (((JJ) + 1) & 1) * KBYTES, qr, r32, hi); \
    FP_FINISH(PX0, PX1); \
    SBAR(); \
    if ((JJ) + 2 < NTILE) FP_LOADK((JJ) + 2); \
    if ((JJ) + 1 < NTILE) FP_LOADV((JJ) + 1); \
    SBAR(); \
    pv_all<DV>(o, vb0 + ((JJ) & 1) * VBYTES, pa0, pa1, pa2, pa3); \
    if ((JJ) + 1 < NTILE) FP_PARTIAL(PY0); \
    SBAR(); \
    if ((JJ) + 2 < NTILE) FP_WRITEK((JJ) & 1); \
    if ((JJ) + 1 < NTILE) FP_WRITEV(((JJ) + 1) & 1); \
    __syncthreads(); } while (0)
  f32x16 pA0, pA1, pB0, pB1; bf16x8 pa0, pa1, pa2, pa3;
  float lsum = 0.f;
  FP_LOADK(0); FP_LOADV(0); FP_WRITEK(0); FP_WRITEV(0); FP_LOADK(1); FP_WRITEK(1);
  __syncthreads();
  qkt<DQK, KS>(pA0, pA1, lds, qr, r32, hi);
  FP_PARTIAL(pA0);
  __syncthreads();
  for (int j = 0; j < NTILE; j += 2) {
    FP_STEP(pA0, pA1, pB0, pB1, j);
    FP_STEP(pB0, pB1, pA0, pA1, j + 1);
  }
#undef FP_LOADK
#undef FP_LOADV
#undef FP_WRITEK
#undef FP_WRITEV
#undef FP_PARTIAL
#undef FP_FINISH
#undef FP_STEP
  l_out = half_sum(lsum);
}

template <int DQK, int DV, bool DEEP>
DI void flash_pipe(const u16* __restrict__ Qlane, const u16* __restrict__ Kb, const int ldk, const u16* __restrict__ Vb, const int ldv,
                   f32x16 (&o)[DV / 32], float& l_out, char* lds) {
  constexpr int KS = DQK == 64 ? 128 : 256, KCR = DQK / 8, NKC = (KCR + 7) / 8, VCR = DV / 8, NVC = VCR / 8, ND0 = DV / 32, NQ = DQK / 16;
  constexpr int KBYTES = 64 * KS, VBYTES = 64 * DV * 2, VOFF0 = 2 * KBYTES, NTILE = SEQ / 64;
  const int tid = my_tid(), lane = tid & 63, r32 = lane & 31, hi = lane >> 5;
  bf16x8 qr[NQ];
#pragma unroll
  for (int d0 = 0; d0 < NQ; ++d0) qr[d0] = *(const bf16x8*)(Qlane + d0 * 16);
  int kg[NKC], kl[NKC], vg[NVC], vl[NVC];
#pragma unroll
  for (int i = 0; i < NKC; ++i) { const int c = min(tid + i * NTHR, 64 * KCR - 1), row = c / KCR, cc = c % KCR; kg[i] = row * ldk + cc * 8; kl[i] = kswz<KS>(row, cc); }
#pragma unroll
  for (int i = 0; i < NVC; ++i) { const int c = tid + i * NTHR, key = c / VCR, c8 = c % VCR; vg[i] = key * ldv + c8 * 8; vl[i] = VOFF0 + v_st<DV>(key, c8 * 8); }
  const int vb0 = (int)(uintptr_t)lds + VOFF0 + v_rd_base(lane);
#pragma unroll
  for (int d = 0; d < ND0; ++d)
#pragma unroll
    for (int r = 0; r < 16; ++r) o[d][r] = 0.f;
  bf16x8 ksA[NKC], vsA[NVC], ksB[NKC], vsB[NVC];
#define FP_LOADK(KSR, J) do { const u16* kn = Kb + (size_t)(J) * 64 * ldk; _Pragma("unroll") for (int i = 0; i < NKC; ++i) KSR[i] = *(const bf16x8*)(kn + kg[i]); } while (0)
#define FP_LOADV(VSR, J) do { const u16* vn = Vb + (size_t)(J) * 64 * ldv; _Pragma("unroll") for (int i = 0; i < NVC; ++i) VSR[i] = *(const bf16x8*)(vn + vg[i]); } while (0)
#define FP_WRITEK(KSR, B) do { _Pragma("unroll") for (int i = 0; i < NKC; ++i) *(bf16x8*)(lds + (B) * KBYTES + kl[i]) = KSR[i]; } while (0)
#define FP_WRITEV(VSR, B) do { _Pragma("unroll") for (int i = 0; i < NVC; ++i) *(bf16x8*)(lds + (B) * VBYTES + vl[i]) = VSR[i]; } while (0)
#define FP_PARTIAL(P0) do { _Pragma("unroll") for (int r = 0; r < 16; ++r) P0[r] = __builtin_amdgcn_exp2f(P0[r]); } while (0)
#define FP_FINISH(P0, P1) do { _Pragma("unroll") for (int r = 0; r < 16; ++r) P1[r] = __builtin_amdgcn_exp2f(P1[r]); \
    { const f32x16 s_ = P0 + P1; lsum += ((s_[0] + s_[1]) + (s_[2] + s_[3])) + ((s_[4] + s_[5]) + (s_[6] + s_[7])) + ((s_[8] + s_[9]) + (s_[10] + s_[11])) + ((s_[12] + s_[13]) + (s_[14] + s_[15])); } \
    PK4(P0, 0, pa0); PK4(P0, 8, pa1); PK4(P1, 0, pa2); PK4(P1, 8, pa3); } while (0)
#define FP_STEP(PX0, PX1, PY0, PY1, KX, VX, KY, VY, JJ) do { \
    SBAR(); \
    if (DEEP) { if ((JJ) + 3 < NTILE) FP_LOADK(KY, (JJ) + 3); if ((JJ) + 2 < NTILE) FP_LOADV(VY, (JJ) + 2); } \
    SBAR(); \
    if ((JJ) + 1 < NTILE) qkt<DQK, KS>(PY0, PY1, lds + (((JJ) + 1) & 1) * KBYTES, qr, r32, hi); \
    FP_FINISH(PX0, PX1); \
    SBAR(); \
    if (!DEEP) { if ((JJ) + 2 < NTILE) FP_LOADK(KX, (JJ) + 2); if ((JJ) + 1 < NTILE) FP_LOADV(VX, (JJ) + 1); } \
    SBAR(); \
    pv_all<DV>(o, vb0 + ((JJ) & 1) * VBYTES, pa0, pa1, pa2, pa3); \
    if ((JJ) + 1 < NTILE) FP_PARTIAL(PY0); \
    SBAR(); \
    if ((JJ) + 2 < NTILE) FP_WRITEK(KX, (JJ) & 1); \
    if ((JJ) + 1 < NTILE) FP_WRITEV(VX, ((JJ) + 1) & 1); \
    __syncthreads(); } while (0)
  f32x16 pA0, pA1, pB0, pB1; bf16x8 pa0, pa1, pa2, pa3;
  float lsum = 0.f;
  FP_LOADK(ksA, 0); FP_LOADV(vsA, 0); FP_LOADK(ksB, 1);
  FP_WRITEK(ksA, 0); FP_WRITEV(vsA, 0); FP_WRITEK(ksB, 1);
  if (DEEP) { FP_LOADK(ksA, 2); FP_LOADV(vsA, 1); }
  __syncthreads();
  qkt<DQK, KS>(pA0, pA1, lds, qr, r32, hi);
  FP_PARTIAL(pA0);
  __syncthreads();
  for (int j = 0; j < NTILE; j += 2) {
    FP_STEP(pA0, pA1, pB0, pB1, ksA, vsA, ksB, vsB, j);
    FP_STEP(pB0, pB1, pA0, pA1, ksB, vsB, ksA, vsA, j + 1);
  }
#undef FP_LOADK
#undef FP_LOADV
#undef FP_WRITEK
#undef FP_WRITEV
#undef FP_PARTIAL
#undef FP_FINISH
#undef FP_STEP
  l_out = half_sum(lsum);
}

template <int DQK>
DI void flash_p2(const u16* __restrict__ Qlane, const u16* __restrict__ Kb, const int ldk, const u16* __restrict__ Vb, const int ldv,
                 f32x16 (&o)[2], float& l_out, char* lds) {
  constexpr int KS = DQK == 64 ? 128 : 256, KCR = DQK / 8, NKC = KCR / 4, NVC = 2, NQ = DQK / 16;
  constexpr int KST = 128 * KS, VST = 16384, VOFF0 = 3 * KST, NPAIR = SEQ / 128;
  const int tid = my_tid(), lane = tid & 63, r32 = lane & 31, hi = lane >> 5;
  bf16x8 qr[NQ];
#pragma unroll
  for (int d0 = 0; d0 < NQ; ++d0) qr[d0] = *(const bf16x8*)(Qlane + d0 * 16);
  int kg[NKC], kl[NKC], vg[NVC], vl[NVC];
#pragma unroll
  for (int i = 0; i < NKC; ++i) { const int c = tid + i * NTHR, row = c / KCR, cc = c % KCR; kg[i] = row * ldk + cc * 8; kl[i] = kswz<KS>(row, cc); }
#pragma unroll
  for (int i = 0; i < NVC; ++i) { const int c = tid + i * NTHR, key = c >> 3, c8 = c & 7; vg[i] = key * ldv + c8 * 8; vl[i] = VOFF0 + (key >> 6) * 8192 + v_st<64>(key & 63, c8 * 8); }
  const int vb0 = (int)(uintptr_t)lds + VOFF0 + v_rd_base(lane);
#pragma unroll
  for (int d = 0; d < 2; ++d)
#pragma unroll
    for (int r = 0; r < 16; ++r) o[d][r] = 0.f;
  bf16x8 ks[NKC], vs[NVC];
#define P2_LOADK(M) do { const u16* kn = Kb + (size_t)(M) * 128 * ldk; _Pragma("unroll") for (int i = 0; i < NKC; ++i) ks[i] = *(const bf16x8*)(kn + kg[i]); } while (0)
#define P2_LOADV(M) do { const u16* vn = Vb + (size_t)(M) * 128 * ldv; _Pragma("unroll") for (int i = 0; i < NVC; ++i) vs[i] = *(const bf16x8*)(vn + vg[i]); } while (0)
#define P2_WRITEK(OFF) do { _Pragma("unroll") for (int i = 0; i < NKC; ++i) *(bf16x8*)(lds + (OFF) + kl[i]) = ks[i]; } while (0)
#define P2_WRITEV(S) do { _Pragma("unroll") for (int i = 0; i < NVC; ++i) *(bf16x8*)(lds + (S) * VST + vl[i]) = vs[i]; } while (0)
#define P2_PARTIAL(P0) do { _Pragma("unroll") for (int r = 0; r < 16; ++r) P0[r] = __builtin_amdgcn_exp2f(P0[r]); } while (0)
#define P2_FINISH(P0, P1) do { _Pragma("unroll") for (int r = 0; r < 16; ++r) P1[r] = __builtin_amdgcn_exp2f(P1[r]); \
    { const f32x16 s_ = P0 + P1; lsum += ((s_[0] + s_[1]) + (s_[2] + s_[3])) + ((s_[4] + s_[5]) + (s_[6] + s_[7])) + ((s_[8] + s_[9]) + (s_[10] + s_[11])) + ((s_[12] + s_[13]) + (s_[14] + s_[15])); } \
    PK4(P0, 0, pa0); PK4(P0, 8, pa1); PK4(P1, 0, pa2); PK4(P1, 8, pa3); } while (0)
  f32x16 pA0, pA1, pB0, pB1; bf16x8 pa0, pa1, pa2, pa3;
  float lsum = 0.f;
  P2_LOADK(0); P2_WRITEK(0); P2_LOADK(1); P2_WRITEK(KST); P2_LOADV(0); P2_WRITEV(0);
  __syncthreads();
  qkt<DQK, KS>(pA0, pA1, lds, qr, r32, hi);
  P2_PARTIAL(pA0);
  __syncthreads();
  int k0 = 0, k1 = KST, k2 = 2 * KST;
  for (int m = 0; m < NPAIR; ++m) {
    const int s = m & 1;
    SBAR();
    if (m + 2 < NPAIR) P2_LOADK(m + 2);
    if (m + 1 < NPAIR) P2_LOADV(m + 1);
    SBAR();
    qkt<DQK, KS>(pB0, pB1, lds + k0 + 64 * KS, qr, r32, hi);
    P2_FINISH(pA0, pA1);
    SBAR();
    pv_all<64>(o, vb0 + s * VST, pa0, pa1, pa2, pa3);
    P2_PARTIAL(pB0);
    SBAR();
    if (m + 1 < NPAIR) qkt<DQK, KS>(pA0, pA1, lds + k1, qr, r32, hi);
    P2_FINISH(pB0, pB1);
    SBAR();
    pv_all<64>(o, vb0 + s * VST + 8192, pa0, pa1, pa2, pa3);
    if (m + 1 < NPAIR) P2_PARTIAL(pA0);
    SBAR();
    if (m + 2 < NPAIR) P2_WRITEK(k2);
    { const int t_ = k0; k0 = k1; k1 = k2; k2 = t_; }
    if (m + 1 < NPAIR) P2_WRITEV(s ^ 1);
    __syncthreads();
  }
#undef P2_LOADK
#undef P2_LOADV
#undef P2_WRITEK
#undef P2_WRITEV
#undef P2_PARTIAL
#undef P2_FINISH
  l_out = half_sum(lsum);
}

template <int ND0>
DI void store_gated(const f32x16 (&o)[ND0], const u16* gp, u16* op, int hi) {
#pragma unroll
  for (int d = 0; d < ND0; ++d) { f32x16 g; load_blk_bf16(gp + 32 * d, hi, g); f32x16 v = o[d] * g; store_blk_bf16(op + 32 * d, v, hi); }
}

DI void na_item(const Params& p, int b, int h, int rp, char* lds) {
  constexpr int KBYTES = 8192, ABUF = 16384;
  const int tid = my_tid(), wave = tid >> 6, lane = tid & 63, r32 = lane & 31, hi = lane >> 5;
  float* tbl = (float*)(lds + 2 * ABUF);
  for (int i = tid; i < 465; i += NTHR) tbl[i] = p.rpb_a[h * 465 + i] * LOG2E;
  const int gr = 4 * rp + (wave >> 1), cq = (wave & 1) * 32 + r32;
  const int r0w = min(max(gr - 4, 0), 56), ra = min(max(4 * rp - 4, 0), 56), rb = min(max(4 * rp - 1, 0), 56) + 8;
  const int c0 = min(max(cq - 8, 0), 48);
  const size_t tb = (size_t)b * SEQ;
  const u16* Qlane = p.proj + (tb + gr * 64 + cq) * NE + h * 64 + hi * 8;
  const u16* Kb = p.proj + tb * NE + 512 + h * 64; const u16* Vb = p.proj + tb * NE + 1024 + h * 64;
  bf16x8 qr[4];
#pragma unroll
  for (int d0 = 0; d0 < 4; ++d0) qr[d0] = *(const bf16x8*)(Qlane + d0 * 16);
  int kg[1], kl[1], vl[1];
#pragma unroll
  for (int i = 0; i < 1; ++i) { const int c = tid, row = c >> 3, cc = c & 7; kg[i] = row * NE + cc * 8; kl[i] = kswz<128>(row, cc); vl[i] = KBYTES + v_st<64>(row, cc * 8); }
  const int vb0 = (int)(uintptr_t)lds + KBYTES + v_rd_base(lane);
  float m = -1e30f, l = 0.f; f32x16 o[2];
#pragma unroll
  for (int d = 0; d < 2; ++d)
#pragma unroll
    for (int r = 0; r < 16; ++r) o[d][r] = 0.f;
  bf16x8 ks[1], vs[1];
  {
    const u16* kn = Kb + (size_t)ra * 64 * NE; const u16* vn = Vb + (size_t)ra * 64 * NE;
#pragma unroll
    for (int i = 0; i < 1; ++i) { ks[i] = *(const bf16x8*)(kn + kg[i]); vs[i] = *(const bf16x8*)(vn + kg[i]); }
#pragma unroll
    for (int i = 0; i < 1; ++i) { *(bf16x8*)(lds + kl[i]) = ks[i]; *(bf16x8*)(lds + vl[i]) = vs[i]; }
  }
  __syncthreads();
  const float C = 0.125f * LOG2E;
  const int nt = rb - ra;
  for (int j = 0; j < nt; ++j) {
    const int cur = j & 1, kr = ra + j;
    if (j + 1 < nt) {
      const u16* kn = Kb + (size_t)(kr + 1) * 64 * NE; const u16* vn = Vb + (size_t)(kr + 1) * 64 * NE;
#pragma unroll
      for (int i = 0; i < 1; ++i) { ks[i] = *(const bf16x8*)(kn + kg[i]); vs[i] = *(const bf16x8*)(vn + kg[i]); }
    }
    if (kr >= r0w && kr < r0w + 8) {
      f32x16 p0, p1; bf16x8 pa0, pa1, pa2, pa3;
      qkt<64, 128>(p0, p1, lds + cur * ABUF, qr, r32, hi);
      const int rowoff = (kr - gr + 7) * 31 + 15 - cq;
#pragma unroll
      for (int r = 0; r < 16; ++r) {
        const int kc = crow(r, hi);
        const float b0 = tbl[rowoff + kc], b1 = tbl[rowoff + kc + 32];
        p0[r] = ((unsigned)(kc - c0) < 16u) ? fmaf(p0[r], C, b0) : -1e30f;
        p1[r] = ((unsigned)(kc + 32 - c0) < 16u) ? fmaf(p1[r], C, b1) : -1e30f;
      }
      softmax_step<2>(p0, p1, m, l, o, pa0, pa1, pa2, pa3);
      pv_all<64>(o, vb0 + cur * ABUF, pa0, pa1, pa2, pa3);
    }
    if (j + 1 < nt) {
      char* nb = lds + (cur ^ 1) * ABUF;
#pragma unroll
      for (int i = 0; i < 1; ++i) { *(bf16x8*)(nb + kl[i]) = ks[i]; *(bf16x8*)(nb + vl[i]) = vs[i]; }
    }
    __syncthreads();
  }
  const float inv = 1.f / l;
  o[0] = o[0] * inv; o[1] = o[1] * inv;
  const size_t T = tb + gr * 64 + cq;
  store_gated<2>(o, p.proj + T * NE + 2304 + h * 64, p.ob + T * LDX + h * 64, hi);
}

DI void attn_phase_even(const Params& p, char* lds) {
  const int wave = my_tid() >> 6, lane = my_tid() & 63, r32 = lane & 31, hi = lane >> 5;
  for (int t = blockIdx.x; t < 1024; t += gridDim.x) { const int b = t & 7, idx = t >> 3; na_item(p, b, idx >> 4, idx & 15, lds); }
  for (int t = blockIdx.x; t < 1024; t += gridDim.x) {
    const int b = t & 7, idx = t >> 3, h = idx >> 4, qb = idx & 15, kvh = h >> 2;
    const size_t tb = (size_t)b * SEQ, T = tb + qb * 256 + wave * 32 + r32;
    f32x16 o[2]; float l;
    flash_p2<64>(p.proj + T * NE + 1536 + h * 64 + hi * 8, p.proj + tb * NE + 2048 + kvh * 64, NE, p.proj + tb * NE + 2176 + kvh * 64, NE, o, l, lds);
    const float inv = 1.f / l; o[0] = o[0] * inv; o[1] = o[1] * inv;
    store_gated<2>(o, p.proj + T * NE + 2304 + 512 + h * 64, p.ob + T * LDX + 512 + h * 64, hi);
  }
}
DI void attn_phase_odd(const Params& p, char* lds) {
  const int wave = my_tid() >> 6, lane = my_tid() & 63, r32 = lane & 31, hi = lane >> 5;
  for (int t = blockIdx.x; t < 1024; t += gridDim.x) {
    const int b = t & 7, idx = t >> 3, h = idx >> 4, qb = idx & 15;
    const size_t tb = (size_t)b * SEQ, T = tb + qb * 256 + wave * 32 + r32;
    f32x16 o[2]; float l;
    flash_p2<96>(p.qc + T * 768 + h * 96 + hi * 8, p.kc + tb * 768 + h * 96, 768, p.vc + tb * 512 + h * 64, 512, o, l, lds);
    const float inv = 1.f / l; o[0] = o[0] * inv; o[1] = o[1] * inv;
    store_gated<2>(o, p.proj + T * NO + 1920 + h * 64, p.ob + T * LDX + h * 64, hi);
  }
  const float lam = p.lam[0], nMd = -p.lam[3] * LOG2E;
  for (int t = blockIdx.x; t < 512; t += gridDim.x) {
    const int b = t & 7, idx = t >> 3, h = idx >> 4, qb = idx & 15;
    const size_t tb = (size_t)b * SEQ, T = tb + qb * 256 + wave * 32 + r32;
    f32x16 o1[4]; float l1, l2;
    const u16* vb = p.proj + tb * NO + 1408 + h * 128;
    float* stash = (float*)p.xb + (size_t)blockIdx.x * 32768 + my_tid() * 64;
    flash<64, 128>(p.proj + T * NO + 384 + h * 128 + hi * 8, p.proj + tb * NO + 896 + h * 128, NO, vb, NO, 0.125f * LOG2E, nMd, o1, l1, lds);
    { const float inv = 1.f / l1;
#pragma unroll
      for (int d = 0; d < 4; ++d)
#pragma unroll
        for (int q = 0; q < 4; ++q) { f32x4 v; v[0] = o1[d][4 * q] * inv; v[1] = o1[d][4 * q + 1] * inv; v[2] = o1[d][4 * q + 2] * inv; v[3] = o1[d][4 * q + 3] * inv; *(f32x4*)(stash + (d * 4 + q) * 4) = v; } }
    flash<64, 128>(p.proj + T * NO + 384 + h * 128 + 64 + hi * 8, p.proj + tb * NO + 896 + h * 128 + 64, NO, vb, NO, 0.125f * LOG2E, nMd, o1, l2, lds);
    const float f = lam / l2; float ss = 0.f;
#pragma unroll
    for (int d = 0; d < 4; ++d) {
#pragma unroll
      for (int q = 0; q < 4; ++q) { const f32x4 v = *(const f32x4*)(stash + (d * 4 + q) * 4);
#pragma unroll
        for (int j = 0; j < 4; ++j) o1[d][4 * q + j] = v[j] - o1[d][4 * q + j] * f; }
      ss += sumsq16(o1[d]);
    }
    ss = half_sum(ss);
    const float ri = rsqrtf(ss * (1.f / 128) + EPS) * (1.f - LAM_INIT);
#pragma unroll
    for (int d = 0; d < 4; ++d) { f32x16 g; load_blk_f32(p.g_sub_d + 32 * d, hi, g); o1[d] = o1[d] * ri * g; }
    store_gated<4>(o1, p.proj + T * NO + 1920 + 512 + h * 128, p.ob + T * LDX + 512 + h * 128, hi);
  }
}

DI void grid_bar(unsigned* cnt, unsigned target) {
  asm volatile("s_waitcnt vmcnt(0)" ::: "memory");
  __syncthreads();
  if (threadIdx.x == 0) {
    __builtin_amdgcn_fence(__ATOMIC_RELEASE, "agent");
    asm volatile("s_waitcnt vmcnt(0)" ::: "memory");
    __hip_atomic_fetch_add(cnt, 1u, __ATOMIC_RELAXED, __HIP_MEMORY_SCOPE_AGENT);
    unsigned spins = 0;
    while (__hip_atomic_load(cnt, __ATOMIC_RELAXED, __HIP_MEMORY_SCOPE_AGENT) < target) { __builtin_amdgcn_s_sleep(2); if (++spins > (1u << 24)) break; }
    __builtin_amdgcn_fence(__ATOMIC_ACQUIRE, "agent");
    asm volatile("s_waitcnt vmcnt(0)" ::: "memory");
  }
  __syncthreads();
}

constexpr int LDS_BYTES = 147456;
__global__ void __launch_bounds__(512, 2) mega(Params p) {
  extern __shared__ __attribute__((aligned(16))) char lds[];
  cg::grid_group grid = cg::this_grid();
  const int lo = p.phase_lo, hi_ = p.phase_hi;
#ifndef PROBE_REPEAT
#define PROBE_REPEAT -1
#endif
#define PHASE(k, body) if (lo <= k && k <= hi_) { if (k > lo) { if (k == 1) grid.sync(); else grid_bar(p.bar, (unsigned)(k - 1) * gridDim.x); } body; if (k == PROBE_REPEAT) { grid.sync(); body; } }
  PHASE(0, phase0(p))
  PHASE(1, gemm_phase<0>(p, lds))
  PHASE(2, attn_phase_even(p, lds))
  PHASE(3, gemm_phase<1>(p, lds))
  PHASE(4, gemm_phase<2>(p, lds))
  PHASE(5, upproj_phase(p, lds))
  PHASE(6, attn_phase_odd(p, lds))
  PHASE(7, gemm_phase<3>(p, lds))
#undef PHASE
}

#ifndef NLAUNCH
#define NLAUNCH 1
#endif
extern "C" void kernel_launch(void* const* d_in, const int* in_sizes, int n_in, void* d_out, int out_size, void* d_ws, size_t ws_size, hipStream_t stream) {
  static int grid_blocks = 0;
  if (!grid_blocks) {
    int dev = 0, cus = 0, per_cu = 0;
    (void)hipGetDevice(&dev);
    (void)hipDeviceGetAttribute(&cus, hipDeviceAttributeMultiprocessorCount, dev);
    (void)hipFuncSetAttribute((const void*)mega, hipFuncAttributeMaxDynamicSharedMemorySize, LDS_BYTES);
    (void)hipOccupancyMaxActiveBlocksPerMultiprocessor(&per_cu, mega, NTHR, LDS_BYTES);
    if (per_cu > 1) per_cu = 1;
    if (per_cu < 1) per_cu = 1;
    grid_blocks = cus * per_cu;
  }
  Params p;
  memset(&p, 0, sizeof(p));
  const float** fp = (const float**)&p;
  for (int i = 0; i < 25; ++i) fp[i] = (const float*)d_in[i];
  p.out = (float*)d_out;
  char* w = (char*)d_ws; size_t off = 0;
  auto take = [&](size_t bytes) { char* r = w + off; off += (bytes + 255) & ~(size_t)255; return r; };
  p.xb = (u16*)take((size_t)NTOK * LDX * 2);
  p.proj = (u16*)take((size_t)NTOK * NE * 2);
  p.ob = (u16*)take((size_t)NTOK * LDX * 2);
  p.qc = (u16*)take((size_t)NTOK * 768 * 2);
  p.kc = (u16*)take((size_t)NTOK * 768 * 2);
  p.vc = (u16*)take((size_t)NTOK * 512 * 2);
  p.wt_ine = (u16*)take((size_t)NE * LDX * 2);
  p.wt_oute = (u16*)take((size_t)1024 * LDX * 2);
  p.wt_ino = (u16*)take((size_t)NO * LDX * 2);
  p.wt_cq = (u16*)take((size_t)768 * 256 * 2);
  p.wt_ckv = (u16*)take((size_t)1024 * 128 * 2);
  p.wt_outo = (u16*)take((size_t)1024 * LDX * 2);
  p.rs0 = (float*)take(NTOK * 4); p.ss1 = (float*)take(NTOK * 4); p.sscq = (float*)take(NTOK * 4); p.ssckv = (float*)take(NTOK * 4);
  p.lam = (float*)take(256);
  p.bar = (unsigned*)take(256);
  p.tab_ax = (float2*)take(64 * 16 * 8); p.tab_mla = (float2*)take(4096 * 16 * 8); p.tab_part = (float2*)take(4096 * 8 * 8);
  if (off > ws_size) { fprintf(stderr, "workspace too small: need %zu have %zu\n", off, ws_size); return; }
  for (int i = 0; i < 16; ++i) p.inv16[i] = (float)pow(10000.0, -(double)i / 16.0);
  for (int i = 0; i < 8; ++i) p.inv8[i] = (float)pow(500000.0, -(double)i / 8.0);
#if NLAUNCH == 1
  p.phase_lo = 0; p.phase_hi = 7;
  void* args[] = {&p};
  hipError_t e = hipLaunchCooperativeKernel((void*)mega, dim3(grid_blocks), dim3(NTHR), args, LDS_BYTES, stream);
  if (e != hipSuccess) fprintf(stderr, "cooperative launch failed: %s (grid %d)\n", hipGetErrorString(e), grid_blocks);
#else
  for (int ph = 0; ph < 8; ++ph) { p.phase_lo = ph; p.phase_hi = ph; hipLaunchKernelGGL(mega, dim3(grid_blocks), dim3(NTHR), LDS_BYTES, stream, p); }
#endif
}
```

```cpp
#include <hip/hip_runtime.h>
#include <hip/hip_cooperative_groups.h>
#include <cstdio>
#include <cstdint>
#include <cmath>
#include <cstring>
namespace cg = cooperative_groups;

typedef unsigned short u16;
using bf16x8 = __attribute__((ext_vector_type(8))) short;
using s16x4  = __attribute__((ext_vector_type(4))) short;
using f32x16 = __attribute__((ext_vector_type(16))) float;
using f32x4  = __attribute__((ext_vector_type(4))) float;
using u32x4  = __attribute__((ext_vector_type(4))) unsigned;
using u32x2  = __attribute__((ext_vector_type(2))) unsigned;

#define DI __device__ __forceinline__
#define MFMA32(a, b, c) __builtin_amdgcn_mfma_f32_32x32x16_bf16((a), (b), (c), 0, 0, 0)
#define SBAR() __builtin_amdgcn_sched_barrier(0)

constexpr int NTOK = 32768, SEQ = 4096, DM = 1024, NE = 3328, NO = 3072;
constexpr int NTHR = 512, NWAVE = 8;
constexpr int LDX = 1088;
constexpr float EPS = 1e-6f, LOG2E = 1.4426950408889634f;
constexpr float LAM_INIT = 0.35550906759096930f;

struct Params {
  const float *x, *norm_e, *w_in_e, *gq_a, *gk_a, *rpb_a, *gq_b, *gk_b, *w_out_e,
      *norm_o, *w_in_o, *g_cq, *w_cq_b, *g_ckv, *w_ckv_b, *gq_c, *gk_c, *gq_d, *gk_d,
      *lam_q1, *lam_k1, *lam_q2, *lam_k2, *g_sub_d, *w_out_o;
  float* out;
  u16 *xb, *proj, *ob, *qc, *kc, *vc, *wt_ine, *wt_oute, *wt_ino, *wt_cq, *wt_ckv, *wt_outo;
  float *rs0, *ss1, *sscq, *ssckv, *lam;
  unsigned* bar;
  float2 *tab_ax, *tab_mla, *tab_part;
  float inv16[16];
  float inv8[8];
  int phase_lo, phase_hi;
};

DI int my_tid() { int t = threadIdx.x; asm volatile("" : "+v"(t)); return t; }
DI int crow(int r, int hi) { return (r & 3) + 8 * (r >> 2) + 4 * hi; }
DI unsigned cvtpk(float lo, float hi) { unsigned r; asm volatile("v_cvt_pk_bf16_f32 %0, %1, %2" : "=v"(r) : "v"(lo), "v"(hi)); return r; }
DI float bflo(unsigned w) { return __uint_as_float(w << 16); }
DI float bfhi(unsigned w) { return __uint_as_float(w & 0xffff0000u); }
DI float half_sum(float v) {
  auto rr = __builtin_amdgcn_permlane32_swap(__float_as_uint(v), __float_as_uint(v), false, false);
  return __uint_as_float(rr[0]) + __uint_as_float(rr[1]);
}
DI float half_max(float v) {
  auto rr = __builtin_amdgcn_permlane32_swap(__float_as_uint(v), __float_as_uint(v), false, false);
  return fmaxf(__uint_as_float(rr[0]), __uint_as_float(rr[1]));
}
DI float wave_sum(float v) {
  v += __shfl_xor(v, 32); v += __shfl_xor(v, 16); v += __shfl_xor(v, 8); v += __shfl_xor(v, 4); v += __shfl_xor(v, 2); v += __shfl_xor(v, 1);
  return v;
}
DI void store_blk_bf16(u16* rowp, const f32x16& v, int hi) {
#pragma unroll
  for (int q = 0; q < 4; ++q) { u32x2 w; w.x = cvtpk(v[4 * q], v[4 * q + 1]); w.y = cvtpk(v[4 * q + 2], v[4 * q + 3]); *(u32x2*)(rowp + 8 * q + 4 * hi) = w; }
}
DI void load_blk_f32(const float* g, int hi, f32x16& o) {
#pragma unroll
  for (int q = 0; q < 4; ++q) { f32x4 t = *(const f32x4*)(g + 8 * q + 4 * hi); o[4 * q] = t[0]; o[4 * q + 1] = t[1]; o[4 * q + 2] = t[2]; o[4 * q + 3] = t[3]; }
}
DI void load_blk_bf16(const u16* g, int hi, f32x16& o) {
#pragma unroll
  for (int q = 0; q < 4; ++q) { u32x2 w = *(const u32x2*)(g + 8 * q + 4 * hi); o[4 * q] = bflo(w.x); o[4 * q + 1] = bfhi(w.x); o[4 * q + 2] = bflo(w.y); o[4 * q + 3] = bfhi(w.y); }
}
DI float sumsq16(const f32x16& v) { float s = 0;
#pragma unroll
  for (int r = 0; r < 16; ++r) s = fmaf(v[r], v[r], s); return s; }
DI void rot16(f32x16& v, const float2* tab, int hi) {
#pragma unroll
  for (int r = 0; r < 8; ++r) { const float2 cs = tab[crow(r, hi)]; const float a = v[r], b = v[r + 8]; v[r] = a * cs.x - b * cs.y; v[r + 8] = b * cs.x + a * cs.y; }
}
DI void rot8(f32x16& v, const float2* tab, int hi) {
#pragma unroll
  for (int r = 0; r < 4; ++r) { const float2 cs = tab[r + 4 * hi]; const float a = v[r], b = v[r + 4]; v[r] = a * cs.x - b * cs.y; v[r + 4] = b * cs.x + a * cs.y; }
}
DI float silu(float v) { return v / (1.f + __expf(-v)); }

DI void sincos_rev(double f, float& c, float& s) {
  const double q = floor(4.0 * f + 0.5), y = f - 0.25 * q, th = 6.283185307179586 * y, t2 = th * th;
  const double sn = th * (1.0 + t2 * (-1.0 / 6 + t2 * (1.0 / 120 + t2 * (-1.0 / 5040 + t2 * (1.0 / 362880 + t2 * (-1.0 / 39916800 + t2 * (1.0 / 6227020800.0)))))));
  const double cs = 1.0 + t2 * (-0.5 + t2 * (1.0 / 24 + t2 * (-1.0 / 720 + t2 * (1.0 / 40320 + t2 * (-1.0 / 3628800 + t2 * (1.0 / 479001600.0 + t2 * (-1.0 / 87178291200.0)))))));
  const int qi = ((int)q) & 3;
  const double cc = qi == 0 ? cs : qi == 1 ? -sn : qi == 2 ? -cs : sn;
  const double ss = qi == 0 ? sn : qi == 1 ? cs : qi == 2 ? -sn : -cs;
  c = (float)cc; s = (float)ss;
}
DI float2 angle_cs(float pos, float inv) {
  const float ang = __fmul_rn(pos, inv);
  double rev = (double)ang * 0.15915494309189535; rev -= floor(rev);
  float2 r; sincos_rev(rev, r.x, r.y); return r;
}
template <int MODE>
DI void wtrans(const float* __restrict__ W, int K, int N, int Npad, const float* __restrict__ gain, u16* __restrict__ Wt, int ldw, int gt, int gn) {
  const int total = (K / 8) * Npad;
  for (int idx = gt; idx < total; idx += gn) {
    const int n = idx % Npad, kc = idx / Npad;
    int src = n;
    if (MODE == 1) src = n < 384 ? n : (n < 2944 ? n + 32 : (n < 2976 ? n - 2944 + 384 : -1));
    u32x4 w;
#pragma unroll
    for (int j = 0; j < 4; ++j) {
      const int k = kc * 8 + 2 * j; float a = 0.f, b = 0.f;
      if (src >= 0) { a = W[(size_t)k * N + src]; b = W[(size_t)(k + 1) * N + src]; if (gain) { a *= gain[k]; b *= gain[k + 1]; } }
      w[j] = cvtpk(a, b);
    }
    *(u32x4*)(Wt + (size_t)n * ldw + kc * 8) = w;
  }
}
DI void phase0(const Params& p) {
  const int tid = my_tid(), gt = blockIdx.x * NTHR + tid, gn = gridDim.x * NTHR, wave = tid >> 6, lane = tid & 63;
  for (int i = gt; i < NTOK; i += gn) { p.ss1[i] = 0.f; p.sscq[i] = 0.f; p.ssckv[i] = 0.f; }
  for (int row = blockIdx.x * NWAVE + wave; row < NTOK; row += gridDim.x * NWAVE) {
    const float* xr = p.x + (size_t)row * DM; f32x4 v[4]; float ss = 0.f;
#pragma unroll
    for (int i = 0; i < 4; ++i) { v[i] = *(const f32x4*)(xr + i * 256 + lane * 4); ss += v[i][0] * v[i][0] + v[i][1] * v[i][1] + v[i][2] * v[i][2] + v[i][3] * v[i][3]; }
    ss = wave_sum(ss);
    if (lane == 0) p.rs0[row] = rsqrtf(ss * (1.f / DM) + EPS);
#pragma unroll
    for (int i = 0; i < 4; ++i) { u32x2 w; w.x = cvtpk(v[i][0], v[i][1]); w.y = cvtpk(v[i][2], v[i][3]); *(u32x2*)(p.xb + (size_t)row * LDX + i * 256 + lane * 4) = w; }
  }
  wtrans<0>(p.w_in_e, 1024, NE, NE, p.norm_e, p.wt_ine, LDX, gt, gn);
  wtrans<0>(p.w_out_e, 1024, 1024, 1024, nullptr, p.wt_oute, LDX, gt, gn);
  wtrans<1>(p.w_in_o, 1024, 2976, NO, p.norm_o, p.wt_ino, LDX, gt, gn);
  wtrans<0>(p.w_cq_b, 256, 768, 768, p.g_cq, p.wt_cq, 256, gt, gn);
  wtrans<0>(p.w_ckv_b, 128, 1024, 1024, p.g_ckv, p.wt_ckv, 128, gt, gn);
  wtrans<0>(p.w_out_o, 1024, 1024, 1024, nullptr, p.wt_outo, LDX, gt, gn);
  for (int idx = gt; idx < 4096 * 16; idx += gn) p.tab_mla[idx] = angle_cs((float)(idx >> 4), p.inv16[idx & 15]);
  for (int idx = gt; idx < 4096 * 8; idx += gn) p.tab_part[idx] = angle_cs((float)(idx >> 3), p.inv8[idx & 7]);
  for (int idx = gt; idx < 64 * 16; idx += gn) p.tab_ax[idx] = angle_cs((float)(idx >> 4), p.inv16[idx & 15]);
  if (blockIdx.x == 0 && wave == 0) {
    float a = wave_sum(p.lam_q1[lane] * p.lam_k1[lane]), b = wave_sum(p.lam_q2[lane] * p.lam_k2[lane]);
    if (lane == 0) p.lam[0] = expf(a) - expf(b) + LAM_INIT;
    if (lane == 0) __hip_atomic_store(p.bar, 0u, __ATOMIC_RELAXED, __HIP_MEMORY_SCOPE_AGENT);
    float gq = fabsf(p.gq_b[lane]), gk = fabsf(p.gk_b[lane]);
    float gcq = fmaxf(fabsf(p.gq_c[lane]), lane < 32 ? fabsf(p.gq_c[64 + lane]) : 0.f), gck = fmaxf(fabsf(p.gk_c[lane]), lane < 32 ? fabsf(p.gk_c[64 + lane]) : 0.f);
    float gdq = fabsf(p.gq_d[lane]), gdk = fabsf(p.gk_d[lane]);
#pragma unroll
    for (int s = 32; s >= 1; s >>= 1) { gq = fmaxf(gq, __shfl_xor(gq, s)); gk = fmaxf(gk, __shfl_xor(gk, s)); gcq = fmaxf(gcq, __shfl_xor(gcq, s)); gck = fmaxf(gck, __shfl_xor(gck, s));
      gdq = fmaxf(gdq, __shfl_xor(gdq, s)); gdk = fmaxf(gdk, __shfl_xor(gdk, s)); }
    if (lane == 0) { p.lam[1] = 8.f * gq * gk; p.lam[2] = 9.797958971132712f * gcq * gck; p.lam[3] = 8.f * gdq * gdk; }
  }
}

#define LAS3 __attribute__((address_space(3)))
DI void dma16(const void* g, char* lds_uniform) {
  __builtin_amdgcn_global_load_lds((const unsigned*)g, (LAS3 unsigned*)(LAS3 char*)lds_uniform, 16, 0, 0);
}
template <int WM, int WN, int MI, int NI>
DI void gemm_mainloop(const u16* __restrict__ A, const int lda, const u16* __restrict__ Bt, const int ldb, const int K, char* lds, f32x16 (&acc)[MI][NI]) {
  constexpr int BM = WM * MI * 32, BN = WN * NI * 32, BNS = (BN + 63) / 64 * 64, ACH = BM / 64, BCH = BNS / 64, ABYTES = BM * 128, BUF = (BM + BNS) * 128;
  const int tid = my_tid(), wave = __builtin_amdgcn_readfirstlane(tid >> 6), lane = tid & 63, r32 = lane & 31, hi = lane >> 5;
  const int wr = wave / WN, wc = wave % WN;
  const int srow = wave * 8 + (lane >> 3), spos = lane & 7, schunk = spos ^ ((srow >> 1) & 7);
  const u16* ag = A + (size_t)srow * lda + schunk * 8;
  const u16* bg = Bt + (size_t)srow * ldb + schunk * 8;
  const int sw = (r32 >> 1) & 7;
  const int abase = (wr * MI * 32 + r32) * 128, bbase = ABYTES + (wc * NI * 32 + r32) * 128;
#pragma unroll
  for (int mi = 0; mi < MI; ++mi)
#pragma unroll
    for (int ni = 0; ni < NI; ++ni)
#pragma unroll
      for (int r = 0; r < 16; ++r) acc[mi][ni][r] = 0.f;
#define G_DMA(BUFP, KT) do { _Pragma("unroll") for (int i = 0; i < ACH; ++i) dma16(ag + (size_t)i * 64 * lda + (KT) * 64, (BUFP) + i * 8192 + wave * 1024); \
    _Pragma("unroll") for (int i = 0; i < BCH; ++i) dma16(bg + (size_t)i * 64 * ldb + (KT) * 64, (BUFP) + ABYTES + i * 8192 + wave * 1024); } while (0)
#define G_COMPUTE(CUR) do { _Pragma("unroll") for (int kk = 0; kk < 4; ++kk) { const int xk = ((kk * 2 + hi) ^ sw) << 4; bf16x8 af[MI], bfr[NI]; \
    _Pragma("unroll") for (int mi = 0; mi < MI; ++mi) af[mi] = *(const bf16x8*)((CUR) + abase + mi * 4096 + xk); \
    _Pragma("unroll") for (int ni = 0; ni < NI; ++ni) bfr[ni] = *(const bf16x8*)((CUR) + bbase + ni * 4096 + xk); \
    _Pragma("unroll") for (int mi = 0; mi < MI; ++mi) _Pragma("unroll") for (int ni = 0; ni < NI; ++ni) acc[mi][ni] = MFMA32(bfr[ni], af[mi], acc[mi][ni]); } } while (0)
  const int nk = K >> 6;
  G_DMA(lds, 0);
  for (int kt = 0; kt < nk; ++kt) {
    asm volatile("s_waitcnt vmcnt(0)" ::: "memory");
    __syncthreads();
    char* cur = lds + (kt & 1) * BUF;
    if (kt + 1 < nk) G_DMA(lds + ((kt + 1) & 1) * BUF, kt + 1);
    G_COMPUTE(cur);
  }
  __syncthreads();
#undef G_DMA
#undef G_COMPUTE
}

DI void tile_of(int t, int NT, int& mt, int& nt) {
  const int xcd = t & 7, idx = t >> 3, g = idx / (8 * NT), rem = idx % (8 * NT);
  mt = xcd * 16 + g * 8 + (rem & 7); nt = rem >> 3;
}

DI void epi_in_e(const Params& p, f32x16& a00, f32x16& a01, f32x16& a10, f32x16& a11, int mrow0, int cb, int r32, int hi) {
  int type; const float* g = nullptr;
  if (cb < 512) { type = 1; g = p.gq_a; } else if (cb < 1024) { type = 1; g = p.gk_a; } else if (cb < 1536) type = 0;
  else if (cb < 2048) { type = 2; g = p.gq_b; } else if (cb < 2176) { type = 2; g = p.gk_b; } else if (cb < 2304) type = 0; else type = 3;
#pragma unroll
  for (int mi = 0; mi < 2; ++mi) {
    f32x16& r0 = mi ? a10 : a00; f32x16& r1 = mi ? a11 : a01;
    const int T = mrow0 + mi * 32 + r32; const float rs = p.rs0[T];
    f32x16 v0 = r0 * rs, v1 = r1 * rs;
    if (type == 1 || type == 2) {
      const float ss = half_sum(sumsq16(v0) + sumsq16(v1)); const float ri = rsqrtf(ss * (1.f / 64) + EPS);
      { f32x16 gg; load_blk_f32(g, hi, gg); v0 = v0 * ri * gg; load_blk_f32(g + 32, hi, gg); v1 = v1 * ri * gg; }
      if (type == 2) { const int t = T & 4095; rot16(v0, p.tab_ax + (t >> 6) * 16, hi); rot16(v1, p.tab_ax + (t & 63) * 16, hi); }
      if (cb >= 1536 && cb < 2048) { v0 = v0 * (0.125f * LOG2E); v1 = v1 * (0.125f * LOG2E); }
    } else if (type == 3) {
#pragma unroll
      for (int r = 0; r < 16; ++r) { v0[r] = silu(v0[r]); v1[r] = silu(v1[r]); }
    }
    r0 = v0; r1 = v1;
  }
}
DI void epi_in_o(const Params& p, f32x16& a00, f32x16& a01, f32x16& a10, f32x16& a11, int mrow0, int cb, int r32, int hi) {
  int type; const float* g = nullptr;
  if (cb < 256) type = 4; else if (cb < 384) type = 5; else if (cb < 896) { type = 2; g = p.gq_d; } else if (cb < 1408) { type = 2; g = p.gk_d; }
  else if (cb < 1920) type = 0; else if (cb < 2944) type = 3; else type = 0;
#pragma unroll
  for (int mi = 0; mi < 2; ++mi) {
    f32x16& r0 = mi ? a10 : a00; f32x16& r1 = mi ? a11 : a01;
    const int T = mrow0 + mi * 32 + r32; const float rs = rsqrtf(p.ss1[T] * (1.f / DM) + EPS);
    f32x16 v0 = r0 * rs, v1 = r1 * rs;
    if (type == 2) {
      const float ss = half_sum(sumsq16(v0) + sumsq16(v1)); const float ri = rsqrtf(ss * (1.f / 64) + EPS);
      { f32x16 gg; load_blk_f32(g, hi, gg); v0 = v0 * ri * gg; load_blk_f32(g + 32, hi, gg); v1 = v1 * ri * gg; }
      rot8(v0, p.tab_part + (T & 4095) * 8, hi);
      if (cb < 896) { v0 = v0 * (0.125f * LOG2E); v1 = v1 * (0.125f * LOG2E); }
    } else if (type == 3) {
#pragma unroll
      for (int r = 0; r < 16; ++r) { v0[r] = silu(v0[r]); v1[r] = silu(v1[r]); }
    } else if (type >= 4) {
      const float ss = half_sum(sumsq16(v0) + sumsq16(v1));
      if (hi == 0) atomicAdd((type == 4 ? p.sscq : p.ssckv) + T, ss);
    }
    r0 = v0; r1 = v1;
  }
}
DI void stage_out_bf16(f32x16 (&acc)[2][4], u16* dst, int ld, char* lds) {
  const int tid = my_tid(), wave = tid >> 6, lane = tid & 63, r32 = lane & 31, hi = lane >> 5, wr = wave >> 1, wc = wave & 1;
#pragma unroll
  for (int half = 0; half < 2; ++half) {
    if ((wr >> 1) == half) {
#pragma unroll
      for (int mi = 0; mi < 2; ++mi) {
        u16* rowp = (u16*)(lds + ((wr & 1) * 64 + mi * 32 + r32) * 520) + wc * 128;
#pragma unroll
        for (int ni = 0; ni < 4; ++ni) store_blk_bf16(rowp + 32 * ni, acc[mi][ni], hi);
      }
    }
    __syncthreads();
#pragma unroll
    for (int i = 0; i < 8; ++i) {
      const int c = tid + i * NTHR, row = c >> 5, ch = c & 31;
      const u32x2 a = *(const u32x2*)(lds + row * 520 + ch * 16), b = *(const u32x2*)(lds + row * 520 + ch * 16 + 8);
      u32x4 w; w.x = a.x; w.y = a.y; w.z = b.x; w.w = b.y;
      *(u32x4*)(dst + (size_t)(half * 128 + row) * ld + ch * 8) = w;
    }
    __syncthreads();
  }
}
template <bool FIRST>
DI void epi_out(const Params& p, f32x16 (&acc)[2][4], int m0, int n0, char* lds) {
  const float* res = FIRST ? p.x : p.out;
  const int tid = my_tid(), wave = tid >> 6, lane = tid & 63, r32 = lane & 31, hi = lane >> 5, wr = wave >> 1, wc = wave & 1;
#pragma unroll
  for (int mi = 0; mi < 2; ++mi)
#pragma unroll
    for (int half = 0; half < 2; ++half) {
      if ((wr >> 1) == half) {
        float* rowp = (float*)(lds + ((wr & 1) * 32 + r32) * 1040) + wc * 128;
#pragma unroll
        for (int ni = 0; ni < 4; ++ni)
#pragma unroll
          for (int q = 0; q < 4; ++q) { f32x4 v; v[0] = acc[mi][ni][4 * q]; v[1] = acc[mi][ni][4 * q + 1]; v[2] = acc[mi][ni][4 * q + 2]; v[3] = acc[mi][ni][4 * q + 3]; *(f32x4*)(rowp + 32 * ni + 8 * q + 4 * hi) = v; }
      }
      __syncthreads();
#pragma unroll
      for (int i = 0; i < 8; ++i) {
        const int c = tid + i * NTHR, row = c >> 6, ch = c & 63;
        const int T = m0 + half * 128 + (row >> 5) * 64 + mi * 32 + (row & 31);
        const size_t off = (size_t)T * DM + n0 + ch * 4;
        const f32x4 a = *(const f32x4*)(lds + row * 1040 + ch * 16), rv = *(const f32x4*)(res + off);
        f32x4 ov = a + rv;
        *(f32x4*)(p.out + off) = ov;
        if (FIRST) {
          float ss = ov[0] * ov[0] + ov[1] * ov[1] + ov[2] * ov[2] + ov[3] * ov[3];
          u32x2 w; w.x = cvtpk(ov[0], ov[1]); w.y = cvtpk(ov[2], ov[3]); *(u32x2*)(p.xb + (size_t)T * LDX + n0 + ch * 4) = w;
          ss = wave_sum(ss);
          if (ch == 0) atomicAdd(p.ss1 + T, ss);
        }
      }
      __syncthreads();
    }
}
template <int WHICH>
DI void gemm_phase(const Params& p, char* lds) {
  constexpr int NT = WHICH == 0 ? NE / 256 : WHICH == 2 ? NO / 256 : 4;
  const u16* A = (WHICH == 0 || WHICH == 2) ? p.xb : p.ob;
  const u16* Bt = WHICH == 0 ? p.wt_ine : WHICH == 1 ? p.wt_oute : WHICH == 2 ? p.wt_ino : p.wt_outo;
  const int wave = my_tid() >> 6, lane = my_tid() & 63, r32 = lane & 31, hi = lane >> 5, wr = wave >> 1, wc = wave & 1;
  for (int t = blockIdx.x; t < 128 * NT; t += gridDim.x) {
    int mt, nt; tile_of(t, NT, mt, nt);
    f32x16 acc[2][4];
    gemm_mainloop<4, 2, 2, 4>(A + (size_t)mt * 256 * LDX, LDX, Bt + (size_t)nt * 256 * LDX, LDX, DM, lds, acc);
    const int mrow0 = mt * 256 + wr * 64, cb = nt * 256 + wc * 128;
    if (WHICH == 0) {
      epi_in_e(p, acc[0][0], acc[0][1], acc[1][0], acc[1][1], mrow0, cb, r32, hi);
      epi_in_e(p, acc[0][2], acc[0][3], acc[1][2], acc[1][3], mrow0, cb + 64, r32, hi);
      stage_out_bf16(acc, p.proj + (size_t)mt * 256 * NE + nt * 256, NE, lds);
    } else if (WHICH == 2) {
      epi_in_o(p, acc[0][0], acc[0][1], acc[1][0], acc[1][1], mrow0, cb, r32, hi);
      epi_in_o(p, acc[0][2], acc[0][3], acc[1][2], acc[1][3], mrow0, cb + 64, r32, hi);
      stage_out_bf16(acc, p.proj + (size_t)mt * 256 * NO + nt * 256, NO, lds);
    } else if (WHICH == 1) epi_out<true>(p, acc, mt * 256, nt * 256, lds);
    else epi_out<false>(p, acc, mt * 256, nt * 256, lds);
  }
}
template <int NCH, int STR>
DI void copy_rows_bf16(const char* lds, u16* dst, int ld) {
  const int tid = my_tid();
#pragma unroll
  for (int i = 0; i < (256 * NCH) / NTHR; ++i) {
    const int c = tid + i * NTHR, row = c / NCH, ch = c % NCH;
    const u32x2 a = *(const u32x2*)(lds + row * STR + ch * 16), b = *(const u32x2*)(lds + row * STR + ch * 16 + 8);
    u32x4 w; w.x = a.x; w.y = a.y; w.z = b.x; w.w = b.y;
    *(u32x4*)(dst + (size_t)row * ld + ch * 8) = w;
  }
}
DI void upproj_phase(const Params& p, char* lds) {
  const int wave = my_tid() >> 6, lane = my_tid() & 63, r32 = lane & 31, hi = lane >> 5;
  for (int t = blockIdx.x; t < 128 * 8; t += gridDim.x) {
    int mt, hh; tile_of(t, 8, mt, hh);
    f32x16 acc[1][3];
    gemm_mainloop<8, 1, 1, 3>(p.proj + (size_t)mt * 256 * NO, NO, p.wt_cq + (size_t)hh * 96 * 256, 256, 256, lds, acc);
    const int T = mt * 256 + wave * 32 + r32;
    const float rcq = rsqrtf(p.sscq[T] * (1.f / 256) + EPS);
    f32x16 v0 = acc[0][0] * rcq, v1 = acc[0][1] * rcq, v2 = acc[0][2] * rcq;
    const float ss = half_sum(sumsq16(v0) + sumsq16(v1) + sumsq16(v2)); const float ri = rsqrtf(ss * (1.f / 96) + EPS);
    f32x16 g; load_blk_f32(p.gq_c, hi, g); v0 = v0 * ri * g; load_blk_f32(p.gq_c + 32, hi, g); v1 = v1 * ri * g; load_blk_f32(p.gq_c + 64, hi, g); v2 = v2 * ri * g;
    rot16(v2, p.tab_mla + (T & 4095) * 16, hi);
    { const float cs = 0.10206207261596575f * LOG2E; v0 = v0 * cs; v1 = v1 * cs; v2 = v2 * cs; }
    u16* rowp = (u16*)(lds + (wave * 32 + r32) * 200);
    store_blk_bf16(rowp, v0, hi); store_blk_bf16(rowp + 32, v1, hi); store_blk_bf16(rowp + 64, v2, hi);
    __syncthreads();
    copy_rows_bf16<12, 200>(lds, p.qc + (size_t)mt * 256 * 768 + hh * 96, 768);
    __syncthreads();
  }
  for (int t = blockIdx.x; t < 128 * 8; t += gridDim.x) {
    int mt, hh; tile_of(t, 8, mt, hh);
    f32x16 acc[1][4];
    gemm_mainloop<8, 1, 1, 4>(p.proj + (size_t)mt * 256 * NO + 256, NO, p.wt_ckv + (size_t)hh * 128 * 128, 128, 128, lds, acc);
    const int T = mt * 256 + wave * 32 + r32;
    const float rkv = rsqrtf(p.ssckv[T] * (1.f / 128) + EPS);
    f32x16 v0 = acc[0][0] * rkv, v1 = acc[0][1] * rkv, v2 = acc[0][2] * rkv, v3 = acc[0][3] * rkv, kp;
    load_blk_bf16(p.proj + (size_t)T * NO + 2944, hi, kp);
    const float ss = half_sum(sumsq16(v0) + sumsq16(v1) + sumsq16(kp)); const float ri = rsqrtf(ss * (1.f / 96) + EPS);
    f32x16 g; load_blk_f32(p.gk_c, hi, g); v0 = v0 * ri * g; load_blk_f32(p.gk_c + 32, hi, g); v1 = v1 * ri * g; load_blk_f32(p.gk_c + 64, hi, g); kp = kp * ri * g;
    rot16(kp, p.tab_mla + (T & 4095) * 16, hi);
    u16* rowp = (u16*)(lds + (wave * 32 + r32) * 200);
    store_blk_bf16(rowp, v0, hi); store_blk_bf16(rowp + 32, v1, hi); store_blk_bf16(rowp + 64, kp, hi);
    u16* vrow = (u16*)(lds + 51200 + (wave * 32 + r32) * 136);
    store_blk_bf16(vrow, v2, hi); store_blk_bf16(vrow + 32, v3, hi);
    __syncthreads();
    copy_rows_bf16<12, 200>(lds, p.kc + (size_t)mt * 256 * 768 + hh * 96, 768);
    copy_rows_bf16<8, 136>(lds + 51200, p.vc + (size_t)mt * 256 * 512 + hh * 64, 512);
    __syncthreads();
  }
}

template <int KS> DI int kswz(int row, int chunk) { return KS == 128 ? row * 128 + ((chunk ^ ((row >> 1) & 7)) << 4) : row * 256 + ((chunk ^ (row & 7)) << 4); }
template <int DV> DI int v_st(int k, int c) { constexpr int NCS = DV / 32; const int kk = k; return ((kk >> 3) * NCS + (c >> 5)) * 512 + ((kk & 7) * 32 + (c & 31)) * 2; }
DI int v_rd_base(int lane) { return ((lane & 3) << 3) | (((lane >> 2) & 3) << 6) | (((lane >> 4) & 1) << 5) | (((lane >> 5) & 1) << 8); }
template <int OFF> DI s16x4 tr_read(int vb) { s16x4 r; asm volatile("ds_read_b64_tr_b16 %0, %1 offset:%2" : "=&v"(r) : "v"(vb), "i"(OFF) : "memory"); return r; }

template <int DQK, int KS>
DI void qkt(f32x16& p0, f32x16& p1, const char* Ks, const bf16x8* qr, int r32, int hi) {
#pragma unroll
  for (int r = 0; r < 16; ++r) { p0[r] = 0.f; p1[r] = 0.f; }
#pragma unroll
  for (int d0 = 0; d0 < DQK / 16; ++d0) {
    const bf16x8 b0 = *(const bf16x8*)(Ks + kswz<KS>(r32, d0 * 2 + hi));
    const bf16x8 b1 = *(const bf16x8*)(Ks + kswz<KS>(32 + r32, d0 * 2 + hi));
    p0 = MFMA32(b0, qr[d0], p0); p1 = MFMA32(b1, qr[d0], p1);
  }
}
template <int DV, int D0>
DI void pv_one(f32x16& od, int vb, bf16x8 pa0, bf16x8 pa1, bf16x8 pa2, bf16x8 pa3) {
  constexpr int NCS = DV / 32;
#define VOFF(ks, half) (D0 * 512 + (2 * (ks) + (half)) * NCS * 512)
  const s16x4 l0 = tr_read<VOFF(0, 0)>(vb), h0 = tr_read<VOFF(0, 1)>(vb), l1 = tr_read<VOFF(1, 0)>(vb), h1 = tr_read<VOFF(1, 1)>(vb);
  const s16x4 l2 = tr_read<VOFF(2, 0)>(vb), h2 = tr_read<VOFF(2, 1)>(vb), l3 = tr_read<VOFF(3, 0)>(vb), h3 = tr_read<VOFF(3, 1)>(vb);
#undef VOFF
  asm volatile("s_waitcnt lgkmcnt(0)" ::: "memory"); SBAR();
#define PK(L, H) (bf16x8){L[0], L[1], L[2], L[3], H[0], H[1], H[2], H[3]}
  od = MFMA32(PK(l0, h0), pa0, od); od = MFMA32(PK(l1, h1), pa1, od); od = MFMA32(PK(l2, h2), pa2, od); od = MFMA32(PK(l3, h3), pa3, od);
#undef PK
}
template <int DV>
DI void pv_all(f32x16 (&o)[DV / 32], int vb, bf16x8 pa0, bf16x8 pa1, bf16x8 pa2, bf16x8 pa3) {
  pv_one<DV, 0>(o[0], vb, pa0, pa1, pa2, pa3); pv_one<DV, 1>(o[1], vb, pa0, pa1, pa2, pa3);
  if constexpr (DV == 128) { pv_one<DV, 2>(o[2], vb, pa0, pa1, pa2, pa3); pv_one<DV, 3>(o[3], vb, pa0, pa1, pa2, pa3); }
}
#define PK4(P, BASE, OUT) do { u32x4 w = {cvtpk(P[BASE + 0], P[BASE + 1]), cvtpk(P[BASE + 2], P[BASE + 3]), cvtpk(P[BASE + 4], P[BASE + 5]), cvtpk(P[BASE + 6], P[BASE + 7])}; \
    OUT = *reinterpret_cast<bf16x8*>(&w); } while (0)

template <int ND0>
DI void softmax_step(f32x16& t0, f32x16& t1, float& m, float& l, f32x16 (&o)[ND0], bf16x8& pa0, bf16x8& pa1, bf16x8& pa2, bf16x8& pa3) {
  float pmax = t0[0];
#pragma unroll
  for (int r = 1; r < 16; ++r) pmax = fmaxf(pmax, t0[r]);
#pragma unroll
  for (int r = 0; r < 16; ++r) pmax = fmaxf(pmax, t1[r]);
  pmax = half_max(pmax);
  const float mn = fmaxf(m, pmax);
  const float alpha = __builtin_amdgcn_exp2f(m - mn);
  m = mn;
#pragma unroll
  for (int r = 0; r < 16; ++r) { t0[r] = __builtin_amdgcn_exp2f(t0[r] - mn); t1[r] = __builtin_amdgcn_exp2f(t1[r] - mn); }
  float ps = 0.f;
#pragma unroll
  for (int r = 0; r < 16; ++r) ps += t0[r] + t1[r];
  ps = half_sum(ps);
  l = l * alpha + ps;
  if (__any(alpha < 1.f)) {
#pragma unroll
    for (int d = 0; d < ND0; ++d) o[d] = o[d] * alpha;
  }
  PK4(t0, 0, pa0); PK4(t0, 8, pa1); PK4(t1, 0, pa2); PK4(t1, 8, pa3);
}

template <int DQK, int DV>
DI void flash(const u16* __restrict__ Qlane, const u16* __restrict__ Kb, const int ldk, const u16* __restrict__ Vb, const int ldv,
              const float C, const float nMc, f32x16 (&o)[DV / 32], float& l_out, char* lds) {
  constexpr int KS = DQK == 64 ? 128 : 256, KCR = DQK / 8, NKC = (KCR + 7) / 8, VCR = DV / 8, NVC = VCR / 8, ND0 = DV / 32, NQ = DQK / 16;
  constexpr int KBYTES = 64 * KS, ABUF = KBYTES + 64 * DV * 2, NTILE = SEQ / 64;
  const int tid = my_tid(), lane = tid & 63, r32 = lane & 31, hi = lane >> 5;
  bf16x8 qr[NQ];
#pragma unroll
  for (int d0 = 0; d0 < NQ; ++d0) qr[d0] = *(const bf16x8*)(Qlane + d0 * 16);
  int kg[NKC], kl[NKC], vg[NVC], vl[NVC];
#pragma unroll
  for (int i = 0; i < NKC; ++i) { const int c = min(tid + i * NTHR, 64 * KCR - 1), row = c / KCR, cc = c % KCR; kg[i] = row * ldk + cc * 8; kl[i] = kswz<KS>(row, cc); }
#pragma unroll
  for (int i = 0; i < NVC; ++i) { const int c = tid + i * NTHR, key = c / VCR, c8 = c % VCR; vg[i] = key * ldv + c8 * 8; vl[i] = KBYTES + v_st<DV>(key, c8 * 8); }
  const int vb0 = (int)(uintptr_t)lds + KBYTES + v_rd_base(lane);
  float lsum = 0.f;
#pragma unroll
  for (int d = 0; d < ND0; ++d)
#pragma unroll
    for (int r = 0; r < 16; ++r) o[d][r] = 0.f;
  bf16x8 ks[NKC], vs[NVC];
#pragma unroll
  for (int i = 0; i < NKC; ++i) ks[i] = *(const bf16x8*)(Kb + kg[i]);
#pragma unroll
  for (int i = 0; i < NVC; ++i) vs[i] = *(const bf16x8*)(Vb + vg[i]);
#pragma unroll
  for (int i = 0; i < NKC; ++i) *(bf16x8*)(lds + kl[i]) = ks[i];
#pragma unroll
  for (int i = 0; i < NVC; ++i) *(bf16x8*)(lds + vl[i]) = vs[i];
  __syncthreads();
  for (int j = 0; j < NTILE; ++j) {
    const int cur = j & 1;
    if (j + 1 < NTILE) {
      const u16* kn = Kb + (size_t)(j + 1) * 64 * ldk; const u16* vn = Vb + (size_t)(j + 1) * 64 * ldv;
#pragma unroll
      for (int i = 0; i < NKC; ++i) ks[i] = *(const bf16x8*)(kn + kg[i]);
#pragma unroll
      for (int i = 0; i < NVC; ++i) vs[i] = *(const bf16x8*)(vn + vg[i]);
    }
    f32x16 p0, p1; bf16x8 pa0, pa1, pa2, pa3;
    qkt<DQK, KS>(p0, p1, lds + cur * ABUF, qr, r32, hi);
#pragma unroll
    for (int r = 0; r < 16; ++r) { p0[r] = __builtin_amdgcn_exp2f(p0[r]); p1[r] = __builtin_amdgcn_exp2f(p1[r]); }
    { const f32x16 s_ = p0 + p1; lsum += ((s_[0] + s_[1]) + (s_[2] + s_[3])) + ((s_[4] + s_[5]) + (s_[6] + s_[7])) + ((s_[8] + s_[9]) + (s_[10] + s_[11])) + ((s_[12] + s_[13]) + (s_[14] + s_[15])); }
    PK4(p0, 0, pa0); PK4(p0, 8, pa1); PK4(p1, 0, pa2); PK4(p1, 8, pa3);
    pv_all<DV>(o, vb0 + cur * ABUF, pa0, pa1, pa2, pa3);
    if (j + 1 < NTILE) {
      char* nb = lds + (cur ^ 1) * ABUF;
#pragma unroll
      for (int i = 0; i < NKC; ++i) *(bf16x8*)(nb + kl[i]) = ks[i];
#pragma unroll
      for (int i = 0; i < NVC; ++i) *(bf16x8*)(nb + vl[i]) = vs[i];
    }
    __syncthreads();
  }
  l_out = half_sum(lsum);
}

template <int DQK, int DV>
DI void flash_pipe_v1(const u16* __restrict__ Qlane, const u16* __restrict__ Kb, const int ldk, const u16* __restrict__ Vb, const int ldv,
                   const float C, const float nMc, f32x16 (&o)[DV / 32], float& l_out, char* lds) {
  constexpr int KS = DQK == 64 ? 128 : 256, KCR = DQK / 8, NKC = (KCR + 7) / 8, VCR = DV / 8, NVC = VCR / 8, ND0 = DV / 32, NQ = DQK / 16;
  constexpr int KBYTES = 64 * KS, VBYTES = 64 * DV * 2, VOFF0 = 2 * KBYTES, NTILE = SEQ / 64;
  const int tid = my_tid(), lane = tid & 63, r32 = lane & 31, hi = lane >> 5;
  bf16x8 qr[NQ];
#pragma unroll
  for (int d0 = 0; d0 < NQ; ++d0) qr[d0] = *(const bf16x8*)(Qlane + d0 * 16);
  int kg[NKC], kl[NKC], vg[NVC], vl[NVC];
#pragma unroll
  for (int i = 0; i < NKC; ++i) { const int c = min(tid + i * NTHR, 64 * KCR - 1), row = c / KCR, cc = c % KCR; kg[i] = row * ldk + cc * 8; kl[i] = kswz<KS>(row, cc); }
#pragma unroll
  for (int i = 0; i < NVC; ++i) { const int c = tid + i * NTHR, key = c / VCR, c8 = c % VCR; vg[i] = key * ldv + c8 * 8; vl[i] = VOFF0 + v_st<DV>(key, c8 * 8); }
  const int vb0 = (int)(uintptr_t)lds + VOFF0 + v_rd_base(lane);
  float l = 0.f;
#pragma unroll
  for (int d = 0; d < ND0; ++d)
#pragma unroll
    for (int r = 0; r < 16; ++r) o[d][r] = 0.f;
  bf16x8 ks[NKC], vs[NVC];
#define FP_LOADK(J) do { const u16* kn = Kb + (size_t)(J) * 64 * ldk; _Pragma("unroll") for (int i = 0; i < NKC; ++i) ks[i] = *(const bf16x8*)(kn + kg[i]); } while (0)
#define FP_LOADV(J) do { const u16* vn = Vb + (size_t)(J) * 64 * ldv; _Pragma("unroll") for (int i = 0; i < NVC; ++i) vs[i] = *(const bf16x8*)(vn + vg[i]); } while (0)
#define FP_WRITEK(B) do { _Pragma("unroll") for (int i = 0; i < NKC; ++i) *(bf16x8*)(lds + (B) * KBYTES + kl[i]) = ks[i]; } while (0)
#define FP_WRITEV(B) do { _Pragma("unroll") for (int i = 0; i < NVC; ++i) *(bf16x8*)(lds + (B) * VBYTES + vl[i]) = vs[i]; } while (0)
#define FP_PARTIAL(P0) do { _Pragma("unroll") for (int r = 0; r < 16; ++r) P0[r] = __builtin_amdgcn_exp2f(P0[r]); } while (0)
#define FP_FINISH(P0, P1) do { _Pragma("unroll") for (int r = 0; r < 16; ++r) P1[r] = __builtin_amdgcn_exp2f(P1[r]); \
    { const f32x16 s_ = P0 + P1; lsum += ((s_[0] + s_[1]) + (s_[2] + s_[3])) + ((s_[4] + s_[5]) + (s_[6] + s_[7])) + ((s_[8] + s_[9]) + (s_[10] + s_[11])) + ((s_[12] + s_[13]) + (s_[14] + s_[15])); } \
    PK4(P0, 0, pa0); PK4(P0, 8, pa1); PK4(P1, 0, pa2); PK4(P1, 8, pa3); } while (0)
#define FP_STEP(PX0, PX1, PY0, PY1, JJ) do { \
    SBAR(); \
    if ((JJ) + 1 < NTILE) qkt<DQK, KS>(PY0, PY1, lds + (((JJ) + 1) & 1) * KBYTES, qr, r32, hi); \
    FP_FINISH(PX0, PX1); \
    SBAR(); \
    if ((JJ) + 2 < NTILE) FP_LOADK((JJ) + 2); \
    if ((JJ) + 1 < NTILE) FP_LOADV((JJ) + 1); \
    SBAR(); \
    pv_all<DV>(o, vb0 + ((JJ) & 1) * VBYTES, pa0, pa1, pa2, pa3); \
    if ((JJ) + 1 < NTILE) FP_PARTIAL(PY0); \
    SBAR(); \
    if ((JJ) + 2 < NTILE) FP_WRITEK((JJ) & 1); \
    if ((JJ) + 1 < NTILE) FP_WRITEV(((JJ) + 1) & 1); \
    __syncthreads(); } while (0)
  f32x16 pA0, pA1, pB0, pB1; bf16x8 pa0, pa1, pa2, pa3;
  float lsum = 0.f;
  FP_LOADK(0); FP_LOADV(0); FP_WRITEK(0); FP_WRITEV(0); FP_LOADK(1); FP_WRITEK(1);
  __syncthreads();
  qkt<DQK, KS>(pA0, pA1, lds, qr, r32, hi);
  FP_PARTIAL(pA0);
  __syncthreads();
  for (int j = 0; j < NTILE; j += 2) {
    FP_STEP(pA0, pA1, pB0, pB1, j);
    FP_STEP(pB0, pB1, pA0, pA1, j + 1);
  }
#undef FP_LOADK
#undef FP_LOADV
#undef FP_WRITEK
#undef FP_WRITEV
#undef FP_PARTIAL
#undef FP_FINISH
#undef FP_STEP
  l_out = half_sum(lsum);
}

template <int DQK, int DV, bool DEEP>
DI void flash_pipe(const u16* __restrict__ Qlane, const u16* __restrict__ Kb, const int ldk, const u16* __restrict__ Vb, const int ldv,
                   f32x16 (&o)[DV / 32], float& l_out, char* lds) {
  constexpr int KS = DQK == 64 ? 128 : 256, KCR = DQK / 8, NKC = (KCR + 7) / 8, VCR = DV / 8, NVC = VCR / 8, ND0 = DV / 32, NQ = DQK / 16;
  constexpr int KBYTES = 64 * KS, VBYTES = 64 * DV * 2, VOFF0 = 2 * KBYTES, NTILE = SEQ / 64;
  const int tid = my_tid(), lane = tid & 63, r32 = lane & 31, hi = lane >> 5;
  bf16x8 qr[NQ];
#pragma unroll
  for (int d0 = 0; d0 < NQ; ++d0) qr[d0] = *(const bf16x8*)(Qlane + d0 * 16);
  int kg[NKC], kl[NKC], vg[NVC], vl[NVC];
#pragma unroll
  for (int i = 0; i < NKC; ++i) { const int c = min(tid + i * NTHR, 64 * KCR - 1), row = c / KCR, cc = c % KCR; kg[i] = row * ldk + cc * 8; kl[i] = kswz<KS>(row, cc); }
#pragma unroll
  for (int i = 0; i < NVC; ++i) { const int c = tid + i * NTHR, key = c / VCR, c8 = c % VCR; vg[i] = key * ldv + c8 * 8; vl[i] = VOFF0 + v_st<DV>(key, c8 * 8); }
  const int vb0 = (int)(uintptr_t)lds + VOFF0 + v_rd_base(lane);
#pragma unroll
  for (int d = 0; d < ND0; ++d)
#pragma unroll
    for (int r = 0; r < 16; ++r) o[d][r] = 0.f;
  bf16x8 ksA[NKC], vsA[NVC], ksB[NKC], vsB[NVC];
#define FP_LOADK(KSR, J) do { const u16* kn = Kb + (size_t)(J) * 64 * ldk; _Pragma("unroll") for (int i = 0; i < NKC; ++i) KSR[i] = *(const bf16x8*)(kn + kg[i]); } while (0)
#define FP_LOADV(VSR, J) do { const u16* vn = Vb + (size_t)(J) * 64 * ldv; _Pragma("unroll") for (int i = 0; i < NVC; ++i) VSR[i] = *(const bf16x8*)(vn + vg[i]); } while (0)
#define FP_WRITEK(KSR, B) do { _Pragma("unroll") for (int i = 0; i < NKC; ++i) *(bf16x8*)(lds + (B) * KBYTES + kl[i]) = KSR[i]; } while (0)
#define FP_WRITEV(VSR, B) do { _Pragma("unroll") for (int i = 0; i < NVC; ++i) *(bf16x8*)(lds + (B) * VBYTES + vl[i]) = VSR[i]; } while (0)
#define FP_PARTIAL(P0) do { _Pragma("unroll") for (int r = 0; r < 16; ++r) P0[r] = __builtin_amdgcn_exp2f(P0[r]); } while (0)
#define FP_FINISH(P0, P1) do { _Pragma("unroll") for (int r = 0; r < 16; ++r) P1[r] = __builtin_amdgcn_exp2f(P1[r]); \
    { const f32x16 s_ = P0 + P1; lsum += ((s_[0] + s_[1]) + (s_[2] + s_[3])) + ((s_[4] + s_[5]) + (s_[6] + s_[7])) + ((s_[8] + s_[9]) + (s_[10] + s_[11])) + ((s_[12] + s_[13]) + (s_[14] + s_[15])); } \
    PK4(P0, 0, pa0); PK4(P0, 8, pa1); PK4(P1, 0, pa2); PK4(P1, 8, pa3); } while (0)
#define FP_STEP(PX0, PX1, PY0, PY1, KX, VX, KY, VY, JJ) do { \
    SBAR(); \
    if (DEEP) { if ((JJ) + 3 < NTILE) FP_LOADK(KY, (JJ) + 3); if ((JJ) + 2 < NTILE) FP_LOADV(VY, (JJ) + 2); } \
    SBAR(); \
    if ((JJ) + 1 < NTILE) qkt<DQK, KS>(PY0, PY1, lds + (((JJ) + 1) & 1) * KBYTES, qr, r32, hi); \
    FP_FINISH(PX0, PX1); \
    SBAR(); \
    if (!DEEP) { if ((JJ) + 2 < NTILE) FP_LOADK(KX, (JJ) + 2); if ((JJ) + 1 < NTILE) FP_LOADV(VX, (JJ) + 1); } \
    SBAR(); \
    pv_all<DV>(o, vb0 + ((JJ) & 1) * VBYTES, pa0, pa1, pa2, pa3); \
    if ((JJ) + 1 < NTILE) FP_PARTIAL(PY0); \
    SBAR(); \
    if ((JJ) + 2 < NTILE) FP_WRITEK(KX, (JJ) & 1); \
    if ((JJ) + 1 < NTILE) FP_WRITEV(VX, ((JJ) + 1) & 1); \
    __syncthreads(); } while (0)
  f32x16 pA0, pA1, pB0, pB1; bf16x8 pa0, pa1, pa2, pa3;
  float lsum = 0.f;
  FP_LOADK(ksA, 0); FP_LOADV(vsA, 0); FP_LOADK(ksB, 1);
  FP_WRITEK(ksA, 0); FP_WRITEV(vsA, 0); FP_WRITEK(ksB, 1);
  if (DEEP) { FP_LOADK(ksA, 2); FP_LOADV(vsA, 1); }
  __syncthreads();
  qkt<DQK, KS>(pA0, pA1, lds, qr, r32, hi);
  FP_PARTIAL(pA0);
  __syncthreads();
  for (int j = 0; j < NTILE; j += 2) {
    FP_STEP(pA0, pA1, pB0, pB1, ksA, vsA, ksB, vsB, j);
    FP_STEP(pB0, pB1, pA0, pA1, ksB, vsB, ksA, vsA, j + 1);
  }
#undef FP_LOADK
#undef FP_LOADV
#undef FP_WRITEK
#undef FP_WRITEV
#undef FP_PARTIAL
#undef FP_FINISH
#undef FP_STEP
  l_out = half_sum(lsum);
}

template <int DQK>
DI void flash_p2(const u16* __restrict__ Qlane, const u16* __restrict__ Kb, const int ldk, const u16* __restrict__ Vb, const int ldv,
                 f32x16 (&o)[2], float& l_out, char* lds) {
  constexpr int KS = DQK == 64 ? 128 : 256, KCR = DQK / 8, NKC = KCR / 4, NVC = 2, NQ = DQK / 16;
  constexpr int KST = 128 * KS, VST = 16384, VOFF0 = 3 * KST, NPAIR = SEQ / 128;
  const int tid = my_tid(), lane = tid & 63, r32 = lane & 31, hi = lane >> 5;
  bf16x8 qr[NQ];
#pragma unroll
  for (int d0 = 0; d0 < NQ; ++d0) qr[d0] = *(const bf16x8*)(Qlane + d0 * 16);
  int kg[NKC], kl[NKC], vg[NVC], vl[NVC];
#pragma unroll
  for (int i = 0; i < NKC; ++i) { const int c = tid + i * NTHR, row = c / KCR, cc = c % KCR; kg[i] = row * ldk + cc * 8; kl[i] = kswz<KS>(row, cc); }
#pragma unroll
  for (int i = 0; i < NVC; ++i) { const int c = tid + i * NTHR, key = c >> 3, c8 = c & 7; vg[i] = key * ldv + c8 * 8; vl[i] = VOFF0 + (key >> 6) * 8192 + v_st<64>(key & 63, c8 * 8); }
  const int vb0 = (int)(uintptr_t)lds + VOFF0 + v_rd_base(lane);
#pragma unroll
  for (int d = 0; d < 2; ++d)
#pragma unroll
    for (int r = 0; r < 16; ++r) o[d][r] = 0.f;
  bf16x8 ks[NKC], vs[NVC];
#define P2_LOADK(M) do { const u16* kn = Kb + (size_t)(M) * 128 * ldk; _Pragma("unroll") for (int i = 0; i < NKC; ++i) ks[i] = *(const bf16x8*)(kn + kg[i]); } while (0)
#define P2_LOADV(M) do { const u16* vn = Vb + (size_t)(M) * 128 * ldv; _Pragma("unroll") for (int i = 0; i < NVC; ++i) vs[i] = *(const bf16x8*)(vn + vg[i]); } while (0)
#define P2_WRITEK(OFF) do { _Pragma("unroll") for (int i = 0; i < NKC; ++i) *(bf16x8*)(lds + (OFF) + kl[i]) = ks[i]; } while (0)
#define P2_WRITEV(S) do { _Pragma("unroll") for (int i = 0; i < NVC; ++i) *(bf16x8*)(lds + (S) * VST + vl[i]) = vs[i]; } while (0)
#define P2_PARTIAL(P0) do { _Pragma("unroll") for (int r = 0; r < 16; ++r) P0[r] = __builtin_amdgcn_exp2f(P0[r]); } while (0)
#define P2_FINISH(P0, P1) do { _Pragma("unroll") for (int r = 0; r < 16; ++r) P1[r] = __builtin_amdgcn_exp2f(P1[r]); \
    { const f32x16 s_ = P0 + P1; lsum += ((s_[0] + s_[1]) + (s_[2] + s_[3])) + ((s_[4] + s_[5]) + (s_[6] + s_[7])) + ((s_[8] + s_[9]) + (s_[10] + s_[11])) + ((s_[12] + s_[13]) + (s_[14] + s_[15])); } \
    PK4(P0, 0, pa0); PK4(P0, 8, pa1); PK4(P1, 0, pa2); PK4(P1, 8, pa3); } while (0)
  f32x16 pA0, pA1, pB0, pB1; bf16x8 pa0, pa1, pa2, pa3;
  float lsum = 0.f;
  P2_LOADK(0); P2_WRITEK(0); P2_LOADK(1); P2_WRITEK(KST); P2_LOADV(0); P2_WRITEV(0);
  __syncthreads();
  qkt<DQK, KS>(pA0, pA1, lds, qr, r32, hi);
  P2_PARTIAL(pA0);
  __syncthreads();
  int k0 = 0, k1 = KST, k2 = 2 * KST;
  for (int m = 0; m < NPAIR; ++m) {
    const int s = m & 1;
    SBAR();
    if (m + 2 < NPAIR) P2_LOADK(m + 2);
    if (m + 1 < NPAIR) P2_LOADV(m + 1);
    SBAR();
    qkt<DQK, KS>(pB0, pB1, lds + k0 + 64 * KS, qr, r32, hi);
    P2_FINISH(pA0, pA1);
    SBAR();
    pv_all<64>(o, vb0 + s * VST, pa0, pa1, pa2, pa3);
    P2_PARTIAL(pB0);
    SBAR();
    if (m + 1 < NPAIR) qkt<DQK, KS>(pA0, pA1, lds + k1, qr, r32, hi);
    P2_FINISH(pB0, pB1);
    SBAR();
    pv_all<64>(o, vb0 + s * VST + 8192, pa0, pa1, pa2, pa3);
    if (m + 1 < NPAIR) P2_PARTIAL(pA0);
    SBAR();
    if (m + 2 < NPAIR) P2_WRITEK(k2);
    { const int t_ = k0; k0 = k1; k1 = k2; k2 = t_; }
    if (m + 1 < NPAIR) P2_WRITEV(s ^ 1);
    __syncthreads();
  }
#undef P2_LOADK
#undef P2_LOADV
#undef P2_WRITEK
#undef P2_WRITEV
#undef P2_PARTIAL
#undef P2_FINISH
  l_out = half_sum(lsum);
}

template <int ND0>
DI void store_gated(const f32x16 (&o)[ND0], const u16* gp, u16* op, int hi) {
#pragma unroll
  for (int d = 0; d < ND0; ++d) { f32x16 g; load_blk_bf16(gp + 32 * d, hi, g); f32x16 v = o[d] * g; store_blk_bf16(op + 32 * d, v, hi); }
}

template <int DV>
DI void store_gated_staged(const f32x16 (&o)[DV / 32], const u16* __restrict__ gate0, const int ldg, u16* __restrict__ out0, char* lds) {
  constexpr int STR = DV * 4 + 16, NCH = DV / 8;
  const int tid = my_tid(), wave = tid >> 6, lane = tid & 63, r32 = lane & 31, hi = lane >> 5;
  char* rowp = lds + (wave * 32 + r32) * STR;
#pragma unroll
  for (int d = 0; d < DV / 32; ++d)
#pragma unroll
    for (int q = 0; q < 4; ++q) { f32x4 v; v[0] = o[d][4 * q]; v[1] = o[d][4 * q + 1]; v[2] = o[d][4 * q + 2]; v[3] = o[d][4 * q + 3]; *(f32x4*)(rowp + (32 * d + 8 * q + 4 * hi) * 4) = v; }
  __syncthreads();
#pragma unroll
  for (int i = 0; i < (256 * NCH) / NTHR; ++i) {
    const int c = tid + i * NTHR, row = c / NCH, ch = c % NCH;
    const f32x4 a = *(const f32x4*)(lds + row * STR + ch * 32), b = *(const f32x4*)(lds + row * STR + ch * 32 + 16);
    const u32x4 g = *(const u32x4*)(gate0 + (size_t)row * ldg + ch * 8);
    u32x4 w;
    w.x = cvtpk(a[0] * bflo(g.x), a[1] * bfhi(g.x)); w.y = cvtpk(a[2] * bflo(g.y), a[3] * bfhi(g.y));
    w.z = cvtpk(b[0] * bflo(g.z), b[1] * bfhi(g.z)); w.w = cvtpk(b[2] * bflo(g.w), b[3] * bfhi(g.w));
    *(u32x4*)(out0 + (size_t)row * LDX + ch * 8) = w;
  }
  __syncthreads();
}

DI void na_item(const Params& p, int b, int h, int rp, char* lds) {
  constexpr int KBYTES = 8192, ABUF = 16384;
  const int tid = my_tid(), wave = tid >> 6, lane = tid & 63, r32 = lane & 31, hi = lane >> 5;
  float* tbl = (float*)(lds + 2 * ABUF);
  for (int i = tid; i < 465; i += NTHR) tbl[i] = p.rpb_a[h * 465 + i] * LOG2E;
  const int gr = 4 * rp + (wave >> 1), cq = (wave & 1) * 32 + r32;
  const int r0w = min(max(gr - 4, 0), 56), ra = min(max(4 * rp - 4, 0), 56), rb = min(max(4 * rp - 1, 0), 56) + 8;
  const int c0 = min(max(cq - 8, 0), 48);
  const size_t tb = (size_t)b * SEQ;
  const u16* Qlane = p.proj + (tb + gr * 64 + cq) * NE + h * 64 + hi * 8;
  const u16* Kb = p.proj + tb * NE + 512 + h * 64; const u16* Vb = p.proj + tb * NE + 1024 + h * 64;
  bf16x8 qr[4];
#pragma unroll
  for (int d0 = 0; d0 < 4; ++d0) qr[d0] = *(const bf16x8*)(Qlane + d0 * 16);
  int kg[1], kl[1], vl[1];
#pragma unroll
  for (int i = 0; i < 1; ++i) { const int c = tid, row = c >> 3, cc = c & 7; kg[i] = row * NE + cc * 8; kl[i] = kswz<128>(row, cc); vl[i] = KBYTES + v_st<64>(row, cc * 8); }
  const int vb0 = (int)(uintptr_t)lds + KBYTES + v_rd_base(lane);
  float m = -1e30f, l = 0.f; f32x16 o[2];
#pragma unroll
  for (int d = 0; d < 2; ++d)
#pragma unroll
    for (int r = 0; r < 16; ++r) o[d][r] = 0.f;
  bf16x8 ks[1], vs[1];
  {
    const u16* kn = Kb + (size_t)ra * 64 * NE; const u16* vn = Vb + (size_t)ra * 64 * NE;
#pragma unroll
    for (int i = 0; i < 1; ++i) { ks[i] = *(const bf16x8*)(kn + kg[i]); vs[i] = *(const bf16x8*)(vn + kg[i]); }
#pragma unroll
    for (int i = 0; i < 1; ++i) { *(bf16x8*)(lds + kl[i]) = ks[i]; *(bf16x8*)(lds + vl[i]) = vs[i]; }
  }
  __syncthreads();
  const float C = 0.125f * LOG2E;
  const int nt = rb - ra;
  for (int j = 0; j < nt; ++j) {
    const int cur = j & 1, kr = ra + j;
    if (j + 1 < nt) {
      const u16* kn = Kb + (size_t)(kr + 1) * 64 * NE; const u16* vn = Vb + (size_t)(kr + 1) * 64 * NE;
#pragma unroll
      for (int i = 0; i < 1; ++i) { ks[i] = *(const bf16x8*)(kn + kg[i]); vs[i] = *(const bf16x8*)(vn + kg[i]); }
    }
    if (kr >= r0w && kr < r0w + 8) {
      f32x16 p0, p1; bf16x8 pa0, pa1, pa2, pa3;
      qkt<64, 128>(p0, p1, lds + cur * ABUF, qr, r32, hi);
      const int rowoff = (kr - gr + 7) * 31 + 15 - cq;
#pragma unroll
      for (int r = 0; r < 16; ++r) {
        const int kc = crow(r, hi);
        const float b0 = tbl[rowoff + kc], b1 = tbl[rowoff + kc + 32];
        p0[r] = ((unsigned)(kc - c0) < 16u) ? fmaf(p0[r], C, b0) : -1e30f;
        p1[r] = ((unsigned)(kc + 32 - c0) < 16u) ? fmaf(p1[r], C, b1) : -1e30f;
      }
      softmax_step<2>(p0, p1, m, l, o, pa0, pa1, pa2, pa3);
      pv_all<64>(o, vb0 + cur * ABUF, pa0, pa1, pa2, pa3);
    }
    if (j + 1 < nt) {
      char* nb = lds + (cur ^ 1) * ABUF;
#pragma unroll
      for (int i = 0; i < 1; ++i) { *(bf16x8*)(nb + kl[i]) = ks[i]; *(bf16x8*)(nb + vl[i]) = vs[i]; }
    }
    __syncthreads();
  }
  const float inv = 1.f / l;
  o[0] = o[0] * inv; o[1] = o[1] * inv;
  const size_t T = tb + gr * 64 + cq;
  { const size_t T0 = tb + (size_t)rp * 256; store_gated_staged<64>(o, p.proj + T0 * NE + 2304 + h * 64, NE, p.ob + T0 * LDX + h * 64, lds); }
}

DI void attn_phase_even(const Params& p, char* lds) {
  const int wave = my_tid() >> 6, lane = my_tid() & 63, r32 = lane & 31, hi = lane >> 5;
  for (int t = blockIdx.x; t < 1024; t += gridDim.x) { const int b = t & 7, idx = t >> 3; na_item(p, b, idx >> 4, idx & 15, lds); }
  for (int t = blockIdx.x; t < 1024; t += gridDim.x) {
    const int b = t & 7, idx = t >> 3, h = idx >> 4, qb = idx & 15, kvh = h >> 2;
    const size_t tb = (size_t)b * SEQ, T = tb + qb * 256 + wave * 32 + r32;
    f32x16 o[2]; float l;
    flash_p2<64>(p.proj + T * NE + 1536 + h * 64 + hi * 8, p.proj + tb * NE + 2048 + kvh * 64, NE, p.proj + tb * NE + 2176 + kvh * 64, NE, o, l, lds);
    const float inv = 1.f / l; o[0] = o[0] * inv; o[1] = o[1] * inv;
    { const size_t T0 = tb + (size_t)qb * 256; store_gated_staged<64>(o, p.proj + T0 * NE + 2304 + 512 + h * 64, NE, p.ob + T0 * LDX + 512 + h * 64, lds); }
  }
}
DI void attn_phase_odd(const Params& p, char* lds) {
  const int wave = my_tid() >> 6, lane = my_tid() & 63, r32 = lane & 31, hi = lane >> 5;
  for (int t = blockIdx.x; t < 1024; t += gridDim.x) {
    const int b = t & 7, idx = t >> 3, h = idx >> 4, qb = idx & 15;
    const size_t tb = (size_t)b * SEQ, T = tb + qb * 256 + wave * 32 + r32;
    f32x16 o[2]; float l;
    flash_p2<96>(p.qc + T * 768 + h * 96 + hi * 8, p.kc + tb * 768 + h * 96, 768, p.vc + tb * 512 + h * 64, 512, o, l, lds);
    const float inv = 1.f / l; o[0] = o[0] * inv; o[1] = o[1] * inv;
    { const size_t T0 = tb + (size_t)qb * 256; store_gated_staged<64>(o, p.proj + T0 * NO + 1920 + h * 64, NO, p.ob + T0 * LDX + h * 64, lds); }
  }
  const float lam = p.lam[0], nMd = -p.lam[3] * LOG2E;
  for (int t = blockIdx.x; t < 512; t += gridDim.x) {
    const int b = t & 7, idx = t >> 3, h = idx >> 4, qb = idx & 15;
    const size_t tb = (size_t)b * SEQ, T = tb + qb * 256 + wave * 32 + r32;
    f32x16 o1[4]; float l1, l2;
    const u16* vb = p.proj + tb * NO + 1408 + h * 128;
    float* stash = (float*)p.xb + (size_t)blockIdx.x * 32768 + my_tid() * 64;
    flash<64, 128>(p.proj + T * NO + 384 + h * 128 + hi * 8, p.proj + tb * NO + 896 + h * 128, NO, vb, NO, 0.125f * LOG2E, nMd, o1, l1, lds);
    { const float inv = 1.f / l1;
#pragma unroll
      for (int d = 0; d < 4; ++d)
#pragma unroll
        for (int q = 0; q < 4; ++q) { f32x4 v; v[0] = o1[d][4 * q] * inv; v[1] = o1[d][4 * q + 1] * inv; v[2] = o1[d][4 * q + 2] * inv; v[3] = o1[d][4 * q + 3] * inv; *(f32x4*)(stash + (d * 4 + q) * 4) = v; } }
    flash<64, 128>(p.proj + T * NO + 384 + h * 128 + 64 + hi * 8, p.proj + tb * NO + 896 + h * 128 + 64, NO, vb, NO, 0.125f * LOG2E, nMd, o1, l2, lds);
    const float f = lam / l2; float ss = 0.f;
#pragma unroll
    for (int d = 0; d < 4; ++d) {
#pragma unroll
      for (int q = 0; q < 4; ++q) { const f32x4 v = *(const f32x4*)(stash + (d * 4 + q) * 4);
#pragma unroll
        for (int j = 0; j < 4; ++j) o1[d][4 * q + j] = v[j] - o1[d][4 * q + j] * f; }
      ss += sumsq16(o1[d]);
    }
    ss = half_sum(ss);
    const float ri = rsqrtf(ss * (1.f / 128) + EPS) * (1.f - LAM_INIT);
#pragma unroll
    for (int d = 0; d < 4; ++d) { f32x16 g; load_blk_f32(p.g_sub_d + 32 * d, hi, g); o1[d] = o1[d] * ri * g; }
    { const size_t T0 = tb + (size_t)qb * 256; store_gated_staged<128>(o1, p.proj + T0 * NO + 1920 + 512 + h * 128, NO, p.ob + T0 * LDX + 512 + h * 128, lds); }
  }
}

DI void grid_bar(unsigned* cnt, unsigned target) {
  asm volatile("s_waitcnt vmcnt(0)" ::: "memory");
  __syncthreads();
  if (threadIdx.x == 0) {
    __builtin_amdgcn_fence(__ATOMIC_RELEASE, "agent");
    asm volatile("s_waitcnt vmcnt(0)" ::: "memory");
    __hip_atomic_fetch_add(cnt, 1u, __ATOMIC_RELAXED, __HIP_MEMORY_SCOPE_AGENT);
    unsigned spins = 0;
    while (__hip_atomic_load(cnt, __ATOMIC_RELAXED, __HIP_MEMORY_SCOPE_AGENT) < target) { __builtin_amdgcn_s_sleep(2); if (++spins > (1u << 24)) break; }
    __builtin_amdgcn_fence(__ATOMIC_ACQUIRE, "agent");
    asm volatile("s_waitcnt vmcnt(0)" ::: "memory");
  }
  __syncthreads();
}

constexpr int LDS_BYTES = 135168;
__global__ void __launch_bounds__(512, 2) mega(Params p) {
  extern __shared__ __attribute__((aligned(16))) char lds[];
  cg::grid_group grid = cg::this_grid();
  const int lo = p.phase_lo, hi_ = p.phase_hi;
#ifndef PROBE_REPEAT
#define PROBE_REPEAT -1
#endif
#define PHASE(k, body) if (lo <= k && k <= hi_) { if (k > lo) { if (k == 1) grid.sync(); else grid_bar(p.bar, (unsigned)(k - 1) * gridDim.x); } body; if (k == PROBE_REPEAT) { grid.sync(); body; } }
  PHASE(0, phase0(p))
  PHASE(1, gemm_phase<0>(p, lds))
  PHASE(2, attn_phase_even(p, lds))
  PHASE(3, gemm_phase<1>(p, lds))
  PHASE(4, gemm_phase<2>(p, lds))
  PHASE(5, upproj_phase(p, lds))
  PHASE(6, attn_phase_odd(p, lds))
  PHASE(7, gemm_phase<3>(p, lds))
#undef PHASE
}

#ifndef NLAUNCH
#define NLAUNCH 1
#endif
extern "C" void kernel_launch(void* const* d_in, const int* in_sizes, int n_in, void* d_out, int out_size, void* d_ws, size_t ws_size, hipStream_t stream) {
  static int grid_blocks = 0;
  if (!grid_blocks) {
    int dev = 0, cus = 0, per_cu = 0;
    (void)hipGetDevice(&dev);
    (void)hipDeviceGetAttribute(&cus, hipDeviceAttributeMultiprocessorCount, dev);
    (void)hipFuncSetAttribute((const void*)mega, hipFuncAttributeMaxDynamicSharedMemorySize, LDS_BYTES);
    (void)hipOccupancyMaxActiveBlocksPerMultiprocessor(&per_cu, mega, NTHR, LDS_BYTES);
    if (per_cu > 1) per_cu = 1;
    if (per_cu < 1) per_cu = 1;
    grid_blocks = cus * per_cu;
  }
  Params p;
  memset(&p, 0, sizeof(p));
  const float** fp = (const float**)&p;
  for (int i = 0; i < 25; ++i) fp[i] = (const float*)d_in[i];
  p.out = (float*)d_out;
  char* w = (char*)d_ws; size_t off = 0;
  auto take = [&](size_t bytes) { char* r = w + off; off += (bytes + 255) & ~(size_t)255; return r; };
  p.xb = (u16*)take((size_t)NTOK * LDX * 2);
  p.proj = (u16*)take((size_t)NTOK * NE * 2);
  p.ob = (u16*)take((size_t)NTOK * LDX * 2);
  p.qc = (u16*)take((size_t)NTOK * 768 * 2);
  p.kc = (u16*)take((size_t)NTOK * 768 * 2);
  p.vc = (u16*)take((size_t)NTOK * 512 * 2);
  p.wt_ine = (u16*)take((size_t)NE * LDX * 2);
  p.wt_oute = (u16*)take((size_t)1024 * LDX * 2);
  p.wt_ino = (u16*)take((size_t)NO * LDX * 2);
  p.wt_cq = (u16*)take((size_t)768 * 256 * 2);
  p.wt_ckv = (u16*)take((size_t)1024 * 128 * 2);
  p.wt_outo = (u16*)take((size_t)1024 * LDX * 2);
  p.rs0 = (float*)take(NTOK * 4); p.ss1 = (float*)take(NTOK * 4); p.sscq = (float*)take(NTOK * 4); p.ssckv = (float*)take(NTOK * 4);
  p.lam = (float*)take(256);
  p.bar = (unsigned*)take(256);
  p.tab_ax = (float2*)take(64 * 16 * 8); p.tab_mla = (float2*)take(4096 * 16 * 8); p.tab_part = (float2*)take(4096 * 8 * 8);
  if (off > ws_size) { fprintf(stderr, "workspace too small: need %zu have %zu\n", off, ws_size); return; }
  for (int i = 0; i < 16; ++i) p.inv16[i] = (float)pow(10000.0, -(double)i / 16.0);
  for (int i = 0; i < 8; ++i) p.inv8[i] = (float)pow(500000.0, -(double)i / 8.0);
#if NLAUNCH == 1
  p.phase_lo = 0; p.phase_hi = 7;
  void* args[] = {&p};
  hipError_t e = hipLaunchCooperativeKernel((void*)mega, dim3(grid_blocks), dim3(NTHR), args, LDS_BYTES, stream);
  if (e != hipSuccess) fprintf(stderr, "cooperative launch failed: %s (grid %d)\n", hipGetErrorString(e), grid_blocks);
#else
  for (int ph = 0; ph < 8; ++ph) { p.phase_lo = ph; p.phase_hi = ph; hipLaunchKernelGGL(mega, dim3(grid_blocks), dim3(NTHR), LDS_BYTES, stream, p); }
#endif
}
```

```cpp
#include <hip/hip_runtime.h>
#include <hip/hip_cooperative_groups.h>
#include <cstdio>
#include <cstdint>
#include <cmath>
#include <cstring>
namespace cg = cooperative_groups;

typedef unsigned short u16;
using bf16x8 = __attribute__((ext_vector_type(8))) short;
using s16x4  = __attribute__((ext_vector_type(4))) short;
using f32x16 = __attribute__((ext_vector_type(16))) float;
using f32x4  = __attribute__((ext_vector_type(4))) float;
using u32x4  = __attribute__((ext_vector_type(4))) unsigned;
using u32x2  = __attribute__((ext_vector_type(2))) unsigned;

#define DI __device__ __forceinline__
#define MFMA32(a, b, c) __builtin_amdgcn_mfma_f32_32x32x16_bf16((a), (b), (c), 0, 0, 0)
#define SBAR() __builtin_amdgcn_sched_barrier(0)

constexpr int NTOK = 32768, SEQ = 4096, DM = 1024, NE = 3328, NO = 3072;
constexpr int NTHR = 512, NWAVE = 8;
constexpr int LDX = 1024;
constexpr float EPS = 1e-6f, LOG2E = 1.4426950408889634f;
constexpr float LAM_INIT = 0.35550906759096930f;

struct Params {
  const float *x, *norm_e, *w_in_e, *gq_a, *gk_a, *rpb_a, *gq_b, *gk_b, *w_out_e,
      *norm_o, *w_in_o, *g_cq, *w_cq_b, *g_ckv, *w_ckv_b, *gq_c, *gk_c, *gq_d, *gk_d,
      *lam_q1, *lam_k1, *lam_q2, *lam_k2, *g_sub_d, *w_out_o;
  float* out;
  u16 *xb, *proj, *ob, *qc, *kc, *vc, *wt_ine, *wt_oute, *wt_ino, *wt_cq, *wt_ckv, *wt_outo;
  float *rs0, *ss1, *sscq, *ssckv, *lam;
  unsigned* bar;
  float2 *tab_ax, *tab_mla, *tab_part;
  float inv16[16];
  float inv8[8];
  int phase_lo, phase_hi;
};

DI int my_tid() { int t = threadIdx.x; asm volatile("" : "+v"(t)); return t; }
DI int crow(int r, int hi) { return (r & 3) + 8 * (r >> 2) + 4 * hi; }
DI unsigned cvtpk(float lo, float hi) { unsigned r; asm volatile("v_cvt_pk_bf16_f32 %0, %1, %2" : "=v"(r) : "v"(lo), "v"(hi)); return r; }
DI float bflo(unsigned w) { return __uint_as_float(w << 16); }
DI float bfhi(unsigned w) { return __uint_as_float(w & 0xffff0000u); }
DI float half_sum(float v) {
  auto rr = __builtin_amdgcn_permlane32_swap(__float_as_uint(v), __float_as_uint(v), false, false);
  return __uint_as_float(rr[0]) + __uint_as_float(rr[1]);
}
DI float half_max(float v) {
  auto rr = __builtin_amdgcn_permlane32_swap(__float_as_uint(v), __float_as_uint(v), false, false);
  return fmaxf(__uint_as_float(rr[0]), __uint_as_float(rr[1]));
}
DI float wave_sum(float v) {
  v += __shfl_xor(v, 32); v += __shfl_xor(v, 16); v += __shfl_xor(v, 8); v += __shfl_xor(v, 4); v += __shfl_xor(v, 2); v += __shfl_xor(v, 1);
  return v;
}
DI void store_blk_bf16(u16* rowp, const f32x16& v, int hi) {
#pragma unroll
  for (int q = 0; q < 4; ++q) { u32x2 w; w.x = cvtpk(v[4 * q], v[4 * q + 1]); w.y = cvtpk(v[4 * q + 2], v[4 * q + 3]); *(u32x2*)(rowp + 8 * q + 4 * hi) = w; }
}
DI void load_blk_f32(const float* g, int hi, f32x16& o) {
#pragma unroll
  for (int q = 0; q < 4; ++q) { f32x4 t = *(const f32x4*)(g + 8 * q + 4 * hi); o[4 * q] = t[0]; o[4 * q + 1] = t[1]; o[4 * q + 2] = t[2]; o[4 * q + 3] = t[3]; }
}
DI void load_blk_bf16(const u16* g, int hi, f32x16& o) {
#pragma unroll
  for (int q = 0; q < 4; ++q) { u32x2 w = *(const u32x2*)(g + 8 * q + 4 * hi); o[4 * q] = bflo(w.x); o[4 * q + 1] = bfhi(w.x); o[4 * q + 2] = bflo(w.y); o[4 * q + 3] = bfhi(w.y); }
}
DI float sumsq16(const f32x16& v) { float s = 0;
#pragma unroll
  for (int r = 0; r < 16; ++r) s = fmaf(v[r], v[r], s); return s; }
DI void rot16(f32x16& v, const float2* tab, int hi) {
#pragma unroll
  for (int r = 0; r < 8; ++r) { const float2 cs = tab[crow(r, hi)]; const float a = v[r], b = v[r + 8]; v[r] = a * cs.x - b * cs.y; v[r + 8] = b * cs.x + a * cs.y; }
}
DI void rot8(f32x16& v, const float2* tab, int hi) {
#pragma unroll
  for (int r = 0; r < 4; ++r) { const float2 cs = tab[r + 4 * hi]; const float a = v[r], b = v[r + 4]; v[r] = a * cs.x - b * cs.y; v[r + 4] = b * cs.x + a * cs.y; }
}
DI float silu(float v) { return v / (1.f + __expf(-v)); }

DI void sincos_rev(double f, float& c, float& s) {
  const double q = floor(4.0 * f + 0.5), y = f - 0.25 * q, th = 6.283185307179586 * y, t2 = th * th;
  const double sn = th * (1.0 + t2 * (-1.0 / 6 + t2 * (1.0 / 120 + t2 * (-1.0 / 5040 + t2 * (1.0 / 362880 + t2 * (-1.0 / 39916800 + t2 * (1.0 / 6227020800.0)))))));
  const double cs = 1.0 + t2 * (-0.5 + t2 * (1.0 / 24 + t2 * (-1.0 / 720 + t2 * (1.0 / 40320 + t2 * (-1.0 / 3628800 + t2 * (1.0 / 479001600.0 + t2 * (-1.0 / 87178291200.0)))))));
  const int qi = ((int)q) & 3;
  const double cc = qi == 0 ? cs : qi == 1 ? -sn : qi == 2 ? -cs : sn;
  const double ss = qi == 0 ? sn : qi == 1 ? cs : qi == 2 ? -sn : -cs;
  c = (float)cc; s = (float)ss;
}
DI float2 angle_cs(float pos, float inv) {
  const float ang = __fmul_rn(pos, inv);
  double rev = (double)ang * 0.15915494309189535; rev -= floor(rev);
  float2 r; sincos_rev(rev, r.x, r.y); return r;
}
template <int MODE>
DI void wtrans(const float* __restrict__ W, int K, int N, int Npad, const float* __restrict__ gain, u16* __restrict__ Wt, int ldw, int gt, int gn) {
  const int total = (K / 8) * Npad;
  for (int idx = gt; idx < total; idx += gn) {
    const int n = idx % Npad, kc = idx / Npad;
    int src = n;
    if (MODE == 1) src = n < 384 ? n : (n < 2944 ? n + 32 : (n < 2976 ? n - 2944 + 384 : -1));
    u32x4 w;
#pragma unroll
    for (int j = 0; j < 4; ++j) {
      const int k = kc * 8 + 2 * j; float a = 0.f, b = 0.f;
      if (src >= 0) { a = W[(size_t)k * N + src]; b = W[(size_t)(k + 1) * N + src]; if (gain) { a *= gain[k]; b *= gain[k + 1]; } }
      w[j] = cvtpk(a, b);
    }
    *(u32x4*)(Wt + (size_t)n * ldw + kc * 8) = w;
  }
}
DI void phase0(const Params& p) {
  const int tid = my_tid(), gt = blockIdx.x * NTHR + tid, gn = gridDim.x * NTHR, wave = tid >> 6, lane = tid & 63;
  for (int i = gt; i < NTOK; i += gn) { p.ss1[i] = 0.f; p.sscq[i] = 0.f; p.ssckv[i] = 0.f; }
  for (int row = blockIdx.x * NWAVE + wave; row < NTOK; row += gridDim.x * NWAVE) {
    const float* xr = p.x + (size_t)row * DM; f32x4 v[4]; float ss = 0.f;
#pragma unroll
    for (int i = 0; i < 4; ++i) { v[i] = *(const f32x4*)(xr + i * 256 + lane * 4); ss += v[i][0] * v[i][0] + v[i][1] * v[i][1] + v[i][2] * v[i][2] + v[i][3] * v[i][3]; }
    ss = wave_sum(ss);
    if (lane == 0) p.rs0[row] = rsqrtf(ss * (1.f / DM) + EPS);
#pragma unroll
    for (int i = 0; i < 4; ++i) { u32x2 w; w.x = cvtpk(v[i][0], v[i][1]); w.y = cvtpk(v[i][2], v[i][3]); *(u32x2*)(p.xb + (size_t)row * LDX + i * 256 + lane * 4) = w; }
  }
  wtrans<0>(p.w_in_e, 1024, NE, NE, p.norm_e, p.wt_ine, LDX, gt, gn);
  wtrans<0>(p.w_out_e, 1024, 1024, 1024, nullptr, p.wt_oute, LDX, gt, gn);
  wtrans<1>(p.w_in_o, 1024, 2976, NO, p.norm_o, p.wt_ino, LDX, gt, gn);
  wtrans<0>(p.w_cq_b, 256, 768, 768, p.g_cq, p.wt_cq, 256, gt, gn);
  wtrans<0>(p.w_ckv_b, 128, 1024, 1024, p.g_ckv, p.wt_ckv, 128, gt, gn);
  wtrans<0>(p.w_out_o, 1024, 1024, 1024, nullptr, p.wt_outo, LDX, gt, gn);
  for (int idx = gt; idx < 4096 * 16; idx += gn) p.tab_mla[idx] = angle_cs((float)(idx >> 4), p.inv16[idx & 15]);
  for (int idx = gt; idx < 4096 * 8; idx += gn) p.tab_part[idx] = angle_cs((float)(idx >> 3), p.inv8[idx & 7]);
  for (int idx = gt; idx < 64 * 16; idx += gn) p.tab_ax[idx] = angle_cs((float)(idx >> 4), p.inv16[idx & 15]);
  if (blockIdx.x == 0 && wave == 0) {
    float a = wave_sum(p.lam_q1[lane] * p.lam_k1[lane]), b = wave_sum(p.lam_q2[lane] * p.lam_k2[lane]);
    if (lane == 0) p.lam[0] = expf(a) - expf(b) + LAM_INIT;
    if (lane == 0) __hip_atomic_store(p.bar, 0u, __ATOMIC_RELAXED, __HIP_MEMORY_SCOPE_AGENT);
    float gq = fabsf(p.gq_b[lane]), gk = fabsf(p.gk_b[lane]);
    float gcq = fmaxf(fabsf(p.gq_c[lane]), lane < 32 ? fabsf(p.gq_c[64 + lane]) : 0.f), gck = fmaxf(fabsf(p.gk_c[lane]), lane < 32 ? fabsf(p.gk_c[64 + lane]) : 0.f);
    float gdq = fabsf(p.gq_d[lane]), gdk = fabsf(p.gk_d[lane]);
#pragma unroll
    for (int s = 32; s >= 1; s >>= 1) { gq = fmaxf(gq, __shfl_xor(gq, s)); gk = fmaxf(gk, __shfl_xor(gk, s)); gcq = fmaxf(gcq, __shfl_xor(gcq, s)); gck = fmaxf(gck, __shfl_xor(gck, s));
      gdq = fmaxf(gdq, __shfl_xor(gdq, s)); gdk = fmaxf(gdk, __shfl_xor(gdk, s)); }
    if (lane == 0) { p.lam[1] = 8.f * gq * gk; p.lam[2] = 9.797958971132712f * gcq * gck; p.lam[3] = 8.f * gdq * gdk; }
  }
}

#define LAS3 __attribute__((address_space(3)))
DI void dma16(const void* g, char* lds_uniform) {
  __builtin_amdgcn_global_load_lds((const unsigned*)g, (LAS3 unsigned*)(LAS3 char*)lds_uniform, 16, 0, 0);
}
template <int WM, int WN, int MI, int NI>
DI void gemm_mainloop(const u16* __restrict__ A, const int lda, const u16* __restrict__ Bt, const int ldb, const int K, char* lds, f32x16 (&acc)[MI][NI]) {
  constexpr int BM = WM * MI * 32, BN = WN * NI * 32, BNS = (BN + 63) / 64 * 64, ACH = BM / 64, BCH = BNS / 64, ABYTES = BM * 128, BUF = (BM + BNS) * 128;
  const int tid = my_tid(), wave = __builtin_amdgcn_readfirstlane(tid >> 6), lane = tid & 63, r32 = lane & 31, hi = lane >> 5;
  const int wr = wave / WN, wc = wave % WN;
  const int srow = wave * 8 + (lane >> 3), spos = lane & 7, schunk = spos ^ ((srow >> 1) & 7);
  const u16* ag = A + (size_t)srow * lda + schunk * 8;
  const u16* bg = Bt + (size_t)srow * ldb + schunk * 8;
  const int sw = (r32 >> 1) & 7;
  const int abase = (wr * MI * 32 + r32) * 128, bbase = ABYTES + (wc * NI * 32 + r32) * 128;
#pragma unroll
  for (int mi = 0; mi < MI; ++mi)
#pragma unroll
    for (int ni = 0; ni < NI; ++ni)
#pragma unroll
      for (int r = 0; r < 16; ++r) acc[mi][ni][r] = 0.f;
#define G_DMA(BUFP, KT) do { _Pragma("unroll") for (int i = 0; i < ACH; ++i) dma16(ag + (size_t)i * 64 * lda + (KT) * 64, (BUFP) + i * 8192 + wave * 1024); \
    _Pragma("unroll") for (int i = 0; i < BCH; ++i) dma16(bg + (size_t)i * 64 * ldb + (KT) * 64, (BUFP) + ABYTES + i * 8192 + wave * 1024); } while (0)
#define G_COMPUTE(CUR) do { _Pragma("unroll") for (int kk = 0; kk < 4; ++kk) { const int xk = ((kk * 2 + hi) ^ sw) << 4; bf16x8 af[MI], bfr[NI]; \
    _Pragma("unroll") for (int mi = 0; mi < MI; ++mi) af[mi] = *(const bf16x8*)((CUR) + abase + mi * 4096 + xk); \
    _Pragma("unroll") for (int ni = 0; ni < NI; ++ni) bfr[ni] = *(const bf16x8*)((CUR) + bbase + ni * 4096 + xk); \
    _Pragma("unroll") for (int mi = 0; mi < MI; ++mi) _Pragma("unroll") for (int ni = 0; ni < NI; ++ni) acc[mi][ni] = MFMA32(bfr[ni], af[mi], acc[mi][ni]); } } while (0)
  const int nk = K >> 6;
  G_DMA(lds, 0);
  for (int kt = 0; kt < nk; ++kt) {
    asm volatile("s_waitcnt vmcnt(0)" ::: "memory");
    __syncthreads();
    char* cur = lds + (kt & 1) * BUF;
    if (kt + 1 < nk) G_DMA(lds + ((kt + 1) & 1) * BUF, kt + 1);
    G_COMPUTE(cur);
  }
  __syncthreads();
#undef G_DMA
#undef G_COMPUTE
}

DI void tile_of(int t, int NT, int& mt, int& nt) {
  const int xcd = t & 7, idx = t >> 3, g = idx / (8 * NT), rem = idx % (8 * NT);
  mt = xcd * 16 + g * 8 + (rem & 7); nt = rem >> 3;
}

DI void epi_in_e(const Params& p, f32x16& a00, f32x16& a01, f32x16& a10, f32x16& a11, int mrow0, int cb, int r32, int hi) {
  int type; const float* g = nullptr;
  if (cb < 512) { type = 1; g = p.gq_a; } else if (cb < 1024) { type = 1; g = p.gk_a; } else if (cb < 1536) type = 0;
  else if (cb < 2048) { type = 2; g = p.gq_b; } else if (cb < 2176) { type = 2; g = p.gk_b; } else if (cb < 2304) type = 0; else type = 3;
#pragma unroll
  for (int mi = 0; mi < 2; ++mi) {
    f32x16& r0 = mi ? a10 : a00; f32x16& r1 = mi ? a11 : a01;
    const int T = mrow0 + mi * 32 + r32; const float rs = p.rs0[T];
    f32x16 v0 = r0 * rs, v1 = r1 * rs;
    if (type == 1 || type == 2) {
      const float ss = half_sum(sumsq16(v0) + sumsq16(v1)); const float ri = rsqrtf(ss * (1.f / 64) + EPS);
      { f32x16 gg; load_blk_f32(g, hi, gg); v0 = v0 * ri * gg; load_blk_f32(g + 32, hi, gg); v1 = v1 * ri * gg; }
      if (type == 2) { const int t = T & 4095; rot16(v0, p.tab_ax + (t >> 6) * 16, hi); rot16(v1, p.tab_ax + (t & 63) * 16, hi); }
      if (cb >= 1536 && cb < 2048) { v0 = v0 * (0.125f * LOG2E); v1 = v1 * (0.125f * LOG2E); }
    } else if (type == 3) {
#pragma unroll
      for (int r = 0; r < 16; ++r) { v0[r] = silu(v0[r]); v1[r] = silu(v1[r]); }
    }
    r0 = v0; r1 = v1;
  }
}
DI void epi_in_o(const Params& p, f32x16& a00, f32x16& a01, f32x16& a10, f32x16& a11, int mrow0, int cb, int r32, int hi) {
  int type; const float* g = nullptr;
  if (cb < 256) type = 4; else if (cb < 384) type = 5; else if (cb < 896) { type = 2; g = p.gq_d; } else if (cb < 1408) { type = 2; g = p.gk_d; }
  else if (cb < 1920) type = 0; else if (cb < 2944) type = 3; else type = 0;
#pragma unroll
  for (int mi = 0; mi < 2; ++mi) {
    f32x16& r0 = mi ? a10 : a00; f32x16& r1 = mi ? a11 : a01;
    const int T = mrow0 + mi * 32 + r32; const float rs = rsqrtf(p.ss1[T] * (1.f / DM) + EPS);
    f32x16 v0 = r0 * rs, v1 = r1 * rs;
    if (type == 2) {
      const float ss = half_sum(sumsq16(v0) + sumsq16(v1)); const float ri = rsqrtf(ss * (1.f / 64) + EPS);
      { f32x16 gg; load_blk_f32(g, hi, gg); v0 = v0 * ri * gg; load_blk_f32(g + 32, hi, gg); v1 = v1 * ri * gg; }
      rot8(v0, p.tab_part + (T & 4095) * 8, hi);
      if (cb < 896) { v0 = v0 * (0.125f * LOG2E); v1 = v1 * (0.125f * LOG2E); }
    } else if (type == 3) {
#pragma unroll
      for (int r = 0; r < 16; ++r) { v0[r] = silu(v0[r]); v1[r] = silu(v1[r]); }
    } else if (type >= 4) {
      const float ss = half_sum(sumsq16(v0) + sumsq16(v1));
      if (hi == 0) atomicAdd((type == 4 ? p.sscq : p.ssckv) + T, ss);
    }
    r0 = v0; r1 = v1;
  }
}
DI void stage_out_bf16(f32x16 (&acc)[2][4], u16* dst, int ld, char* lds) {
  const int tid = my_tid(), wave = tid >> 6, lane = tid & 63, r32 = lane & 31, hi = lane >> 5, wr = wave >> 1, wc = wave & 1;
#pragma unroll
  for (int half = 0; half < 2; ++half) {
    if ((wr >> 1) == half) {
#pragma unroll
      for (int mi = 0; mi < 2; ++mi) {
        u16* rowp = (u16*)(lds + ((wr & 1) * 64 + mi * 32 + r32) * 520) + wc * 128;
#pragma unroll
        for (int ni = 0; ni < 4; ++ni) store_blk_bf16(rowp + 32 * ni, acc[mi][ni], hi);
      }
    }
    __syncthreads();
#pragma unroll
    for (int i = 0; i < 8; ++i) {
      const int c = tid + i * NTHR, row = c >> 5, ch = c & 31;
      const u32x2 a = *(const u32x2*)(lds + row * 520 + ch * 16), b = *(const u32x2*)(lds + row * 520 + ch * 16 + 8);
      u32x4 w; w.x = a.x; w.y = a.y; w.z = b.x; w.w = b.y;
      *(u32x4*)(dst + (size_t)(half * 128 + row) * ld + ch * 8) = w;
    }
    __syncthreads();
  }
}
template <bool FIRST>
DI void epi_out(const Params& p, f32x16 (&acc)[2][4], int m0, int n0, char* lds) {
  const float* res = FIRST ? p.x : p.out;
  const int tid = my_tid(), wave = tid >> 6, lane = tid & 63, r32 = lane & 31, hi = lane >> 5, wr = wave >> 1, wc = wave & 1;
#pragma unroll
  for (int mi = 0; mi < 2; ++mi)
#pragma unroll
    for (int half = 0; half < 2; ++half) {
      if ((wr >> 1) == half) {
        float* rowp = (float*)(lds + ((wr & 1) * 32 + r32) * 1040) + wc * 128;
#pragma unroll
        for (int ni = 0; ni < 4; ++ni)
#pragma unroll
          for (int q = 0; q < 4; ++q) { f32x4 v; v[0] = acc[mi][ni][4 * q]; v[1] = acc[mi][ni][4 * q + 1]; v[2] = acc[mi][ni][4 * q + 2]; v[3] = acc[mi][ni][4 * q + 3]; *(f32x4*)(rowp + 32 * ni + 8 * q + 4 * hi) = v; }
      }
      __syncthreads();
#pragma unroll
      for (int i = 0; i < 8; ++i) {
        const int c = tid + i * NTHR, row = c >> 6, ch = c & 63;
        const int T = m0 + half * 128 + (row >> 5) * 64 + mi * 32 + (row & 31);
        const size_t off = (size_t)T * DM + n0 + ch * 4;
        const f32x4 a = *(const f32x4*)(lds + row * 1040 + ch * 16), rv = *(const f32x4*)(res + off);
        f32x4 ov = a + rv;
        *(f32x4*)(p.out + off) = ov;
        if (FIRST) {
          float ss = ov[0] * ov[0] + ov[1] * ov[1] + ov[2] * ov[2] + ov[3] * ov[3];
          u32x2 w; w.x = cvtpk(ov[0], ov[1]); w.y = cvtpk(ov[2], ov[3]); *(u32x2*)(p.xb + (size_t)T * LDX + n0 + ch * 4) = w;
          ss = wave_sum(ss);
          if (ch == 0) atomicAdd(p.ss1 + T, ss);
        }
      }
      __syncthreads();
    }
}
template <int WHICH>
DI void gemm_phase(const Params& p, char* lds) {
  constexpr int NT = WHICH == 0 ? NE / 256 : WHICH == 2 ? NO / 256 : 4;
  const u16* A = (WHICH == 0 || WHICH == 2) ? p.xb : p.ob;
  const u16* Bt = WHICH == 0 ? p.wt_ine : WHICH == 1 ? p.wt_oute : WHICH == 2 ? p.wt_ino : p.wt_outo;
  const int wave = my_tid() >> 6, lane = my_tid() & 63, r32 = lane & 31, hi = lane >> 5, wr = wave >> 1, wc = wave & 1;
  for (int t = blockIdx.x; t < 128 * NT; t += gridDim.x) {
    int mt, nt; tile_of(t, NT, mt, nt);
    f32x16 acc[2][4];
    gemm_mainloop<4, 2, 2, 4>(A + (size_t)mt * 256 * LDX, LDX, Bt + (size_t)nt * 256 * LDX, LDX, DM, lds, acc);
    const int mrow0 = mt * 256 + wr * 64, cb = nt * 256 + wc * 128;
    if (WHICH == 0) {
      epi_in_e(p, acc[0][0], acc[0][1], acc[1][0], acc[1][1], mrow0, cb, r32, hi);
      epi_in_e(p, acc[0][2], acc[0][3], acc[1][2], acc[1][3], mrow0, cb + 64, r32, hi);
      stage_out_bf16(acc, p.proj + (size_t)mt * 256 * NE + nt * 256, NE, lds);
    } else if (WHICH == 2) {
      epi_in_o(p, acc[0][0], acc[0][1], acc[1][0], acc[1][1], mrow0, cb, r32, hi);
      epi_in_o(p, acc[0][2], acc[0][3], acc[1][2], acc[1][3], mrow0, cb + 64, r32, hi);
      stage_out_bf16(acc, p.proj + (size_t)mt * 256 * NO + nt * 256, NO, lds);
    } else if (WHICH == 1) epi_out<true>(p, acc, mt * 256, nt * 256, lds);
    else epi_out<false>(p, acc, mt * 256, nt * 256, lds);
  }
}
template <int NCH, int STR>
DI void copy_rows_bf16(const char* lds, u16* dst, int ld) {
  const int tid = my_tid();
#pragma unroll
  for (int i = 0; i < (256 * NCH) / NTHR; ++i) {
    const int c = tid + i * NTHR, row = c / NCH, ch = c % NCH;
    const u32x2 a = *(const u32x2*)(lds + row * STR + ch * 16), b = *(const u32x2*)(lds + row * STR + ch * 16 + 8);
    u32x4 w; w.x = a.x; w.y = a.y; w.z = b.x; w.w = b.y;
    *(u32x4*)(dst + (size_t)row * ld + ch * 8) = w;
  }
}
DI void upproj_phase(const Params& p, char* lds) {
  const int wave = my_tid() >> 6, lane = my_tid() & 63, r32 = lane & 31, hi = lane >> 5;
  for (int t = blockIdx.x; t < 128 * 8; t += gridDim.x) {
    int mt, hh; tile_of(t, 8, mt, hh);
    f32x16 acc[1][3];
    gemm_mainloop<8, 1, 1, 3>(p.proj + (size_t)mt * 256 * NO, NO, p.wt_cq + (size_t)hh * 96 * 256, 256, 256, lds, acc);
    const int T = mt * 256 + wave * 32 + r32;
    const float rcq = rsqrtf(p.sscq[T] * (1.f / 256) + EPS);
    f32x16 v0 = acc[0][0] * rcq, v1 = acc[0][1] * rcq, v2 = acc[0][2] * rcq;
    const float ss = half_sum(sumsq16(v0) + sumsq16(v1) + sumsq16(v2)); const float ri = rsqrtf(ss * (1.f / 96) + EPS);
    f32x16 g; load_blk_f32(p.gq_c, hi, g); v0 = v0 * ri * g; load_blk_f32(p.gq_c + 32, hi, g); v1 = v1 * ri * g; load_blk_f32(p.gq_c + 64, hi, g); v2 = v2 * ri * g;
    rot16(v2, p.tab_mla + (T & 4095) * 16, hi);
    { const float cs = 0.10206207261596575f * LOG2E; v0 = v0 * cs; v1 = v1 * cs; v2 = v2 * cs; }
    u16* rowp = (u16*)(lds + (wave * 32 + r32) * 200);
    store_blk_bf16(rowp, v0, hi); store_blk_bf16(rowp + 32, v1, hi); store_blk_bf16(rowp + 64, v2, hi);
    __syncthreads();
    copy_rows_bf16<12, 200>(lds, p.qc + (size_t)mt * 256 * 768 + hh * 96, 768);
    __syncthreads();
  }
  for (int t = blockIdx.x; t < 128 * 8; t += gridDim.x) {
    int mt, hh; tile_of(t, 8, mt, hh);
    f32x16 acc[1][4];
    gemm_mainloop<8, 1, 1, 4>(p.proj + (size_t)mt * 256 * NO + 256, NO, p.wt_ckv + (size_t)hh * 128 * 128, 128, 128, lds, acc);
    const int T = mt * 256 + wave * 32 + r32;
    const float rkv = rsqrtf(p.ssckv[T] * (1.f / 128) + EPS);
    f32x16 v0 = acc[0][0] * rkv, v1 = acc[0][1] * rkv, v2 = acc[0][2] * rkv, v3 = acc[0][3] * rkv, kp;
    load_blk_bf16(p.proj + (size_t)T * NO + 2944, hi, kp);
    const float ss = half_sum(sumsq16(v0) + sumsq16(v1) + sumsq16(kp)); const float ri = rsqrtf(ss * (1.f / 96) + EPS);
    f32x16 g; load_blk_f32(p.gk_c, hi, g); v0 = v0 * ri * g; load_blk_f32(p.gk_c + 32, hi, g); v1 = v1 * ri * g; load_blk_f32(p.gk_c + 64, hi, g); kp = kp * ri * g;
    rot16(kp, p.tab_mla + (T & 4095) * 16, hi);
    u16* rowp = (u16*)(lds + (wave * 32 + r32) * 200);
    store_blk_bf16(rowp, v0, hi); store_blk_bf16(rowp + 32, v1, hi); store_blk_bf16(rowp + 64, kp, hi);
    u16* vrow = (u16*)(lds + 51200 + (wave * 32 + r32) * 136);
    store_blk_bf16(vrow, v2, hi); store_blk_bf16(vrow + 32, v3, hi);
    __syncthreads();
    copy_rows_bf16<12, 200>(lds, p.kc + (size_t)mt * 256 * 768 + hh * 96, 768);
    copy_rows_bf16<8, 136>(lds + 51200, p.vc + (size_t)mt * 256 * 512 + hh * 64, 512);
    __syncthreads();
  }
}

namespace pg8 {
#define PG8_LAS __attribute__((address_space(3)))
typedef unsigned short bf16_t;
typedef short bf16x8 __attribute__((ext_vector_type(8)));
typedef float f32x4 __attribute__((ext_vector_type(4)));
typedef unsigned u32x4 __attribute__((ext_vector_type(4)));
constexpr int BM = 256, BK = 64, HALF = 128, HTB = HALF * BK * 2  , STAGE_BYTES = 8 * HTB, NXCD = 8, WGM = 8;

__host__ __device__ __forceinline__ int lds_byte(int r, int c) { const int st = (r >> 4) * 2 + (c >> 5), rr = r & 15, cc = c & 31, ob = rr * 64 + cc * 2; return st * 1024 + (ob ^ (((ob >> 9) & 1) << 5)); }
__host__ __device__ __forceinline__ void stage_rc(int b, int& R, int& C) { const int st = b / 1024, sb = b % 1024, swz = sb ^ (((sb >> 9) & 1) << 5); R = (st >> 1) * 16 + swz / 64; C = (st & 1) * 32 + (swz % 64) / 2; }
__host__ __device__ __forceinline__ int perm32(int rho) { const int n = rho >> 4, i = rho & 15; return 8 * (i >> 2) + 4 * n + (i & 3); }

struct Unit { int pm, pn; };
struct Gemm { const bf16_t* A; const bf16_t* Bt; int M, N, K; };

struct StaticOrder {
    int nM, nN, nwg, G, c;
    __host__ __device__ void init(int M, int N, int G_, int c_) { nM = M / BM; nN = N / BM; nwg = nM * nN; G = G_; c = c_; }
    __host__ __device__ bool next(int i, Unit& u) const {
        const long L = (long)i * G + c; if (L >= nwg) return false;
        int wgid = (int)L; { const int q = nwg / NXCD, r = nwg % NXCD, xcd = wgid % NXCD, off = wgid / NXCD; wgid = (xcd < r ? xcd * (q + 1) : r * (q + 1) + (xcd - r) * q) + off; }
        const int nig = WGM * nN, gid = wgid / nig, fm = gid * WGM, gsz = (nM - fm) < WGM ? (nM - fm) : WGM;
        u.pm = fm + ((wgid % nig) % gsz); u.pn = (wgid % nig) / gsz; return true;
    }
    __device__ __forceinline__ void a_ready(const Unit&) const {}
    __device__ __forceinline__ void done(const Unit&) const {}
};
__device__ __forceinline__ unsigned cvt_pk_bf16(float lo, float hi) { unsigned r; asm volatile("v_cvt_pk_bf16_f32 %0, %1, %2" : "=v"(r) : "v"(lo), "v"(hi)); return r; }
template <class Epi, class Sched, bool STAMP = false>
__device__ __forceinline__ void gemm_phase(PG8_LAS unsigned char* lds, const Gemm g, const Sched& S, const Epi& E, unsigned long long* stamps) {
    const int tid = my_tid(), wid = __builtin_amdgcn_readfirstlane(tid >> 6), lane = tid & 63, wr = wid >> 2, wc = wid & 3, fr = lane & 15, fq = lane >> 4;
    const int K = g.K, nt = K / BK;
    int ts_lo = 0, ts_hi = 0, nts = 0; const unsigned long long rt_entry = STAMP ? (unsigned long long)wall_clock64() : 0ull;
#define PG8_STAMP() do { if (STAMP && wid == 0 && nts < 64) { const unsigned long long _c = (unsigned long long)clock64(); \
        ts_lo = (lane == nts) ? (int)(unsigned)_c : ts_lo; ts_hi = (lane == nts) ? (int)(unsigned)(_c >> 32) : ts_hi; ++nts; } } while (0)
    PG8_STAMP();
    unsigned voffA[2], voffB[2];
#pragma unroll
    for (int i = 0; i < 2; ++i) { int R, C; stage_rc(tid * 16 + i * 8192, R, C); const int Rb = Epi::PERM ? ((R & ~31) + perm32(R & 31)) : R;
        voffA[i] = (unsigned)(R * K + C) * 2u; voffB[i] = (unsigned)(Rb * K + C) * 2u; }
    const size_t kstep = (size_t)(BK * 2);
    const size_t hstep = (size_t)HALF * K * 2;
    const size_t tstep = 2 * hstep;
    const unsigned ldsw = (unsigned)wid * 1024u;
    const int aoff = lds_byte(wr * 64 + fr, fq * 8), boff = lds_byte(wc * 32 + fr, fq * 8);
#define PG8_SA(b, h) (((b) * 2 + (h)) * HTB)
#define PG8_SB(b, h) ((4 + (b) * 2 + (h)) * HTB)
#define PG8_STAGE(bufoff, gbase, voff) do { _Pragma("unroll") for (int _i = 0; _i < 2; ++_i) \
        __builtin_amdgcn_global_load_lds((const unsigned*)((const char*)(gbase) + (voff)[_i]), (PG8_LAS unsigned*)(lds + (bufoff) + ldsw + _i * 8192), 16, 0, 0); } while (0)
#define PG8_LDA(dst, b, h) do { _Pragma("unroll") for (int m = 0; m < 4; ++m) _Pragma("unroll") for (int k = 0; k < 2; ++k) dst[m][k] = *(const PG8_LAS bf16x8*)(lds + PG8_SA(b, h) + aoff + m * 2048 + k * 1024); } while (0)
#define PG8_LDB(dst, b, h) do { _Pragma("unroll") for (int n = 0; n < 2; ++n) _Pragma("unroll") for (int k = 0; k < 2; ++k) dst[n][k] = *(const PG8_LAS bf16x8*)(lds + PG8_SB(b, h) + boff + n * 2048 + k * 1024); } while (0)
#define PG8_MMA(ai, bj, At, Bt) do { __builtin_amdgcn_s_setprio(1); _Pragma("unroll") for (int m = 0; m < 4; ++m) _Pragma("unroll") for (int n = 0; n < 2; ++n) _Pragma("unroll") for (int k = 0; k < 2; ++k) \
        acc[ai][bj][m][n] = __builtin_amdgcn_mfma_f32_16x16x32_bf16(Bt[n][k], At[m][k], acc[ai][bj][m][n], 0, 0, 0); __builtin_amdgcn_s_setprio(0); } while (0)
#define PG8_WAIT_V(n) asm volatile("s_waitcnt vmcnt(" #n ")" ::: "memory")
#define PG8_WAIT_L(n) asm volatile("s_waitcnt lgkmcnt(" #n ")" ::: "memory")
#define PG8_BAR __builtin_amdgcn_s_barrier()
#define PG8_SCHED __builtin_amdgcn_sched_barrier(0)
    Unit cur, nxt; int ui = 0;
    if (!S.next(0, cur)) return;
    f32x4 acc[2][2][4][2];
#pragma unroll
    for (int a = 0; a < 2; ++a)
#pragma unroll
        for (int b = 0; b < 2; ++b)
#pragma unroll
            for (int m = 0; m < 4; ++m)
#pragma unroll
                for (int n = 0; n < 2; ++n) acc[a][b][m][n] = (f32x4){0.f, 0.f, 0.f, 0.f};
    bf16x8 At[4][2], B0[2][2], B1[2][2];
    const char* cA = (const char*)g.A + (size_t)cur.pm * tstep; const char* cB = (const char*)g.Bt + (size_t)cur.pn * tstep;
    S.a_ready(cur);
    PG8_STAGE(PG8_SB(0, 0), cB, voffB); PG8_STAGE(PG8_SA(0, 0), cA, voffA); PG8_STAGE(PG8_SB(0, 1), cB + hstep, voffB); PG8_STAGE(PG8_SA(0, 1), cA + hstep, voffA);
    if (wr == 1) PG8_BAR;
    PG8_WAIT_V(4); PG8_BAR;
    PG8_STAGE(PG8_SB(1, 0), cB + kstep, voffB); PG8_STAGE(PG8_SA(1, 0), cA + kstep, voffA); PG8_STAGE(PG8_SB(1, 1), cB + hstep + kstep, voffB);
    PG8_WAIT_V(6); PG8_BAR;
    PG8_STAMP();
    for (;;) {
        const bool has_next = S.next(ui + 1, nxt);
        const char* nA = has_next ? (const char*)g.A + (size_t)nxt.pm * tstep : cA; const char* nB = has_next ? (const char*)g.Bt + (size_t)nxt.pn * tstep : cB;
        for (int t = 0; t < nt; t += 2) {
            const bool last = (t == nt - 2);
            const char* a1 = cA + (size_t)(t + 1) * kstep;
            const char* a2 = last ? nA : cA + (size_t)(t + 2) * kstep; const char* b2 = last ? nB : cB + (size_t)(t + 2) * kstep;
            const char* a3 = a2 + kstep; const char* b3 = b2 + kstep;
            if (last && has_next) S.a_ready(nxt);
            PG8_LDB(B0, 0, 0); PG8_SCHED; PG8_LDA(At, 0, 0); PG8_STAGE(PG8_SA(1, 1), a1 + hstep, voffA);
            PG8_WAIT_L(8); PG8_BAR; PG8_WAIT_L(0); PG8_MMA(0, 0, At, B0); PG8_BAR; PG8_SCHED;
            PG8_LDB(B1, 0, 1); PG8_STAGE(PG8_SB(0, 0), b2, voffB);
            PG8_BAR; PG8_WAIT_L(0); PG8_MMA(0, 1, At, B1); PG8_BAR;
            PG8_LDA(At, 0, 1); PG8_STAGE(PG8_SA(0, 0), a2, voffA);
            PG8_BAR; PG8_WAIT_L(0); PG8_MMA(1, 0, At, B0); PG8_BAR; PG8_SCHED;
            PG8_STAGE(PG8_SB(0, 1), b2 + hstep, voffB);
            PG8_WAIT_V(6); PG8_BAR; PG8_MMA(1, 1, At, B1); PG8_BAR;
            PG8_LDB(B0, 1, 0); PG8_SCHED; PG8_LDA(At, 1, 0); PG8_STAGE(PG8_SA(0, 1), a2 + hstep, voffA);
            PG8_WAIT_L(8); PG8_BAR; PG8_WAIT_L(0); PG8_MMA(0, 0, At, B0); PG8_BAR; PG8_SCHED;
            PG8_LDB(B1, 1, 1); PG8_STAGE(PG8_SB(1, 0), b3, voffB);
            PG8_BAR; PG8_WAIT_L(0); PG8_MMA(0, 1, At, B1); PG8_BAR;
            PG8_LDA(At, 1, 1); PG8_STAGE(PG8_SA(1, 0), a3, voffA);
            PG8_BAR; PG8_WAIT_L(0); PG8_MMA(1, 0, At, B0); PG8_BAR; PG8_SCHED;
            PG8_STAGE(PG8_SB(1, 1), b3 + hstep, voffB);
            PG8_WAIT_V(6); PG8_BAR; PG8_MMA(1, 1, At, B1); PG8_BAR;
        }
        PG8_STAMP();
        if constexpr (!Epi::AFTER_DRAIN) { E(acc, cur, wr, wc, fr, fq); S.done(cur); }
        PG8_STAMP();
        if (!has_next) break;
#pragma unroll
        for (int a = 0; a < 2; ++a)
#pragma unroll
            for (int b = 0; b < 2; ++b)
#pragma unroll
                for (int m = 0; m < 4; ++m)
#pragma unroll
                    for (int n = 0; n < 2; ++n) acc[a][b][m][n] = (f32x4){0.f, 0.f, 0.f, 0.f};
        cur = nxt; cA = nA; cB = nB; ++ui;
    }
    PG8_WAIT_V(0);
    if (wr == 0) PG8_BAR;
    PG8_BAR;
    if constexpr (Epi::AFTER_DRAIN) { E.fused(acc, cur, wr, wc, fr, fq, lds, wid, lane); S.done(cur); }
    PG8_STAMP();
    if (STAMP && wid == 0) { stamps[lane] = lane < nts ? (((unsigned long long)(unsigned)ts_hi << 32) | (unsigned)ts_lo) : 0ull;
        if (lane == 62) stamps[62] = rt_entry; if (lane == 63) stamps[63] = (unsigned long long)wall_clock64(); }
#undef PG8_STAMP
#undef PG8_SA
#undef PG8_SB
#undef PG8_STAGE
#undef PG8_LDA
#undef PG8_LDB
#undef PG8_MMA
#undef PG8_WAIT_V
#undef PG8_WAIT_L
#undef PG8_BAR
#undef PG8_SCHED
}

__device__ __forceinline__ float silu_f(float v) { return v * __builtin_amdgcn_rcpf(1.f + __builtin_amdgcn_exp2f(v * -1.4426950408889634f)); }
__device__ __forceinline__ void xch_barrier() { asm volatile("s_waitcnt lgkmcnt(0)" ::: "memory"); __builtin_amdgcn_s_barrier(); asm volatile("" ::: "memory"); }
template <int XORL>
__device__ __forceinline__ void rot_lane8(float (&x)[8], const float2* tb, bool apply, bool first) {
    const f32x4 t0 = *(const f32x4*)(tb), t1 = *(const f32x4*)(tb + 2), t2 = *(const f32x4*)(tb + 4), t3 = *(const f32x4*)(tb + 6);
    const float c[8] = {t0[0], t0[2], t1[0], t1[2], t2[0], t2[2], t3[0], t3[2]}, s[8] = {t0[1], t0[3], t1[1], t1[3], t2[1], t2[3], t3[1], t3[3]};
#pragma unroll
    for (int k = 0; k < 8; ++k) { const float xp = __shfl_xor(x[k], XORL); const float r = first ? x[k] * c[k] - xp * s[k] : x[k] * c[k] + xp * s[k]; x[k] = apply ? r : x[k]; }
}
template <bool L1>
struct EpiIn {
    static constexpr bool PERM = true, AFTER_DRAIN = false;
    const Params& p; PG8_LAS float* xch;
    __device__ __forceinline__ void operator()(const f32x4 (&acc)[2][2][4][2], const Unit& u, int wr, int wc, int fr, int fq) const {
        constexpr int LDP = L1 ? NO : NE;
        asm volatile("" : "+v"(fr), "+v"(fq));
        int type[2]; const float* gp[2]; int hbs[2];
#pragma unroll
        for (int bj = 0; bj < 2; ++bj) {
            const int hb = (u.pn * 256 + bj * 128 + wc * 32) & ~63; hbs[bj] = hb; gp[bj] = p.gq_a; int t;
            if (!L1) { if (hb < 512) { t = 1; gp[bj] = p.gq_a; } else if (hb < 1024) { t = 1; gp[bj] = p.gk_a; } else if (hb < 1536) t = 0; else if (hb < 2048) { t = 2; gp[bj] = p.gq_b; }
                       else if (hb < 2176) { t = 2; gp[bj] = p.gk_b; } else if (hb < 2304) t = 0; else t = 3; }
            else     { if (hb < 256) t = 4; else if (hb < 384) t = 5; else if (hb < 896) { t = 2; gp[bj] = p.gq_d; } else if (hb < 1408) { t = 2; gp[bj] = p.gk_d; } else if (hb < 1920) t = 0; else if (hb < 2944) t = 3; else t = 0; }
            type[bj] = t;
        }
        const int w32 = (wc & 1) * 32, ch = w32 + 8 * fq;
#pragma unroll
        for (int ai = 0; ai < 2; ++ai)
#pragma unroll
            for (int m = 0; m < 4; ++m) {
                const int rl = ai * HALF + wr * 64 + m * 16 + fr, T = u.pm * BM + rl;
                const float rs = L1 ? rsqrtf(p.ss1[T] * (1.f / DM) + EPS) : p.rs0[T];
#pragma unroll
                for (int bj = 0; bj < 2; ++bj) {
                    float s = 0.f;
                    if (type[bj] == 1 || type[bj] == 2 || type[bj] >= 4) {
#pragma unroll
                        for (int n = 0; n < 2; ++n)
#pragma unroll
                            for (int e = 0; e < 4; ++e) { const float x = acc[ai][bj][m][n][e] * rs; s = fmaf(x, x, s); }
                        s += __shfl_xor(s, 16); s += __shfl_xor(s, 32);
                        if (type[bj] >= 4) { if (fq == 0) atomicAdd((type[bj] == 4 ? p.sscq : p.ssckv) + T, s); }
                        else if (fq == 0) xch[rl * 8 + bj * 4 + wc] = s;
                    }
                }
                asm volatile("" ::: "memory");
            }
        xch_barrier();
#pragma unroll
        for (int ai = 0; ai < 2; ++ai)
#pragma unroll
            for (int m = 0; m < 4; ++m) {
                const int rl = ai * HALF + wr * 64 + m * 16 + fr, T = u.pm * BM + rl, t = T & 4095;
                const float rs = L1 ? rsqrtf(p.ss1[T] * (1.f / DM) + EPS) : p.rs0[T];
#pragma unroll
                for (int bj = 0; bj < 2; ++bj) {
                    float x[8];
#pragma unroll
                    for (int n = 0; n < 2; ++n)
#pragma unroll
                        for (int e = 0; e < 4; ++e) x[4 * n + e] = acc[ai][bj][m][n][e] * rs;
                    if (type[bj] == 1 || type[bj] == 2) {
                        const float tot = xch[rl * 8 + bj * 4 + wc] + xch[rl * 8 + bj * 4 + (wc ^ 1)];
                        const float ri = rsqrtf(tot * (1.f / 64) + EPS);
                        const f32x4 g0 = *(const f32x4*)(gp[bj] + ch), g1 = *(const f32x4*)(gp[bj] + ch + 4);
#pragma unroll
                        for (int e = 0; e < 4; ++e) { x[e] *= ri * g0[e]; x[4 + e] *= ri * g1[e]; }
                        if (type[bj] == 2) {
                            if (!L1) { const int pos = w32 ? (t & 63) : (t >> 6); rot_lane8<32>(x, p.tab_ax + pos * 16 + 8 * (fq & 1), true, fq < 2); }
                            else     { rot_lane8<16>(x, p.tab_part + t * 8, w32 == 0 && fq < 2, fq == 0); }
                            const bool isq = L1 ? (hbs[bj] < 896) : (hbs[bj] < 2048);
                            if (isq) {
#pragma unroll
                                for (int k = 0; k < 8; ++k) x[k] *= 0.125f * LOG2E;
                            }
                        }
                    } else if (type[bj] == 3) {
#pragma unroll
                        for (int k = 0; k < 8; ++k) x[k] = silu_f(x[k]);
                    }
                    u32x4 w; w.x = cvt_pk_bf16(x[0], x[1]); w.y = cvt_pk_bf16(x[2], x[3]); w.z = cvt_pk_bf16(x[4], x[5]); w.w = cvt_pk_bf16(x[6], x[7]);
                    *(u32x4*)(p.proj + (size_t)T * LDP + u.pn * BM + bj * HALF + wc * 32 + 8 * fq) = w;
                    asm volatile("" ::: "memory");
                }
            }
    }
};
template <bool FIRST>
struct EpiRes {
    static constexpr bool PERM = false, AFTER_DRAIN = false;
    const Params& p; PG8_LAS float* xch;
    __device__ __forceinline__ void operator()(const f32x4 (&acc)[2][2][4][2], const Unit& u, int wr, int wc, int fr, int fq) const {
        const float* res = FIRST ? p.x : p.out;
        asm volatile("" : "+v"(fr), "+v"(fq));
#pragma unroll
        for (int ai = 0; ai < 2; ++ai)
#pragma unroll
            for (int m = 0; m < 4; ++m) {
                const int T = u.pm * BM + ai * HALF + wr * 64 + m * 16 + fr; float ss = 0.f;
#pragma unroll
                for (int bj = 0; bj < 2; ++bj)
#pragma unroll
                    for (int n = 0; n < 2; ++n) {
                        const size_t off = (size_t)T * DM + u.pn * BM + bj * HALF + wc * 32 + n * 16 + 4 * fq;
                        const f32x4 ov = *(const f32x4*)(res + off) + acc[ai][bj][m][n];
                        *(f32x4*)(p.out + off) = ov;
                        if (FIRST) { ss += ov[0] * ov[0] + ov[1] * ov[1] + ov[2] * ov[2] + ov[3] * ov[3];
                            u32x2 w; w.x = cvt_pk_bf16(ov[0], ov[1]); w.y = cvt_pk_bf16(ov[2], ov[3]); *(u32x2*)(p.xb + off) = w; }
                    }
                if (FIRST) { ss += __shfl_xor(ss, 16); ss += __shfl_xor(ss, 32); if (fq == 0) atomicAdd(p.ss1 + T, ss); }
            }
        xch_barrier();
    }
};
}
template <int WHICH>
DI void gemm_phase8(const Params& p, char* lds) {
  constexpr int N = WHICH == 0 ? NE : WHICH == 2 ? NO : 1024;
  pg8::Gemm g; g.A = (WHICH == 0 || WHICH == 2) ? p.xb : p.ob; g.Bt = WHICH == 0 ? p.wt_ine : WHICH == 1 ? p.wt_oute : WHICH == 2 ? p.wt_ino : p.wt_outo; g.M = NTOK; g.N = N; g.K = DM;
  pg8::StaticOrder S; S.init(NTOK, N, (int)gridDim.x, (int)blockIdx.x);
  PG8_LAS unsigned char* l3 = (PG8_LAS unsigned char*)lds;
  PG8_LAS float* xch = (PG8_LAS float*)(l3 + 131072);
  if constexpr (WHICH == 0) { pg8::EpiIn<false> e{p, xch}; pg8::gemm_phase(l3, g, S, e, nullptr); }
  else if constexpr (WHICH == 2) { pg8::EpiIn<true> e{p, xch}; pg8::gemm_phase(l3, g, S, e, nullptr); }
  else if constexpr (WHICH == 1) { pg8::EpiRes<true> e{p, xch}; pg8::gemm_phase(l3, g, S, e, nullptr); }
  else { pg8::EpiRes<false> e{p, xch}; pg8::gemm_phase(l3, g, S, e, nullptr); }
}

template <int KS> DI int kswz(int row, int chunk) { return KS == 128 ? row * 128 + ((chunk ^ ((row >> 1) & 7)) << 4) : row * 256 + ((chunk ^ (row & 7)) << 4); }
template <int DV> DI int v_st(int k, int c) { constexpr int NCS = DV / 32; const int kk = k; return ((kk >> 3) * NCS + (c >> 5)) * 512 + ((kk & 7) * 32 + (c & 31)) * 2; }
DI int v_rd_base(int lane) { return ((lane & 3) << 3) | (((lane >> 2) & 3) << 6) | (((lane >> 4) & 1) << 5) | (((lane >> 5) & 1) << 8); }
template <int OFF> DI s16x4 tr_read(int vb) { s16x4 r; asm volatile("ds_read_b64_tr_b16 %0, %1 offset:%2" : "=&v"(r) : "v"(vb), "i"(OFF) : "memory"); return r; }

template <int DQK, int KS>
DI void qkt(f32x16& p0, f32x16& p1, const char* Ks, const bf16x8* qr, int r32, int hi) {
#pragma unroll
  for (int r = 0; r < 16; ++r) { p0[r] = 0.f; p1[r] = 0.f; }
#pragma unroll
  for (int d0 = 0; d0 < DQK / 16; ++d0) {
    const bf16x8 b0 = *(const bf16x8*)(Ks + kswz<KS>(r32, d0 * 2 + hi));
    const bf16x8 b1 = *(const bf16x8*)(Ks + kswz<KS>(32 + r32, d0 * 2 + hi));
    p0 = MFMA32(b0, qr[d0], p0); p1 = MFMA32(b1, qr[d0], p1);
  }
}
template <int DV, int D0>
DI void pv_one(f32x16& od, int vb, bf16x8 pa0, bf16x8 pa1, bf16x8 pa2, bf16x8 pa3) {
  constexpr int NCS = DV / 32;
#define VOFF(ks, half) (D0 * 512 + (2 * (ks) + (half)) * NCS * 512)
  const s16x4 l0 = tr_read<VOFF(0, 0)>(vb), h0 = tr_read<VOFF(0, 1)>(vb), l1 = tr_read<VOFF(1, 0)>(vb), h1 = tr_read<VOFF(1, 1)>(vb);
  const s16x4 l2 = tr_read<VOFF(2, 0)>(vb), h2 = tr_read<VOFF(2, 1)>(vb), l3 = tr_read<VOFF(3, 0)>(vb), h3 = tr_read<VOFF(3, 1)>(vb);
#undef VOFF
  asm volatile("s_waitcnt lgkmcnt(0)" ::: "memory"); SBAR();
#define PK(L, H) (bf16x8){L[0], L[1], L[2], L[3], H[0], H[1], H[2], H[3]}
  od = MFMA32(PK(l0, h0), pa0, od); od = MFMA32(PK(l1, h1), pa1, od); od = MFMA32(PK(l2, h2), pa2, od); od = MFMA32(PK(l3, h3), pa3, od);
#undef PK
}
template <int DV>
DI void pv_all(f32x16 (&o)[DV / 32], int vb, bf16x8 pa0, bf16x8 pa1, bf16x8 pa2, bf16x8 pa3) {
  pv_one<DV, 0>(o[0], vb, pa0, pa1, pa2, pa3); pv_one<DV, 1>(o[1], vb, pa0, pa1, pa2, pa3);
  if constexpr (DV == 128) { pv_one<DV, 2>(o[2], vb, pa0, pa1, pa2, pa3); pv_one<DV, 3>(o[3], vb, pa0, pa1, pa2, pa3); }
}
#define PK4(P, BASE, OUT) do { u32x4 w = {cvtpk(P[BASE + 0], P[BASE + 1]), cvtpk(P[BASE + 2], P[BASE + 3]), cvtpk(P[BASE + 4], P[BASE + 5]), cvtpk(P[BASE + 6], P[BASE + 7])}; \
    OUT = *reinterpret_cast<bf16x8*>(&w); } while (0)

template <int ND0>
DI void softmax_step(f32x16& t0, f32x16& t1, float& m, float& l, f32x16 (&o)[ND0], bf16x8& pa0, bf16x8& pa1, bf16x8& pa2, bf16x8& pa3) {
  float pmax = t0[0];
#pragma unroll
  for (int r = 1; r < 16; ++r) pmax = fmaxf(pmax, t0[r]);
#pragma unroll
  for (int r = 0; r < 16; ++r) pmax = fmaxf(pmax, t1[r]);
  pmax = half_max(pmax);
  const float mn = fmaxf(m, pmax);
  const float alpha = __builtin_amdgcn_exp2f(m - mn);
  m = mn;
#pragma unroll
  for (int r = 0; r < 16; ++r) { t0[r] = __builtin_amdgcn_exp2f(t0[r] - mn); t1[r] = __builtin_amdgcn_exp2f(t1[r] - mn); }
  float ps = 0.f;
#pragma unroll
  for (int r = 0; r < 16; ++r) ps += t0[r] + t1[r];
  ps = half_sum(ps);
  l = l * alpha + ps;
  if (__any(alpha < 1.f)) {
#pragma unroll
    for (int d = 0; d < ND0; ++d) o[d] = o[d] * alpha;
  }
  PK4(t0, 0, pa0); PK4(t0, 8, pa1); PK4(t1, 0, pa2); PK4(t1, 8, pa3);
}

template <int DQK, int DV>
DI void flash(const u16* __restrict__ Qlane, const u16* __restrict__ Kb, const int ldk, const u16* __restrict__ Vb, const int ldv,
              const float C, const float nMc, f32x16 (&o)[DV / 32], float& l_out, char* lds) {
  constexpr int KS = DQK == 64 ? 128 : 256, KCR = DQK / 8, NKC = (KCR + 7) / 8, VCR = DV / 8, NVC = VCR / 8, ND0 = DV / 32, NQ = DQK / 16;
  constexpr int KBYTES = 64 * KS, ABUF = KBYTES + 64 * DV * 2, NTILE = SEQ / 64;
  const int tid = my_tid(), lane = tid & 63, r32 = lane & 31, hi = lane >> 5;
  bf16x8 qr[NQ];
#pragma unroll
  for (int d0 = 0; d0 < NQ; ++d0) qr[d0] = *(const bf16x8*)(Qlane + d0 * 16);
  int kg[NKC], kl[NKC], vg[NVC], vl[NVC];
#pragma unroll
  for (int i = 0; i < NKC; ++i) { const int c = min(tid + i * NTHR, 64 * KCR - 1), row = c / KCR, cc = c % KCR; kg[i] = row * ldk + cc * 8; kl[i] = kswz<KS>(row, cc); }
#pragma unroll
  for (int i = 0; i < NVC; ++i) { const int c = tid + i * NTHR, key = c / VCR, c8 = c % VCR; vg[i] = key * ldv + c8 * 8; vl[i] = KBYTES + v_st<DV>(key, c8 * 8); }
  const int vb0 = (int)(uintptr_t)lds + KBYTES + v_rd_base(lane);
  float lsum = 0.f;
#pragma unroll
  for (int d = 0; d < ND0; ++d)
#pragma unroll
    for (int r = 0; r < 16; ++r) o[d][r] = 0.f;
  bf16x8 ks[NKC], vs[NVC];
#pragma unroll
  for (int i = 0; i < NKC; ++i) ks[i] = *(const bf16x8*)(Kb + kg[i]);
#pragma unroll
  for (int i = 0; i < NVC; ++i) vs[i] = *(const bf16x8*)(Vb + vg[i]);
#pragma unroll
  for (int i = 0; i < NKC; ++i) *(bf16x8*)(lds + kl[i]) = ks[i];
#pragma unroll
  for (int i = 0; i < NVC; ++i) *(bf16x8*)(lds + vl[i]) = vs[i];
  __syncthreads();
  for (int j = 0; j < NTILE; ++j) {
    const int cur = j & 1;
    if (j + 1 < NTILE) {
      const u16* kn = Kb + (size_t)(j + 1) * 64 * ldk; const u16* vn = Vb + (size_t)(j + 1) * 64 * ldv;
#pragma unroll
      for (int i = 0; i < NKC; ++i) ks[i] = *(const bf16x8*)(kn + kg[i]);
#pragma unroll
      for (int i = 0; i < NVC; ++i) vs[i] = *(const bf16x8*)(vn + vg[i]);
    }
    f32x16 p0, p1; bf16x8 pa0, pa1, pa2, pa3;
    qkt<DQK, KS>(p0, p1, lds + cur * ABUF, qr, r32, hi);
#pragma unroll
    for (int r = 0; r < 16; ++r) { p0[r] = __builtin_amdgcn_exp2f(p0[r]); p1[r] = __builtin_amdgcn_exp2f(p1[r]); }
    { const f32x16 s_ = p0 + p1; lsum += ((s_[0] + s_[1]) + (s_[2] + s_[3])) + ((s_[4] + s_[5]) + (s_[6] + s_[7])) + ((s_[8] + s_[9]) + (s_[10] + s_[11])) + ((s_[12] + s_[13]) + (s_[14] + s_[15])); }
    PK4(p0, 0, pa0); PK4(p0, 8, pa1); PK4(p1, 0, pa2); PK4(p1, 8, pa3);
    pv_all<DV>(o, vb0 + cur * ABUF, pa0, pa1, pa2, pa3);
    if (j + 1 < NTILE) {
      char* nb = lds + (cur ^ 1) * ABUF;
#pragma unroll
      for (int i = 0; i < NKC; ++i) *(bf16x8*)(nb + kl[i]) = ks[i];
#pragma unroll
      for (int i = 0; i < NVC; ++i) *(bf16x8*)(nb + vl[i]) = vs[i];
    }
    __syncthreads();
  }
  l_out = half_sum(lsum);
}

template <int DQK, int DV>
DI void flash_pipe_v1(const u16* __restrict__ Qlane, const u16* __restrict__ Kb, const int ldk, const u16* __restrict__ Vb, const int ldv,
                   const float C, const float nMc, f32x16 (&o)[DV / 32], float& l_out, char* lds) {
  constexpr int KS = DQK == 64 ? 128 : 256, KCR = DQK / 8, NKC = (KCR + 7) / 8, VCR = DV / 8, NVC = VCR / 8, ND0 = DV / 32, NQ = DQK / 16;
  constexpr int KBYTES = 64 * KS, VBYTES = 64 * DV * 2, VOFF0 = 2 * KBYTES, NTILE = SEQ / 64;
  const int tid = my_tid(), lane = tid & 63, r32 = lane & 31, hi = lane >> 5;
  bf16x8 qr[NQ];
#pragma unroll
  for (int d0 = 0; d0 < NQ; ++d0) qr[d0] = *(const bf16x8*)(Qlane + d0 * 16);
  int kg[NKC], kl[NKC], vg[NVC], vl[NVC];
#pragma unroll
  for (int i = 0; i < NKC; ++i) { const int c = min(tid + i * NTHR, 64 * KCR - 1), row = c / KCR, cc = c % KCR; kg[i] = row * ldk + cc * 8; kl[i] = kswz<KS>(row, cc); }
#pragma unroll
  for (int i = 0; i < NVC; ++i) { const int c = tid + i * NTHR, key = c / VCR, c8 = c % VCR; vg[i] = key * ldv + c8 * 8; vl[i] = VOFF0 + v_st<DV>(key, c8 * 8); }
  const int vb0 = (int)(uintptr_t)lds + VOFF0 + v_rd_base(lane);
  float l = 0.f;
#pragma unroll
  for (int d = 0; d < ND0; ++d)
#pragma unroll
    for (int r = 0; r < 16; ++r) o[d][r] = 0.f;
  bf16x8 ks[NKC], vs[NVC];
#define FP_LOADK(J) do { const u16* kn = Kb + (size_t)(J) * 64 * ldk; _Pragma("unroll") for (int i = 0; i < NKC; ++i) ks[i] = *(const bf16x8*)(kn + kg[i]); } while (0)
#define FP_LOADV(J) do { const u16* vn = Vb + (size_t)(J) * 64 * ldv; _Pragma("unroll") for (int i = 0; i < NVC; ++i) vs[i] = *(const bf16x8*)(vn + vg[i]); } while (0)
#define FP_WRITEK(B) do { _Pragma("unroll") for (int i = 0; i < NKC; ++i) *(bf16x8*)(lds + (B) * KBYTES + kl[i]) = ks[i]; } while (0)
#define FP_WRITEV(B) do { _Pragma("unroll") for (int i = 0; i < NVC; ++i) *(bf16x8*)(lds + (B) * VBYTES + vl[i]) = vs[i]; } while (0)
#define FP_PARTIAL(P0) do { _Pragma("unroll") for (int r = 0; r < 16; ++r) P0[r] = __builtin_amdgcn_exp2f(P0[r]); } while (0)
#define FP_FINISH(P0, P1) do { _Pragma("unroll") for (int r = 0; r < 16; ++r) P1[r] = __builtin_amdgcn_exp2f(P1[r]); \
    { const f32x16 s_ = P0 + P1; lsum += ((s_[0] + s_[1]) + (s_[2] + s_[3])) + ((s_[4] + s_[5]) + (s_[6] + s_[7])) + ((s_[8] + s_[9]) + (s_[10] + s_[11])) + ((s_[12] + s_[13]) + (s_[14] + s_[15])); } \
    PK4(P0, 0, pa0); PK4(P0, 8, pa1); PK4(P1, 0, pa2); PK4(P1, 8, pa3); } while (0)
#define FP_STEP(PX0, PX1, PY0, PY1, JJ) do { \
    SBAR(); \
    if ((JJ) + 1 < NTILE) qkt<DQK, KS>(PY0, PY1, lds + (((JJ) + 1) & 1) * KBYTES, qr, r32, hi); \
    FP_FINISH(PX0, PX1); \
    SBAR(); \
    if ((JJ) + 2 < NTILE) FP_LOADK((JJ) + 2); \
    if ((JJ) + 1 < NTILE) FP_LOADV((JJ) + 1); \
    SBAR(); \
    pv_all<DV>(o, vb0 + ((JJ) & 1) * VBYTES, pa0, pa1, pa2, pa3); \
    if ((JJ) + 1 < NTILE) FP_PARTIAL(PY0); \
    SBAR(); \
    if ((JJ) + 2 < NTILE) FP_WRITEK((JJ) & 1); \
    if ((JJ) + 1 < NTILE) FP_WRITEV(((JJ) + 1) & 1); \
    __syncthreads(); } while (0)
  f32x16 pA0, pA1, pB0, pB1; bf16x8 pa0, pa1, pa2, pa3;
  float lsum = 0.f;
  FP_LOADK(0); FP_LOADV(0); FP_WRITEK(0); FP_WRITEV(0); FP_LOADK(1); FP_WRITEK(1);
  __syncthreads();
  qkt<DQK, KS>(pA0, pA1, lds, qr, r32, hi);
  FP_PARTIAL(pA0);
  __syncthreads();
  for (int j = 0; j < NTILE; j += 2) {
    FP_STEP(pA0, pA1, pB0, pB1, j);
    FP_STEP(pB0, pB1, pA0, pA1, j + 1);
  }
#undef FP_LOADK
#undef FP_LOADV
#undef FP_WRITEK
#undef FP_WRITEV
#undef FP_PARTIAL
#undef FP_FINISH
#undef FP_STEP
  l_out = half_sum(lsum);
}

template <int DQK, int DV, bool DEEP>
DI void flash_pipe(const u16* __restrict__ Qlane, const u16* __restrict__ Kb, const int ldk, const u16* __restrict__ Vb, const int ldv,
                   f32x16 (&o)[DV / 32], float& l_out, char* lds) {
  constexpr int KS = DQK == 64 ? 128 : 256, KCR = DQK / 8, NKC = (KCR + 7) / 8, VCR = DV / 8, NVC = VCR / 8, ND0 = DV / 32, NQ = DQK / 16;
  constexpr int KBYTES = 64 * KS, VBYTES = 64 * DV * 2, VOFF0 = 2 * KBYTES, NTILE = SEQ / 64;
  const int tid = my_tid(), lane = tid & 63, r32 = lane & 31, hi = lane >> 5;
  bf16x8 qr[NQ];
#pragma unroll
  for (int d0 = 0; d0 < NQ; ++d0) qr[d0] = *(const bf16x8*)(Qlane + d0 * 16);
  int kg[NKC], kl[NKC], vg[NVC], vl[NVC];
#pragma unroll
  for (int i = 0; i < NKC; ++i) { const int c = min(tid + i * NTHR, 64 * KCR - 1), row = c / KCR, cc = c % KCR; kg[i] = row * ldk + cc * 8; kl[i] = kswz<KS>(row, cc); }
#pragma unroll
  for (int i = 0; i < NVC; ++i) { const int c = tid + i * NTHR, key = c / VCR, c8 = c % VCR; vg[i] = key * ldv + c8 * 8; vl[i] = VOFF0 + v_st<DV>(key, c8 * 8); }
  const int vb0 = (int)(uintptr_t)lds + VOFF0 + v_rd_base(lane);
#pragma unroll
  for (int d = 0; d < ND0; ++d)
#pragma unroll
    for (int r = 0; r < 16; ++r) o[d][r] = 0.f;
  bf16x8 ksA[NKC], vsA[NVC], ksB[NKC], vsB[NVC];
#define FP_LOADK(KSR, J) do { const u16* kn = Kb + (size_t)(J) * 64 * ldk; _Pragma("unroll") for (int i = 0; i < NKC; ++i) KSR[i] = *(const bf16x8*)(kn + kg[i]); } while (0)
#define FP_LOADV(VSR, J) do { const u16* vn = Vb + (size_t)(J) * 64 * ldv; _Pragma("unroll") for (int i = 0; i < NVC; ++i) VSR[i] = *(const bf16x8*)(vn + vg[i]); } while (0)
#define FP_WRITEK(KSR, B) do { _Pragma("unroll") for (int i = 0; i < NKC; ++i) *(bf16x8*)(lds + (B) * KBYTES + kl[i]) = KSR[i]; } while (0)
#define FP_WRITEV(VSR, B) do { _Pragma("unroll") for (int i = 0; i < NVC; ++i) *(bf16x8*)(lds + (B) * VBYTES + vl[i]) = VSR[i]; } while (0)
#define FP_PARTIAL(P0) do { _Pragma("unroll") for (int r = 0; r < 16; ++r) P0[r] = __builtin_amdgcn_exp2f(P0[r]); } while (0)
#define FP_FINISH(P0, P1) do { _Pragma("unroll") for (int r = 0; r < 16; ++r) P1[r] = __builtin_amdgcn_exp2f(P1[r]); \
    { const f32x16 s_ = P0 + P1; lsum += ((s_[0] + s_[1]) + (s_[2] + s_[3])) + ((s_[4] + s_[5]) + (s_[6] + s_[7])) + ((s_[8] + s_[9]) + (s_[10] + s_[11])) + ((s_[12] + s_[13]) + (s_[14] + s_[15])); } \
    PK4(P0, 0, pa0); PK4(P0, 8, pa1); PK4(P1, 0, pa2); PK4(P1, 8, pa3); } while (0)
#define FP_STEP(PX0, PX1, PY0, PY1, KX, VX, KY, VY, JJ) do { \
    SBAR(); \
    if (DEEP) { if ((JJ) + 3 < NTILE) FP_LOADK(KY, (JJ) + 3); if ((JJ) + 2 < NTILE) FP_LOADV(VY, (JJ) + 2); } \
    SBAR(); \
    if ((JJ) + 1 < NTILE) qkt<DQK, KS>(PY0, PY1, lds + (((JJ) + 1) & 1) * KBYTES, qr, r32, hi); \
    FP_FINISH(PX0, PX1); \
    SBAR(); \
    if (!DEEP) { if ((JJ) + 2 < NTILE) FP_LOADK(KX, (JJ) + 2); if ((JJ) + 1 < NTILE) FP_LOADV(VX, (JJ) + 1); } \
    SBAR(); \
    pv_all<DV>(o, vb0 + ((JJ) & 1) * VBYTES, pa0, pa1, pa2, pa3); \
    if ((JJ) + 1 < NTILE) FP_PARTIAL(PY0); \
    SBAR(); \
    if ((JJ) + 2 < NTILE) FP_WRITEK(KX, (JJ) & 1); \
    if ((JJ) + 1 < NTILE) FP_WRITEV(VX, ((JJ) + 1) & 1); \
    __syncthreads(); } while (0)
  f32x16 pA0, pA1, pB0, pB1; bf16x8 pa0, pa1, pa2, pa3;
  float lsum = 0.f;
  FP_LOADK(ksA, 0); FP_LOADV(vsA, 0); FP_LOADK(ksB, 1);
  FP_WRITEK(ksA, 0); FP_WRITEV(vsA, 0); FP_WRITEK(ksB, 1);
  if (DEEP) { FP_LOADK(ksA, 2); FP_LOADV(vsA, 1); }
  __syncthreads();
  qkt<DQK, KS>(pA0, pA1, lds, qr, r32, hi);
  FP_PARTIAL(pA0);
  __syncthreads();
  for (int j = 0; j < NTILE; j += 2) {
    FP_STEP(pA0, pA1, pB0, pB1, ksA, vsA, ksB, vsB, j);
    FP_STEP(pB0, pB1, pA0, pA1, ksB, vsB, ksA, vsA, j + 1);
  }
#undef FP_LOADK
#undef FP_LOADV
#undef FP_WRITEK
#undef FP_WRITEV
#undef FP_PARTIAL
#undef FP_FINISH
#undef FP_STEP
  l_out = half_sum(lsum);
}

template <int DQK>
DI void flash_p2(const u16* __restrict__ Qlane, const u16* __restrict__ Kb, const int ldk, const u16* __restrict__ Vb, const int ldv,
                 f32x16 (&o)[2], float& l_out, char* lds) {
  constexpr int KS = DQK == 64 ? 128 : 256, KCR = DQK / 8, NKC = KCR / 4, NVC = 2, NQ = DQK / 16;
  constexpr int KST = 128 * KS, VST = 16384, VOFF0 = 3 * KST, NPAIR = SEQ / 128;
  const int tid = my_tid(), lane = tid & 63, r32 = lane & 31, hi = lane >> 5;
  bf16x8 qr[NQ];
#pragma unroll
  for (int d0 = 0; d0 < NQ; ++d0) qr[d0] = *(const bf16x8*)(Qlane + d0 * 16);
  int kg[NKC], kl[NKC], vg[NVC], vl[NVC];
#pragma unroll
  for (int i = 0; i < NKC; ++i) { const int c = tid + i * NTHR, row = c / KCR, cc = c % KCR; kg[i] = row * ldk + cc * 8; kl[i] = kswz<KS>(row, cc); }
#pragma unroll
  for (int i = 0; i < NVC; ++i) { const int c = tid + i * NTHR, key = c >> 3, c8 = c & 7; vg[i] = key * ldv + c8 * 8; vl[i] = VOFF0 + (key >> 6) * 8192 + v_st<64>(key & 63, c8 * 8); }
  const int vb0 = (int)(uintptr_t)lds + VOFF0 + v_rd_base(lane);
#pragma unroll
  for (int d = 0; d < 2; ++d)
#pragma unroll
    for (int r = 0; r < 16; ++r) o[d][r] = 0.f;
  bf16x8 ks[NKC], vs[NVC];
#define P2_LOADK(M) do { const u16* kn = Kb + (size_t)(M) * 128 * ldk; _Pragma("unroll") for (int i = 0; i < NKC; ++i) ks[i] = *(const bf16x8*)(kn + kg[i]); } while (0)
#define P2_LOADV(M) do { const u16* vn = Vb + (size_t)(M) * 128 * ldv; _Pragma("unroll") for (int i = 0; i < NVC; ++i) vs[i] = *(const bf16x8*)(vn + vg[i]); } while (0)
#define P2_WRITEK(OFF) do { _Pragma("unroll") for (int i = 0; i < NKC; ++i) *(bf16x8*)(lds + (OFF) + kl[i]) = ks[i]; } while (0)
#define P2_WRITEV(S) do { _Pragma("unroll") for (int i = 0; i < NVC; ++i) *(bf16x8*)(lds + (S) * VST + vl[i]) = vs[i]; } while (0)
#define P2_PARTIAL(P0) do { _Pragma("unroll") for (int r = 0; r < 16; ++r) P0[r] = __builtin_amdgcn_exp2f(P0[r]); } while (0)
#define P2_FINISH(P0, P1) do { _Pragma("unroll") for (int r = 0; r < 16; ++r) P1[r] = __builtin_amdgcn_exp2f(P1[r]); \
    { const f32x16 s_ = P0 + P1; lsum += ((s_[0] + s_[1]) + (s_[2] + s_[3])) + ((s_[4] + s_[5]) + (s_[6] + s_[7])) + ((s_[8] + s_[9]) + (s_[10] + s_[11])) + ((s_[12] + s_[13]) + (s_[14] + s_[15])); } \
    PK4(P0, 0, pa0); PK4(P0, 8, pa1); PK4(P1, 0, pa2); PK4(P1, 8, pa3); } while (0)
  f32x16 pA0, pA1, pB0, pB1; bf16x8 pa0, pa1, pa2, pa3;
  float lsum = 0.f;
  P2_LOADK(0); P2_WRITEK(0); P2_LOADK(1); P2_WRITEK(KST); P2_LOADV(0); P2_WRITEV(0);
  __syncthreads();
  qkt<DQK, KS>(pA0, pA1, lds, qr, r32, hi);
  P2_PARTIAL(pA0);
  __syncthreads();
  int k0 = 0, k1 = KST, k2 = 2 * KST;
  for (int m = 0; m < NPAIR; ++m) {
    const int s = m & 1;
    SBAR();
    if (m + 2 < NPAIR) P2_LOADK(m + 2);
    if (m + 1 < NPAIR) P2_LOADV(m + 1);
    SBAR();
    qkt<DQK, KS>(pB0, pB1, lds + k0 + 64 * KS, qr, r32, hi);
    P2_FINISH(pA0, pA1);
    SBAR();
    pv_all<64>(o, vb0 + s * VST, pa0, pa1, pa2, pa3);
    P2_PARTIAL(pB0);
    SBAR();
    if (m + 1 < NPAIR) qkt<DQK, KS>(pA0, pA1, lds + k1, qr, r32, hi);
    P2_FINISH(pB0, pB1);
    SBAR();
    pv_all<64>(o, vb0 + s * VST + 8192, pa0, pa1, pa2, pa3);
    if (m + 1 < NPAIR) P2_PARTIAL(pA0);
    SBAR();
    if (m + 2 < NPAIR) P2_WRITEK(k2);
    { const int t_ = k0; k0 = k1; k1 = k2; k2 = t_; }
    if (m + 1 < NPAIR) P2_WRITEV(s ^ 1);
    __syncthreads();
  }
#undef P2_LOADK
#undef P2_LOADV
#undef P2_WRITEK
#undef P2_WRITEV
#undef P2_PARTIAL
#undef P2_FINISH
  l_out = half_sum(lsum);
}

template <int ND0>
DI void store_gated(const f32x16 (&o)[ND0], const u16* gp, u16* op, int hi) {
#pragma unroll
  for (int d = 0; d < ND0; ++d) { f32x16 g; load_blk_bf16(gp + 32 * d, hi, g); f32x16 v = o[d] * g; store_blk_bf16(op + 32 * d, v, hi); }
}

template <int DV>
DI void store_gated_staged(const f32x16 (&o)[DV / 32], const u16* __restrict__ gate0, const int ldg, u16* __restrict__ out0, char* lds) {
  constexpr int STR = DV * 4 + 16, NCH = DV / 8;
  const int tid = my_tid(), wave = tid >> 6, lane = tid & 63, r32 = lane & 31, hi = lane >> 5;
  char* rowp = lds + (wave * 32 + r32) * STR;
#pragma unroll
  for (int d = 0; d < DV / 32; ++d)
#pragma unroll
    for (int q = 0; q < 4; ++q) { f32x4 v; v[0] = o[d][4 * q]; v[1] = o[d][4 * q + 1]; v[2] = o[d][4 * q + 2]; v[3] = o[d][4 * q + 3]; *(f32x4*)(rowp + (32 * d + 8 * q + 4 * hi) * 4) = v; }
  __syncthreads();
#pragma unroll
  for (int i = 0; i < (256 * NCH) / NTHR; ++i) {
    const int c = tid + i * NTHR, row = c / NCH, ch = c % NCH;
    const f32x4 a = *(const f32x4*)(lds + row * STR + ch * 32), b = *(const f32x4*)(lds + row * STR + ch * 32 + 16);
    const u32x4 g = *(const u32x4*)(gate0 + (size_t)row * ldg + ch * 8);
    u32x4 w;
    w.x = cvtpk(a[0] * bflo(g.x), a[1] * bfhi(g.x)); w.y = cvtpk(a[2] * bflo(g.y), a[3] * bfhi(g.y));
    w.z = cvtpk(b[0] * bflo(g.z), b[1] * bfhi(g.z)); w.w = cvtpk(b[2] * bflo(g.w), b[3] * bfhi(g.w));
    *(u32x4*)(out0 + (size_t)row * LDX + ch * 8) = w;
  }
  __syncthreads();
}

DI void na_item(const Params& p, int b, int h, int rp, char* lds) {
  constexpr int KBYTES = 8192, ABUF = 16384;
  const int tid = my_tid(), wave = tid >> 6, lane = tid & 63, r32 = lane & 31, hi = lane >> 5;
  float* tbl = (float*)(lds + 2 * ABUF);
  for (int i = tid; i < 465; i += NTHR) tbl[i] = p.rpb_a[h * 465 + i] * LOG2E;
  const int gr = 4 * rp + (wave >> 1), cq = (wave & 1) * 32 + r32;
  const int r0w = min(max(gr - 4, 0), 56), ra = min(max(4 * rp - 4, 0), 56), rb = min(max(4 * rp - 1, 0), 56) + 8;
  const int c0 = min(max(cq - 8, 0), 48);
  const size_t tb = (size_t)b * SEQ;
  const u16* Qlane = p.proj + (tb + gr * 64 + cq) * NE + h * 64 + hi * 8;
  const u16* Kb = p.proj + tb * NE + 512 + h * 64; const u16* Vb = p.proj + tb * NE + 1024 + h * 64;
  bf16x8 qr[4];
#pragma unroll
  for (int d0 = 0; d0 < 4; ++d0) qr[d0] = *(const bf16x8*)(Qlane + d0 * 16);
  int kg[1], kl[1], vl[1];
#pragma unroll
  for (int i = 0; i < 1; ++i) { const int c = tid, row = c >> 3, cc = c & 7; kg[i] = row * NE + cc * 8; kl[i] = kswz<128>(row, cc); vl[i] = KBYTES + v_st<64>(row, cc * 8); }
  const int vb0 = (int)(uintptr_t)lds + KBYTES + v_rd_base(lane);
  float m = -1e30f, l = 0.f; f32x16 o[2];
#pragma unroll
  for (int d = 0; d < 2; ++d)
#pragma unroll
    for (int r = 0; r < 16; ++r) o[d][r] = 0.f;
  bf16x8 ks[1], vs[1];
  {
    const u16* kn = Kb + (size_t)ra * 64 * NE; const u16* vn = Vb + (size_t)ra * 64 * NE;
#pragma unroll
    for (int i = 0; i < 1; ++i) { ks[i] = *(const bf16x8*)(kn + kg[i]); vs[i] = *(const bf16x8*)(vn + kg[i]); }
#pragma unroll
    for (int i = 0; i < 1; ++i) { *(bf16x8*)(lds + kl[i]) = ks[i]; *(bf16x8*)(lds + vl[i]) = vs[i]; }
  }
  __syncthreads();
  const float C = 0.125f * LOG2E;
  const int nt = rb - ra;
  for (int j = 0; j < nt; ++j) {
    const int cur = j & 1, kr = ra + j;
    if (j + 1 < nt) {
      const u16* kn = Kb + (size_t)(kr + 1) * 64 * NE; const u16* vn = Vb + (size_t)(kr + 1) * 64 * NE;
#pragma unroll
      for (int i = 0; i < 1; ++i) { ks[i] = *(const bf16x8*)(kn + kg[i]); vs[i] = *(const bf16x8*)(vn + kg[i]); }
    }
    if (kr >= r0w && kr < r0w + 8) {
      f32x16 p0, p1; bf16x8 pa0, pa1, pa2, pa3;
      qkt<64, 128>(p0, p1, lds + cur * ABUF, qr, r32, hi);
      const int rowoff = (kr - gr + 7) * 31 + 15 - cq;
#pragma unroll
      for (int r = 0; r < 16; ++r) {
        const int kc = crow(r, hi);
        const float b0 = tbl[rowoff + kc], b1 = tbl[rowoff + kc + 32];
        p0[r] = ((unsigned)(kc - c0) < 16u) ? fmaf(p0[r], C, b0) : -1e30f;
        p1[r] = ((unsigned)(kc + 32 - c0) < 16u) ? fmaf(p1[r], C, b1) : -1e30f;
      }
      softmax_step<2>(p0, p1, m, l, o, pa0, pa1, pa2, pa3);
      pv_all<64>(o, vb0 + cur * ABUF, pa0, pa1, pa2, pa3);
    }
    if (j + 1 < nt) {
      char* nb = lds + (cur ^ 1) * ABUF;
#pragma unroll
      for (int i = 0; i < 1; ++i) { *(bf16x8*)(nb + kl[i]) = ks[i]; *(bf16x8*)(nb + vl[i]) = vs[i]; }
    }
    __syncthreads();
  }
  const float inv = 1.f / l;
  o[0] = o[0] * inv; o[1] = o[1] * inv;
  const size_t T = tb + gr * 64 + cq;
  { const size_t T0 = tb + (size_t)rp * 256; store_gated_staged<64>(o, p.proj + T0 * NE + 2304 + h * 64, NE, p.ob + T0 * LDX + h * 64, lds); }
}

DI void attn_phase_even(const Params& p, char* lds) {
  const int wave = my_tid() >> 6, lane = my_tid() & 63, r32 = lane & 31, hi = lane >> 5;
  for (int t = blockIdx.x; t < 1024; t += gridDim.x) { const int b = t & 7, idx = t >> 3; na_item(p, b, idx >> 4, idx & 15, lds); }
  for (int t = blockIdx.x; t < 1024; t += gridDim.x) {
    const int b = t & 7, idx = t >> 3, h = idx >> 4, qb = idx & 15, kvh = h >> 2;
    const size_t tb = (size_t)b * SEQ, T = tb + qb * 256 + wave * 32 + r32;
    f32x16 o[2]; float l;
    flash_p2<64>(p.proj + T * NE + 1536 + h * 64 + hi * 8, p.proj + tb * NE + 2048 + kvh * 64, NE, p.proj + tb * NE + 2176 + kvh * 64, NE, o, l, lds);
    const float inv = 1.f / l; o[0] = o[0] * inv; o[1] = o[1] * inv;
    { const size_t T0 = tb + (size_t)qb * 256; store_gated_staged<64>(o, p.proj + T0 * NE + 2304 + 512 + h * 64, NE, p.ob + T0 * LDX + 512 + h * 64, lds); }
  }
}
DI void attn_phase_odd(const Params& p, char* lds) {
  const int wave = my_tid() >> 6, lane = my_tid() & 63, r32 = lane & 31, hi = lane >> 5;
  for (int t = blockIdx.x; t < 1024; t += gridDim.x) {
    const int b = t & 7, idx = t >> 3, h = idx >> 4, qb = idx & 15;
    const size_t tb = (size_t)b * SEQ, T = tb + qb * 256 + wave * 32 + r32;
    f32x16 o[2]; float l;
    flash_p2<96>(p.qc + T * 768 + h * 96 + hi * 8, p.kc + tb * 768 + h * 96, 768, p.vc + tb * 512 + h * 64, 512, o, l, lds);
    const float inv = 1.f / l; o[0] = o[0] * inv; o[1] = o[1] * inv;
    { const size_t T0 = tb + (size_t)qb * 256; store_gated_staged<64>(o, p.proj + T0 * NO + 1920 + h * 64, NO, p.ob + T0 * LDX + h * 64, lds); }
  }
  const float lam = p.lam[0], nMd = -p.lam[3] * LOG2E;
  for (int t = blockIdx.x; t < 512; t += gridDim.x) {
    const int b = t & 7, idx = t >> 3, h = idx >> 4, qb = idx & 15;
    const size_t tb = (size_t)b * SEQ, T = tb + qb * 256 + wave * 32 + r32;
    f32x16 o1[4]; float l1, l2;
    const u16* vb = p.proj + tb * NO + 1408 + h * 128;
    float* stash = (float*)p.xb + (size_t)blockIdx.x * 32768 + my_tid() * 64;
    flash<64, 128>(p.proj + T * NO + 384 + h * 128 + hi * 8, p.proj + tb * NO + 896 + h * 128, NO, vb, NO, 0.125f * LOG2E, nMd, o1, l1, lds);
    { const float inv = 1.f / l1;
#pragma unroll
      for (int d = 0; d < 4; ++d)
#pragma unroll
        for (int q = 0; q < 4; ++q) { f32x4 v; v[0] = o1[d][4 * q] * inv; v[1] = o1[d][4 * q + 1] * inv; v[2] = o1[d][4 * q + 2] * inv; v[3] = o1[d][4 * q + 3] * inv; *(f32x4*)(stash + (d * 4 + q) * 4) = v; } }
    flash<64, 128>(p.proj + T * NO + 384 + h * 128 + 64 + hi * 8, p.proj + tb * NO + 896 + h * 128 + 64, NO, vb, NO, 0.125f * LOG2E, nMd, o1, l2, lds);
    const float f = lam / l2; float ss = 0.f;
#pragma unroll
    for (int d = 0; d < 4; ++d) {
#pragma unroll
      for (int q = 0; q < 4; ++q) { const f32x4 v = *(const f32x4*)(stash + (d * 4 + q) * 4);
#pragma unroll
        for (int j = 0; j < 4; ++j) o1[d][4 * q + j] = v[j] - o1[d][4 * q + j] * f; }
      ss += sumsq16(o1[d]);
    }
    ss = half_sum(ss);
    const float ri = rsqrtf(ss * (1.f / 128) + EPS) * (1.f - LAM_INIT);
#pragma unroll
    for (int d = 0; d < 4; ++d) { f32x16 g; load_blk_f32(p.g_sub_d + 32 * d, hi, g); o1[d] = o1[d] * ri * g; }
    { const size_t T0 = tb + (size_t)qb * 256; store_gated_staged<128>(o1, p.proj + T0 * NO + 1920 + 512 + h * 128, NO, p.ob + T0 * LDX + 512 + h * 128, lds); }
  }
}

DI void grid_bar(unsigned* cnt, unsigned target) {
  asm volatile("s_waitcnt vmcnt(0)" ::: "memory");
  __syncthreads();
  if (threadIdx.x == 0) {
    __builtin_amdgcn_fence(__ATOMIC_RELEASE, "agent");
    asm volatile("s_waitcnt vmcnt(0)" ::: "memory");
    __hip_atomic_fetch_add(cnt, 1u, __ATOMIC_RELAXED, __HIP_MEMORY_SCOPE_AGENT);
    unsigned spins = 0;
    while (__hip_atomic_load(cnt, __ATOMIC_RELAXED, __HIP_MEMORY_SCOPE_AGENT) < target) { __builtin_amdgcn_s_sleep(2); if (++spins > (1u << 24)) break; }
    __builtin_amdgcn_fence(__ATOMIC_ACQUIRE, "agent");
    asm volatile("s_waitcnt vmcnt(0)" ::: "memory");
  }
  __syncthreads();
}

constexpr int LDS_BYTES = 147456;
__global__ void __launch_bounds__(512, 2) mega(Params p) {
  extern __shared__ __attribute__((aligned(16))) char lds[];
  cg::grid_group grid = cg::this_grid();
  const int lo = p.phase_lo, hi_ = p.phase_hi;
#ifndef PROBE_REPEAT
#define PROBE_REPEAT -1
#endif
#define PHASE(k, body) if (lo <= k && k <= hi_) { if (k > lo) { if (k == 1) grid.sync(); else grid_bar(p.bar, (unsigned)(k - 1) * gridDim.x); } body; if (k == PROBE_REPEAT) { grid.sync(); body; } }
  PHASE(0, phase0(p))
  PHASE(1, gemm_phase8<0>(p, lds))
  PHASE(2, attn_phase_even(p, lds))
  PHASE(3, gemm_phase8<1>(p, lds))
  PHASE(4, gemm_phase8<2>(p, lds))
  PHASE(5, upproj_phase(p, lds))
  PHASE(6, attn_phase_odd(p, lds))
  PHASE(7, gemm_phase8<3>(p, lds))
#undef PHASE
}

#ifndef NLAUNCH
#define NLAUNCH 1
#endif
extern "C" void kernel_launch(void* const* d_in, const int* in_sizes, int n_in, void* d_out, int out_size, void* d_ws, size_t ws_size, hipStream_t stream) {
  static int grid_blocks = 0;
  if (!grid_blocks) {
    int dev = 0, cus = 0, per_cu = 0;
    (void)hipGetDevice(&dev);
    (void)hipDeviceGetAttribute(&cus, hipDeviceAttributeMultiprocessorCount, dev);
    (void)hipFuncSetAttribute((const void*)mega, hipFuncAttributeMaxDynamicSharedMemorySize, LDS_BYTES);
    (void)hipOccupancyMaxActiveBlocksPerMultiprocessor(&per_cu, mega, NTHR, LDS_BYTES);
    if (per_cu > 1) per_cu = 1;
    if (per_cu < 1) per_cu = 1;
    grid_blocks = cus * per_cu;
  }
  Params p;
  memset(&p, 0, sizeof(p));
  const float** fp = (const float**)&p;
  for (int i = 0; i < 25; ++i) fp[i] = (const float*)d_in[i];
  p.out = (float*)d_out;
  char* w = (char*)d_ws; size_t off = 0;
  auto take = [&](size_t bytes) { char* r = w + off; off += (bytes + 255) & ~(size_t)255; return r; };
  p.xb = (u16*)take((size_t)NTOK * LDX * 2);
  p.proj = (u16*)take((size_t)NTOK * NE * 2);
  p.ob = (u16*)take((size_t)NTOK * LDX * 2);
  p.qc = (u16*)take((size_t)NTOK * 768 * 2);
  p.kc = (u16*)take((size_t)NTOK * 768 * 2);
  p.vc = (u16*)take((size_t)NTOK * 512 * 2);
  p.wt_ine = (u16*)take((size_t)NE * LDX * 2);
  p.wt_oute = (u16*)take((size_t)1024 * LDX * 2);
  p.wt_ino = (u16*)take((size_t)NO * LDX * 2);
  p.wt_cq = (u16*)take((size_t)768 * 256 * 2);
  p.wt_ckv = (u16*)take((size_t)1024 * 128 * 2);
  p.wt_outo = (u16*)take((size_t)1024 * LDX * 2);
  p.rs0 = (float*)take(NTOK * 4); p.ss1 = (float*)take(NTOK * 4); p.sscq = (float*)take(NTOK * 4); p.ssckv = (float*)take(NTOK * 4);
  p.lam = (float*)take(256);
  p.bar = (unsigned*)take(256);
  p.tab_ax = (float2*)take(64 * 16 * 8); p.tab_mla = (float2*)take(4096 * 16 * 8); p.tab_part = (float2*)take(4096 * 8 * 8);
  if (off > ws_size) { fprintf(stderr, "workspace too small: need %zu have %zu\n", off, ws_size); return; }
  for (int i = 0; i < 16; ++i) p.inv16[i] = (float)pow(10000.0, -(double)i / 16.0);
  for (int i = 0; i < 8; ++i) p.inv8[i] = (float)pow(500000.0, -(double)i / 8.0);
#if NLAUNCH == 1
  p.phase_lo = 0; p.phase_hi = 7;
  void* args[] = {&p};
  hipError_t e = hipLaunchCooperativeKernel((void*)mega, dim3(grid_blocks), dim3(NTHR), args, LDS_BYTES, stream);
  if (e != hipSuccess) fprintf(stderr, "cooperative launch failed: %s (grid %d)\n", hipGetErrorString(e), grid_blocks);
#else
  for (int ph = 0; ph < 8; ++ph) { p.phase_lo = ph; p.phase_hi = ph; hipLaunchKernelGGL(mega, dim3(grid_blocks), dim3(NTHR), LDS_BYTES, stream, p); }
#endif
}
```

```cpp
#include <hip/hip_runtime.h>
#include <hip/hip_cooperative_groups.h>
#include <cstdio>
#include <cstdint>
#include <cmath>
#include <cstring>
namespace cg = cooperative_groups;

typedef unsigned short u16;
using bf16x8 = __attribute__((ext_vector_type(8))) short;
using s16x4  = __attribute__((ext_vector_type(4))) short;
using f32x16 = __attribute__((ext_vector_type(16))) float;
using f32x4  = __attribute__((ext_vector_type(4))) float;
using u32x4  = __attribute__((ext_vector_type(4))) unsigned;
using u32x2  = __attribute__((ext_vector_type(2))) unsigned;

#define DI __device__ __forceinline__
#define MFMA32(a, b, c) __builtin_amdgcn_mfma_f32_32x32x16_bf16((a), (b), (c), 0, 0, 0)
#define SBAR() __builtin_amdgcn_sched_barrier(0)

constexpr int NTOK = 32768, SEQ = 4096, DM = 1024, NE = 3328, NO = 3072;
constexpr int NTHR = 512, NWAVE = 8;
constexpr int LDX = 1024;
constexpr float EPS = 1e-6f, LOG2E = 1.4426950408889634f;
constexpr float LAM_INIT = 0.35550906759096930f;

struct Params {
  const float *x, *norm_e, *w_in_e, *gq_a, *gk_a, *rpb_a, *gq_b, *gk_b, *w_out_e,
      *norm_o, *w_in_o, *g_cq, *w_cq_b, *g_ckv, *w_ckv_b, *gq_c, *gk_c, *gq_d, *gk_d,
      *lam_q1, *lam_k1, *lam_q2, *lam_k2, *g_sub_d, *w_out_o;
  float* out;
  u16 *xb, *proj, *ob, *qc, *kc, *vc, *wt_ine, *wt_oute, *wt_ino, *wt_cq, *wt_ckv, *wt_outo;
  float *rs0, *ss1, *sscq, *ssckv, *lam;
  unsigned* bar;
  float2 *tab_ax, *tab_mla, *tab_part;
  float inv16[16];
  float inv8[8];
  int phase_lo, phase_hi;
};

DI int my_tid() { int t = threadIdx.x; asm volatile("" : "+v"(t)); return t; }
DI int crow(int r, int hi) { return (r & 3) + 8 * (r >> 2) + 4 * hi; }
DI unsigned cvtpk(float lo, float hi) { unsigned r; asm volatile("v_cvt_pk_bf16_f32 %0, %1, %2" : "=v"(r) : "v"(lo), "v"(hi)); return r; }
DI float bflo(unsigned w) { return __uint_as_float(w << 16); }
DI float bfhi(unsigned w) { return __uint_as_float(w & 0xffff0000u); }
DI float half_sum(float v) {
  auto rr = __builtin_amdgcn_permlane32_swap(__float_as_uint(v), __float_as_uint(v), false, false);
  return __uint_as_float(rr[0]) + __uint_as_float(rr[1]);
}
DI float half_max(float v) {
  auto rr = __builtin_amdgcn_permlane32_swap(__float_as_uint(v), __float_as_uint(v), false, false);
  return fmaxf(__uint_as_float(rr[0]), __uint_as_float(rr[1]));
}
DI float wave_sum(float v) {
  v += __shfl_xor(v, 32); v += __shfl_xor(v, 16); v += __shfl_xor(v, 8); v += __shfl_xor(v, 4); v += __shfl_xor(v, 2); v += __shfl_xor(v, 1);
  return v;
}
DI void store_blk_bf16(u16* rowp, const f32x16& v, int hi) {
#pragma unroll
  for (int q = 0; q < 4; ++q) { u32x2 w; w.x = cvtpk(v[4 * q], v[4 * q + 1]); w.y = cvtpk(v[4 * q + 2], v[4 * q + 3]); *(u32x2*)(rowp + 8 * q + 4 * hi) = w; }
}
DI void load_blk_f32(const float* g, int hi, f32x16& o) {
#pragma unroll
  for (int q = 0; q < 4; ++q) { f32x4 t = *(const f32x4*)(g + 8 * q + 4 * hi); o[4 * q] = t[0]; o[4 * q + 1] = t[1]; o[4 * q + 2] = t[2]; o[4 * q + 3] = t[3]; }
}
DI void load_blk_bf16(const u16* g, int hi, f32x16& o) {
#pragma unroll
  for (int q = 0; q < 4; ++q) { u32x2 w = *(const u32x2*)(g + 8 * q + 4 * hi); o[4 * q] = bflo(w.x); o[4 * q + 1] = bfhi(w.x); o[4 * q + 2] = bflo(w.y); o[4 * q + 3] = bfhi(w.y); }
}
DI float sumsq16(const f32x16& v) { float s = 0;
#pragma unroll
  for (int r = 0; r < 16; ++r) s = fmaf(v[r], v[r], s); return s; }
DI void rot16(f32x16& v, const float2* tab, int hi) {
#pragma unroll
  for (int r = 0; r < 8; ++r) { const float2 cs = tab[crow(r, hi)]; const float a = v[r], b = v[r + 8]; v[r] = a * cs.x - b * cs.y; v[r + 8] = b * cs.x + a * cs.y; }
}
DI void rot8(f32x16& v, const float2* tab, int hi) {
#pragma unroll
  for (int r = 0; r < 4; ++r) { const float2 cs = tab[r + 4 * hi]; const float a = v[r], b = v[r + 4]; v[r] = a * cs.x - b * cs.y; v[r + 4] = b * cs.x + a * cs.y; }
}
DI float silu(float v) { return v / (1.f + __expf(-v)); }

DI void sincos_rev(double f, float& c, float& s) {
  const double q = floor(4.0 * f + 0.5), y = f - 0.25 * q, th = 6.283185307179586 * y, t2 = th * th;
  const double sn = th * (1.0 + t2 * (-1.0 / 6 + t2 * (1.0 / 120 + t2 * (-1.0 / 5040 + t2 * (1.0 / 362880 + t2 * (-1.0 / 39916800 + t2 * (1.0 / 6227020800.0)))))));
  const double cs = 1.0 + t2 * (-0.5 + t2 * (1.0 / 24 + t2 * (-1.0 / 720 + t2 * (1.0 / 40320 + t2 * (-1.0 / 3628800 + t2 * (1.0 / 479001600.0 + t2 * (-1.0 / 87178291200.0)))))));
  const int qi = ((int)q) & 3;
  const double cc = qi == 0 ? cs : qi == 1 ? -sn : qi == 2 ? -cs : sn;
  const double ss = qi == 0 ? sn : qi == 1 ? cs : qi == 2 ? -sn : -cs;
  c = (float)cc; s = (float)ss;
}
DI float2 angle_cs(float pos, float inv) {
  const float ang = __fmul_rn(pos, inv);
  double rev = (double)ang * 0.15915494309189535; rev -= floor(rev);
  float2 r; sincos_rev(rev, r.x, r.y); return r;
}
template <int MODE>
DI void wtrans(const float* __restrict__ W, int K, int N, int Npad, const float* __restrict__ gain, u16* __restrict__ Wt, int ldw, int gt, int gn) {
  const int total = (K / 8) * Npad;
  for (int idx = gt; idx < total; idx += gn) {
    const int n = idx % Npad, kc = idx / Npad;
    int src = n;
    if (MODE == 1) src = n < 384 ? n : (n < 2944 ? n + 32 : (n < 2976 ? n - 2944 + 384 : -1));
    u32x4 w;
#pragma unroll
    for (int j = 0; j < 4; ++j) {
      const int k = kc * 8 + 2 * j; float a = 0.f, b = 0.f;
      if (src >= 0) { a = W[(size_t)k * N + src]; b = W[(size_t)(k + 1) * N + src]; if (gain) { a *= gain[k]; b *= gain[k + 1]; } }
      w[j] = cvtpk(a, b);
    }
    *(u32x4*)(Wt + (size_t)n * ldw + kc * 8) = w;
  }
}
DI void phase0(const Params& p) {
  const int tid = my_tid(), gt = blockIdx.x * NTHR + tid, gn = gridDim.x * NTHR, wave = tid >> 6, lane = tid & 63;
  for (int i = gt; i < NTOK; i += gn) { p.ss1[i] = 0.f; p.sscq[i] = 0.f; p.ssckv[i] = 0.f; }
  for (int row = blockIdx.x * NWAVE + wave; row < NTOK; row += gridDim.x * NWAVE) {
    const float* xr = p.x + (size_t)row * DM; f32x4 v[4]; float ss = 0.f;
#pragma unroll
    for (int i = 0; i < 4; ++i) { v[i] = *(const f32x4*)(xr + i * 256 + lane * 4); ss += v[i][0] * v[i][0] + v[i][1] * v[i][1] + v[i][2] * v[i][2] + v[i][3] * v[i][3]; }
    ss = wave_sum(ss);
    if (lane == 0) p.rs0[row] = rsqrtf(ss * (1.f / DM) + EPS);
#pragma unroll
    for (int i = 0; i < 4; ++i) { u32x2 w; w.x = cvtpk(v[i][0], v[i][1]); w.y = cvtpk(v[i][2], v[i][3]); *(u32x2*)(p.xb + (size_t)row * LDX + i * 256 + lane * 4) = w; }
  }
  wtrans<0>(p.w_in_e, 1024, NE, NE, p.norm_e, p.wt_ine, LDX, gt, gn);
  wtrans<0>(p.w_out_e, 1024, 1024, 1024, nullptr, p.wt_oute, LDX, gt, gn);
  wtrans<1>(p.w_in_o, 1024, 2976, NO, p.norm_o, p.wt_ino, LDX, gt, gn);
  wtrans<0>(p.w_cq_b, 256, 768, 768, p.g_cq, p.wt_cq, 256, gt, gn);
  wtrans<0>(p.w_ckv_b, 128, 1024, 1024, p.g_ckv, p.wt_ckv, 128, gt, gn);
  wtrans<0>(p.w_out_o, 1024, 1024, 1024, nullptr, p.wt_outo, LDX, gt, gn);
  for (int idx = gt; idx < 4096 * 16; idx += gn) p.tab_mla[idx] = angle_cs((float)(idx >> 4), p.inv16[idx & 15]);
  for (int idx = gt; idx < 4096 * 8; idx += gn) p.tab_part[idx] = angle_cs((float)(idx >> 3), p.inv8[idx & 7]);
  for (int idx = gt; idx < 64 * 16; idx += gn) p.tab_ax[idx] = angle_cs((float)(idx >> 4), p.inv16[idx & 15]);
  if (blockIdx.x == 0 && wave == 0) {
    float a = wave_sum(p.lam_q1[lane] * p.lam_k1[lane]), b = wave_sum(p.lam_q2[lane] * p.lam_k2[lane]);
    if (lane == 0) p.lam[0] = expf(a) - expf(b) + LAM_INIT;
    if (lane == 0) __hip_atomic_store(p.bar, 0u, __ATOMIC_RELAXED, __HIP_MEMORY_SCOPE_AGENT);
    float gq = fabsf(p.gq_b[lane]), gk = fabsf(p.gk_b[lane]);
    float gcq = fmaxf(fabsf(p.gq_c[lane]), lane < 32 ? fabsf(p.gq_c[64 + lane]) : 0.f), gck = fmaxf(fabsf(p.gk_c[lane]), lane < 32 ? fabsf(p.gk_c[64 + lane]) : 0.f);
    float gdq = fabsf(p.gq_d[lane]), gdk = fabsf(p.gk_d[lane]);
#pragma unroll
    for (int s = 32; s >= 1; s >>= 1) { gq = fmaxf(gq, __shfl_xor(gq, s)); gk = fmaxf(gk, __shfl_xor(gk, s)); gcq = fmaxf(gcq, __shfl_xor(gcq, s)); gck = fmaxf(gck, __shfl_xor(gck, s));
      gdq = fmaxf(gdq, __shfl_xor(gdq, s)); gdk = fmaxf(gdk, __shfl_xor(gdk, s)); }
    if (lane == 0) { p.lam[1] = 8.f * gq * gk; p.lam[2] = 9.797958971132712f * gcq * gck; p.lam[3] = 8.f * gdq * gdk; }
  }
}

#define LAS3 __attribute__((address_space(3)))
DI void dma16(const void* g, char* lds_uniform) {
  __builtin_amdgcn_global_load_lds((const unsigned*)g, (LAS3 unsigned*)(LAS3 char*)lds_uniform, 16, 0, 0);
}
template <int WM, int WN, int MI, int NI>
DI void gemm_mainloop(const u16* __restrict__ A, const int lda, const u16* __restrict__ Bt, const int ldb, const int K, char* lds, f32x16 (&acc)[MI][NI]) {
  constexpr int BM = WM * MI * 32, BN = WN * NI * 32, BNS = (BN + 63) / 64 * 64, ACH = BM / 64, BCH = BNS / 64, ABYTES = BM * 128, BUF = (BM + BNS) * 128;
  const int tid = my_tid(), wave = __builtin_amdgcn_readfirstlane(tid >> 6), lane = tid & 63, r32 = lane & 31, hi = lane >> 5;
  const int wr = wave / WN, wc = wave % WN;
  const int srow = wave * 8 + (lane >> 3), spos = lane & 7, schunk = spos ^ ((srow >> 1) & 7);
  const u16* ag = A + (size_t)srow * lda + schunk * 8;
  const u16* bg = Bt + (size_t)srow * ldb + schunk * 8;
  const int sw = (r32 >> 1) & 7;
  const int abase = (wr * MI * 32 + r32) * 128, bbase = ABYTES + (wc * NI * 32 + r32) * 128;
#pragma unroll
  for (int mi = 0; mi < MI; ++mi)
#pragma unroll
    for (int ni = 0; ni < NI; ++ni)
#pragma unroll
      for (int r = 0; r < 16; ++r) acc[mi][ni][r] = 0.f;
#define G_DMA(BUFP, KT) do { _Pragma("unroll") for (int i = 0; i < ACH; ++i) dma16(ag + (size_t)i * 64 * lda + (KT) * 64, (BUFP) + i * 8192 + wave * 1024); \
    _Pragma("unroll") for (int i = 0; i < BCH; ++i) dma16(bg + (size_t)i * 64 * ldb + (KT) * 64, (BUFP) + ABYTES + i * 8192 + wave * 1024); } while (0)
#define G_COMPUTE(CUR) do { _Pragma("unroll") for (int kk = 0; kk < 4; ++kk) { const int xk = ((kk * 2 + hi) ^ sw) << 4; bf16x8 af[MI], bfr[NI]; \
    _Pragma("unroll") for (int mi = 0; mi < MI; ++mi) af[mi] = *(const bf16x8*)((CUR) + abase + mi * 4096 + xk); \
    _Pragma("unroll") for (int ni = 0; ni < NI; ++ni) bfr[ni] = *(const bf16x8*)((CUR) + bbase + ni * 4096 + xk); \
    _Pragma("unroll") for (int mi = 0; mi < MI; ++mi) _Pragma("unroll") for (int ni = 0; ni < NI; ++ni) acc[mi][ni] = MFMA32(bfr[ni], af[mi], acc[mi][ni]); } } while (0)
  const int nk = K >> 6;
  G_DMA(lds, 0);
  for (int kt = 0; kt < nk; ++kt) {
    asm volatile("s_waitcnt vmcnt(0)" ::: "memory");
    __syncthreads();
    char* cur = lds + (kt & 1) * BUF;
    if (kt + 1 < nk) G_DMA(lds + ((kt + 1) & 1) * BUF, kt + 1);
    G_COMPUTE(cur);
  }
  __syncthreads();
#undef G_DMA
#undef G_COMPUTE
}

DI void tile_of(int t, int NT, int& mt, int& nt) {
  const int xcd = t & 7, idx = t >> 3, g = idx / (8 * NT), rem = idx % (8 * NT);
  mt = xcd * 16 + g * 8 + (rem & 7); nt = rem >> 3;
}

DI void epi_in_e(const Params& p, f32x16& a00, f32x16& a01, f32x16& a10, f32x16& a11, int mrow0, int cb, int r32, int hi) {
  int type; const float* g = nullptr;
  if (cb < 512) { type = 1; g = p.gq_a; } else if (cb < 1024) { type = 1; g = p.gk_a; } else if (cb < 1536) type = 0;
  else if (cb < 2048) { type = 2; g = p.gq_b; } else if (cb < 2176) { type = 2; g = p.gk_b; } else if (cb < 2304) type = 0; else type = 3;
#pragma unroll
  for (int mi = 0; mi < 2; ++mi) {
    f32x16& r0 = mi ? a10 : a00; f32x16& r1 = mi ? a11 : a01;
    const int T = mrow0 + mi * 32 + r32; const float rs = p.rs0[T];
    f32x16 v0 = r0 * rs, v1 = r1 * rs;
    if (type == 1 || type == 2) {
      const float ss = half_sum(sumsq16(v0) + sumsq16(v1)); const float ri = rsqrtf(ss * (1.f / 64) + EPS);
      { f32x16 gg; load_blk_f32(g, hi, gg); v0 = v0 * ri * gg; load_blk_f32(g + 32, hi, gg); v1 = v1 * ri * gg; }
      if (type == 2) { const int t = T & 4095; rot16(v0, p.tab_ax + (t >> 6) * 16, hi); rot16(v1, p.tab_ax + (t & 63) * 16, hi); }
      if (cb >= 1536 && cb < 2048) { v0 = v0 * (0.125f * LOG2E); v1 = v1 * (0.125f * LOG2E); }
    } else if (type == 3) {
#pragma unroll
      for (int r = 0; r < 16; ++r) { v0[r] = silu(v0[r]); v1[r] = silu(v1[r]); }
    }
    r0 = v0; r1 = v1;
  }
}
DI void epi_in_o(const Params& p, f32x16& a00, f32x16& a01, f32x16& a10, f32x16& a11, int mrow0, int cb, int r32, int hi) {
  int type; const float* g = nullptr;
  if (cb < 256) type = 4; else if (cb < 384) type = 5; else if (cb < 896) { type = 2; g = p.gq_d; } else if (cb < 1408) { type = 2; g = p.gk_d; }
  else if (cb < 1920) type = 0; else if (cb < 2944) type = 3; else type = 0;
#pragma unroll
  for (int mi = 0; mi < 2; ++mi) {
    f32x16& r0 = mi ? a10 : a00; f32x16& r1 = mi ? a11 : a01;
    const int T = mrow0 + mi * 32 + r32; const float rs = rsqrtf(p.ss1[T] * (1.f / DM) + EPS);
    f32x16 v0 = r0 * rs, v1 = r1 * rs;
    if (type == 2) {
      const float ss = half_sum(sumsq16(v0) + sumsq16(v1)); const float ri = rsqrtf(ss * (1.f / 64) + EPS);
      { f32x16 gg; load_blk_f32(g, hi, gg); v0 = v0 * ri * gg; load_blk_f32(g + 32, hi, gg); v1 = v1 * ri * gg; }
      rot8(v0, p.tab_part + (T & 4095) * 8, hi);
      if (cb < 896) { v0 = v0 * (0.125f * LOG2E); v1 = v1 * (0.125f * LOG2E); }
    } else if (type == 3) {
#pragma unroll
      for (int r = 0; r < 16; ++r) { v0[r] = silu(v0[r]); v1[r] = silu(v1[r]); }
    } else if (type >= 4) {
      const float ss = half_sum(sumsq16(v0) + sumsq16(v1));
      if (hi == 0) atomicAdd((type == 4 ? p.sscq : p.ssckv) + T, ss);
    }
    r0 = v0; r1 = v1;
  }
}
DI void stage_out_bf16(f32x16 (&acc)[2][4], u16* dst, int ld, char* lds) {
  const int tid = my_tid(), wave = tid >> 6, lane = tid & 63, r32 = lane & 31, hi = lane >> 5, wr = wave >> 1, wc = wave & 1;
#pragma unroll
  for (int half = 0; half < 2; ++half) {
    if ((wr >> 1) == half) {
#pragma unroll
      for (int mi = 0; mi < 2; ++mi) {
        u16* rowp = (u16*)(lds + ((wr & 1) * 64 + mi * 32 + r32) * 520) + wc * 128;
#pragma unroll
        for (int ni = 0; ni < 4; ++ni) store_blk_bf16(rowp + 32 * ni, acc[mi][ni], hi);
      }
    }
    __syncthreads();
#pragma unroll
    for (int i = 0; i < 8; ++i) {
      const int c = tid + i * NTHR, row = c >> 5, ch = c & 31;
      const u32x2 a = *(const u32x2*)(lds + row * 520 + ch * 16), b = *(const u32x2*)(lds + row * 520 + ch * 16 + 8);
      u32x4 w; w.x = a.x; w.y = a.y; w.z = b.x; w.w = b.y;
      *(u32x4*)(dst + (size_t)(half * 128 + row) * ld + ch * 8) = w;
    }
    __syncthreads();
  }
}
template <bool FIRST>
DI void epi_out(const Params& p, f32x16 (&acc)[2][4], int m0, int n0, char* lds) {
  const float* res = FIRST ? p.x : p.out;
  const int tid = my_tid(), wave = tid >> 6, lane = tid & 63, r32 = lane & 31, hi = lane >> 5, wr = wave >> 1, wc = wave & 1;
#pragma unroll
  for (int mi = 0; mi < 2; ++mi)
#pragma unroll
    for (int half = 0; half < 2; ++half) {
      if ((wr >> 1) == half) {
        float* rowp = (float*)(lds + ((wr & 1) * 32 + r32) * 1040) + wc * 128;
#pragma unroll
        for (int ni = 0; ni < 4; ++ni)
#pragma unroll
          for (int q = 0; q < 4; ++q) { f32x4 v; v[0] = acc[mi][ni][4 * q]; v[1] = acc[mi][ni][4 * q + 1]; v[2] = acc[mi][ni][4 * q + 2]; v[3] = acc[mi][ni][4 * q + 3]; *(f32x4*)(rowp + 32 * ni + 8 * q + 4 * hi) = v; }
      }
      __syncthreads();
#pragma unroll
      for (int i = 0; i < 8; ++i) {
        const int c = tid + i * NTHR, row = c >> 6, ch = c & 63;
        const int T = m0 + half * 128 + (row >> 5) * 64 + mi * 32 + (row & 31);
        const size_t off = (size_t)T * DM + n0 + ch * 4;
        const f32x4 a = *(const f32x4*)(lds + row * 1040 + ch * 16), rv = *(const f32x4*)(res + off);
        f32x4 ov = a + rv;
        *(f32x4*)(p.out + off) = ov;
        if (FIRST) {
          float ss = ov[0] * ov[0] + ov[1] * ov[1] + ov[2] * ov[2] + ov[3] * ov[3];
          u32x2 w; w.x = cvtpk(ov[0], ov[1]); w.y = cvtpk(ov[2], ov[3]); *(u32x2*)(p.xb + (size_t)T * LDX + n0 + ch * 4) = w;
          ss = wave_sum(ss);
          if (ch == 0) atomicAdd(p.ss1 + T, ss);
        }
      }
      __syncthreads();
    }
}
template <int WHICH>
DI void gemm_phase(const Params& p, char* lds) {
  constexpr int NT = WHICH == 0 ? NE / 256 : WHICH == 2 ? NO / 256 : 4;
  const u16* A = (WHICH == 0 || WHICH == 2) ? p.xb : p.ob;
  const u16* Bt = WHICH == 0 ? p.wt_ine : WHICH == 1 ? p.wt_oute : WHICH == 2 ? p.wt_ino : p.wt_outo;
  const int wave = my_tid() >> 6, lane = my_tid() & 63, r32 = lane & 31, hi = lane >> 5, wr = wave >> 1, wc = wave & 1;
  for (int t = blockIdx.x; t < 128 * NT; t += gridDim.x) {
    int mt, nt; tile_of(t, NT, mt, nt);
    f32x16 acc[2][4];
    gemm_mainloop<4, 2, 2, 4>(A + (size_t)mt * 256 * LDX, LDX, Bt + (size_t)nt * 256 * LDX, LDX, DM, lds, acc);
    const int mrow0 = mt * 256 + wr * 64, cb = nt * 256 + wc * 128;
    if (WHICH == 0) {
      epi_in_e(p, acc[0][0], acc[0][1], acc[1][0], acc[1][1], mrow0, cb, r32, hi);
      epi_in_e(p, acc[0][2], acc[0][3], acc[1][2], acc[1][3], mrow0, cb + 64, r32, hi);
      stage_out_bf16(acc, p.proj + (size_t)mt * 256 * NE + nt * 256, NE, lds);
    } else if (WHICH == 2) {
      epi_in_o(p, acc[0][0], acc[0][1], acc[1][0], acc[1][1], mrow0, cb, r32, hi);
      epi_in_o(p, acc[0][2], acc[0][3], acc[1][2], acc[1][3], mrow0, cb + 64, r32, hi);
      stage_out_bf16(acc, p.proj + (size_t)mt * 256 * NO + nt * 256, NO, lds);
    } else if (WHICH == 1) epi_out<true>(p, acc, mt * 256, nt * 256, lds);
    else epi_out<false>(p, acc, mt * 256, nt * 256, lds);
  }
}
template <int NCH, int STR>
DI void copy_rows_bf16(const char* lds, u16* dst, int ld) {
  const int tid = my_tid();
#pragma unroll
  for (int i = 0; i < (256 * NCH) / NTHR; ++i) {
    const int c = tid + i * NTHR, row = c / NCH, ch = c % NCH;
    const u32x2 a = *(const u32x2*)(lds + row * STR + ch * 16), b = *(const u32x2*)(lds + row * STR + ch * 16 + 8);
    u32x4 w; w.x = a.x; w.y = a.y; w.z = b.x; w.w = b.y;
    *(u32x4*)(dst + (size_t)row * ld + ch * 8) = w;
  }
}
DI void upproj_phase(const Params& p, char* lds) {
  const int wave = my_tid() >> 6, lane = my_tid() & 63, r32 = lane & 31, hi = lane >> 5;
  for (int t = blockIdx.x; t < 128 * 8; t += gridDim.x) {
    int mt, hh; tile_of(t, 8, mt, hh);
    f32x16 acc[1][3];
    gemm_mainloop<8, 1, 1, 3>(p.proj + (size_t)mt * 256 * NO, NO, p.wt_cq + (size_t)hh * 96 * 256, 256, 256, lds, acc);
    const int T = mt * 256 + wave * 32 + r32;
    const float rcq = rsqrtf(p.sscq[T] * (1.f / 256) + EPS);
    f32x16 v0 = acc[0][0] * rcq, v1 = acc[0][1] * rcq, v2 = acc[0][2] * rcq;
    const float ss = half_sum(sumsq16(v0) + sumsq16(v1) + sumsq16(v2)); const float ri = rsqrtf(ss * (1.f / 96) + EPS);
    f32x16 g; load_blk_f32(p.gq_c, hi, g); v0 = v0 * ri * g; load_blk_f32(p.gq_c + 32, hi, g); v1 = v1 * ri * g; load_blk_f32(p.gq_c + 64, hi, g); v2 = v2 * ri * g;
    rot16(v2, p.tab_mla + (T & 4095) * 16, hi);
    { const float cs = 0.10206207261596575f * LOG2E; v0 = v0 * cs; v1 = v1 * cs; v2 = v2 * cs; }
    u16* rowp = (u16*)(lds + (wave * 32 + r32) * 200);
    store_blk_bf16(rowp, v0, hi); store_blk_bf16(rowp + 32, v1, hi); store_blk_bf16(rowp + 64, v2, hi);
    __syncthreads();
    copy_rows_bf16<12, 200>(lds, p.qc + (size_t)mt * 256 * 768 + hh * 96, 768);
    __syncthreads();
  }
  for (int t = blockIdx.x; t < 128 * 8; t += gridDim.x) {
    int mt, hh; tile_of(t, 8, mt, hh);
    f32x16 acc[1][4];
    gemm_mainloop<8, 1, 1, 4>(p.proj + (size_t)mt * 256 * NO + 256, NO, p.wt_ckv + (size_t)hh * 128 * 128, 128, 128, lds, acc);
    const int T = mt * 256 + wave * 32 + r32;
    const float rkv = rsqrtf(p.ssckv[T] * (1.f / 128) + EPS);
    f32x16 v0 = acc[0][0] * rkv, v1 = acc[0][1] * rkv, v2 = acc[0][2] * rkv, v3 = acc[0][3] * rkv, kp;
    load_blk_bf16(p.proj + (size_t)T * NO + 2944, hi, kp);
    const float ss = half_sum(sumsq16(v0) + sumsq16(v1) + sumsq16(kp)); const float ri = rsqrtf(ss * (1.f / 96) + EPS);
    f32x16 g; load_blk_f32(p.gk_c, hi, g); v0 = v0 * ri * g; load_blk_f32(p.gk_c + 32, hi, g); v1 = v1 * ri * g; load_blk_f32(p.gk_c + 64, hi, g); kp = kp * ri * g;
    rot16(kp, p.tab_mla + (T & 4095) * 16, hi);
    u16* rowp = (u16*)(lds + (wave * 32 + r32) * 200);
    store_blk_bf16(rowp, v0, hi); store_blk_bf16(rowp + 32, v1, hi); store_blk_bf16(rowp + 64, kp, hi);
    u16* vrow = (u16*)(lds + 51200 + (wave * 32 + r32) * 136);
    store_blk_bf16(vrow, v2, hi); store_blk_bf16(vrow + 32, v3, hi);
    __syncthreads();
    copy_rows_bf16<12, 200>(lds, p.kc + (size_t)mt * 256 * 768 + hh * 96, 768);
    copy_rows_bf16<8, 136>(lds + 51200, p.vc + (size_t)mt * 256 * 512 + hh * 64, 512);
    __syncthreads();
  }
}

namespace pg8 {
#define PG8_LAS __attribute__((address_space(3)))
typedef unsigned short bf16_t;
typedef short bf16x8 __attribute__((ext_vector_type(8)));
typedef float f32x4 __attribute__((ext_vector_type(4)));
typedef unsigned u32x4 __attribute__((ext_vector_type(4)));
constexpr int BM = 256, BK = 64, HALF = 128, HTB = HALF * BK * 2  , STAGE_BYTES = 8 * HTB, NXCD = 8, WGM = 8;

__host__ __device__ __forceinline__ int lds_byte(int r, int c) { const int st = (r >> 4) * 2 + (c >> 5), rr = r & 15, cc = c & 31, ob = rr * 64 + cc * 2; return st * 1024 + (ob ^ (((ob >> 9) & 1) << 5)); }
__host__ __device__ __forceinline__ void stage_rc(int b, int& R, int& C) { const int st = b / 1024, sb = b % 1024, swz = sb ^ (((sb >> 9) & 1) << 5); R = (st >> 1) * 16 + swz / 64; C = (st & 1) * 32 + (swz % 64) / 2; }
__host__ __device__ __forceinline__ int perm32(int rho) { const int n = rho >> 4, i = rho & 15; return 8 * (i >> 2) + 4 * n + (i & 3); }

struct Unit { int pm, pn; };
struct Gemm { const bf16_t* A; const bf16_t* Bt; int M, N, K; };

struct StaticOrder {
    int nM, nN, nwg, G, c;
    __host__ __device__ void init(int M, int N, int G_, int c_) { nM = M / BM; nN = N / BM; nwg = nM * nN; G = G_; c = c_; }
    __host__ __device__ bool next(int i, Unit& u) const {
        const long L = (long)i * G + c; if (L >= nwg) return false;
        int wgid = (int)L; { const int q = nwg / NXCD, r = nwg % NXCD, xcd = wgid % NXCD, off = wgid / NXCD; wgid = (xcd < r ? xcd * (q + 1) : r * (q + 1) + (xcd - r) * q) + off; }
        const int nig = WGM * nN, gid = wgid / nig, fm = gid * WGM, gsz = (nM - fm) < WGM ? (nM - fm) : WGM;
        u.pm = fm + ((wgid % nig) % gsz); u.pn = (wgid % nig) / gsz; return true;
    }
    __device__ __forceinline__ void a_ready(const Unit&) const {}
    __device__ __forceinline__ void done(const Unit&) const {}
};
__device__ __forceinline__ unsigned cvt_pk_bf16(float lo, float hi) { unsigned r; asm volatile("v_cvt_pk_bf16_f32 %0, %1, %2" : "=v"(r) : "v"(lo), "v"(hi)); return r; }
template <class Epi, class Sched, bool STAMP = false>
__device__ __forceinline__ void gemm_phase(PG8_LAS unsigned char* lds, const Gemm g, const Sched& S, const Epi& E, unsigned long long* stamps) {
    const int tid = my_tid(), wid = __builtin_amdgcn_readfirstlane(tid >> 6), lane = tid & 63, wr = wid >> 2, wc = wid & 3, fr = lane & 15, fq = lane >> 4;
    const int K = g.K, nt = K / BK;
    int ts_lo = 0, ts_hi = 0, nts = 0; const unsigned long long rt_entry = STAMP ? (unsigned long long)wall_clock64() : 0ull;
#define PG8_STAMP() do { if (STAMP && wid == 0 && nts < 64) { const unsigned long long _c = (unsigned long long)clock64(); \
        ts_lo = (lane == nts) ? (int)(unsigned)_c : ts_lo; ts_hi = (lane == nts) ? (int)(unsigned)(_c >> 32) : ts_hi; ++nts; } } while (0)
    PG8_STAMP();
    unsigned voffA[2], voffB[2];
#pragma unroll
    for (int i = 0; i < 2; ++i) { int R, C; stage_rc(tid * 16 + i * 8192, R, C); const int Rb = Epi::PERM ? ((R & ~31) + perm32(R & 31)) : R;
        voffA[i] = (unsigned)(R * K + C) * 2u; voffB[i] = (unsigned)(Rb * K + C) * 2u; }
    const size_t kstep = (size_t)(BK * 2);
    const size_t hstep = (size_t)HALF * K * 2;
    const size_t tstep = 2 * hstep;
    const unsigned ldsw = (unsigned)wid * 1024u;
    const int aoff = lds_byte(wr * 64 + fr, fq * 8), boff = lds_byte(wc * 32 + fr, fq * 8);
#define PG8_SA(b, h) (((b) * 2 + (h)) * HTB)
#define PG8_SB(b, h) ((4 + (b) * 2 + (h)) * HTB)
#define PG8_STAGE(bufoff, gbase, voff) do { _Pragma("unroll") for (int _i = 0; _i < 2; ++_i) \
        __builtin_amdgcn_global_load_lds((const unsigned*)((const char*)(gbase) + (voff)[_i]), (PG8_LAS unsigned*)(lds + (bufoff) + ldsw + _i * 8192), 16, 0, 0); } while (0)
#define PG8_LDA(dst, b, h) do { _Pragma("unroll") for (int m = 0; m < 4; ++m) _Pragma("unroll") for (int k = 0; k < 2; ++k) dst[m][k] = *(const PG8_LAS bf16x8*)(lds + PG8_SA(b, h) + aoff + m * 2048 + k * 1024); } while (0)
#define PG8_LDB(dst, b, h) do { _Pragma("unroll") for (int n = 0; n < 2; ++n) _Pragma("unroll") for (int k = 0; k < 2; ++k) dst[n][k] = *(const PG8_LAS bf16x8*)(lds + PG8_SB(b, h) + boff + n * 2048 + k * 1024); } while (0)
#define PG8_MMA(ai, bj, At, Bt) do { __builtin_amdgcn_s_setprio(1); _Pragma("unroll") for (int m = 0; m < 4; ++m) _Pragma("unroll") for (int n = 0; n < 2; ++n) _Pragma("unroll") for (int k = 0; k < 2; ++k) \
        acc[ai][bj][m][n] = __builtin_amdgcn_mfma_f32_16x16x32_bf16(Bt[n][k], At[m][k], acc[ai][bj][m][n], 0, 0, 0); __builtin_amdgcn_s_setprio(0); } while (0)
#define PG8_WAIT_V(n) asm volatile("s_waitcnt vmcnt(" #n ")" ::: "memory")
#define PG8_WAIT_L(n) asm volatile("s_waitcnt lgkmcnt(" #n ")" ::: "memory")
#define PG8_BAR __builtin_amdgcn_s_barrier()
#define PG8_SCHED __builtin_amdgcn_sched_barrier(0)
    Unit cur, nxt; int ui = 0;
    if (!S.next(0, cur)) return;
    f32x4 acc[2][2][4][2];
#pragma unroll
    for (int a = 0; a < 2; ++a)
#pragma unroll
        for (int b = 0; b < 2; ++b)
#pragma unroll
            for (int m = 0; m < 4; ++m)
#pragma unroll
                for (int n = 0; n < 2; ++n) acc[a][b][m][n] = (f32x4){0.f, 0.f, 0.f, 0.f};
    bf16x8 At[4][2], B0[2][2], B1[2][2];
    const char* cA = (const char*)g.A + (size_t)cur.pm * tstep; const char* cB = (const char*)g.Bt + (size_t)cur.pn * tstep;
    S.a_ready(cur);
    PG8_STAGE(PG8_SB(0, 0), cB, voffB); PG8_STAGE(PG8_SA(0, 0), cA, voffA); PG8_STAGE(PG8_SB(0, 1), cB + hstep, voffB); PG8_STAGE(PG8_SA(0, 1), cA + hstep, voffA);
    if (wr == 1) PG8_BAR;
    PG8_WAIT_V(4); PG8_BAR;
    PG8_STAGE(PG8_SB(1, 0), cB + kstep, voffB); PG8_STAGE(PG8_SA(1, 0), cA + kstep, voffA); PG8_STAGE(PG8_SB(1, 1), cB + hstep + kstep, voffB);
    PG8_WAIT_V(6); PG8_BAR;
    PG8_STAMP();
    for (;;) {
        const bool has_next = S.next(ui + 1, nxt);
        const char* nA = has_next ? (const char*)g.A + (size_t)nxt.pm * tstep : cA; const char* nB = has_next ? (const char*)g.Bt + (size_t)nxt.pn * tstep : cB;
        for (int t = 0; t < nt; t += 2) {
            const bool last = (t == nt - 2);
            const char* a1 = cA + (size_t)(t + 1) * kstep;
            const char* a2 = last ? nA : cA + (size_t)(t + 2) * kstep; const char* b2 = last ? nB : cB + (size_t)(t + 2) * kstep;
            const char* a3 = a2 + kstep; const char* b3 = b2 + kstep;
            if (last && has_next) S.a_ready(nxt);
            PG8_LDB(B0, 0, 0); PG8_SCHED; PG8_LDA(At, 0, 0); PG8_STAGE(PG8_SA(1, 1), a1 + hstep, voffA);
            PG8_WAIT_L(8); PG8_BAR; PG8_WAIT_L(0); PG8_MMA(0, 0, At, B0); PG8_BAR; PG8_SCHED;
            PG8_LDB(B1, 0, 1); PG8_STAGE(PG8_SB(0, 0), b2, voffB);
            PG8_BAR; PG8_WAIT_L(0); PG8_MMA(0, 1, At, B1); PG8_BAR;
            PG8_LDA(At, 0, 1); PG8_STAGE(PG8_SA(0, 0), a2, voffA);
            PG8_BAR; PG8_WAIT_L(0); PG8_MMA(1, 0, At, B0); PG8_BAR; PG8_SCHED;
            PG8_STAGE(PG8_SB(0, 1), b2 + hstep, voffB);
            PG8_WAIT_V(6); PG8_BAR; PG8_MMA(1, 1, At, B1); PG8_BAR;
            PG8_LDB(B0, 1, 0); PG8_SCHED; PG8_LDA(At, 1, 0); PG8_STAGE(PG8_SA(0, 1), a2 + hstep, voffA);
            PG8_WAIT_L(8); PG8_BAR; PG8_WAIT_L(0); PG8_MMA(0, 0, At, B0); PG8_BAR; PG8_SCHED;
            PG8_LDB(B1, 1, 1); PG8_STAGE(PG8_SB(1, 0), b3, voffB);
            PG8_BAR; PG8_WAIT_L(0); PG8_MMA(0, 1, At, B1); PG8_BAR;
            PG8_LDA(At, 1, 1); PG8_STAGE(PG8_SA(1, 0), a3, voffA);
            PG8_BAR; PG8_WAIT_L(0); PG8_MMA(1, 0, At, B0); PG8_BAR; PG8_SCHED;
            PG8_STAGE(PG8_SB(1, 1), b3 + hstep, voffB);
            PG8_WAIT_V(6); PG8_BAR; PG8_MMA(1, 1, At, B1); PG8_BAR;
        }
        PG8_STAMP();
        if constexpr (!Epi::AFTER_DRAIN) { E(acc, cur, wr, wc, fr, fq); S.done(cur); }
        PG8_STAMP();
        if (!has_next) break;
#pragma unroll
        for (int a = 0; a < 2; ++a)
#pragma unroll
            for (int b = 0; b < 2; ++b)
#pragma unroll
                for (int m = 0; m < 4; ++m)
#pragma unroll
                    for (int n = 0; n < 2; ++n) acc[a][b][m][n] = (f32x4){0.f, 0.f, 0.f, 0.f};
        cur = nxt; cA = nA; cB = nB; ++ui;
    }
    PG8_WAIT_V(0);
    if (wr == 0) PG8_BAR;
    PG8_BAR;
    if constexpr (Epi::AFTER_DRAIN) { E.fused(acc, cur, wr, wc, fr, fq, lds, wid, lane); S.done(cur); }
    PG8_STAMP();
    if (STAMP && wid == 0) { stamps[lane] = lane < nts ? (((unsigned long long)(unsigned)ts_hi << 32) | (unsigned)ts_lo) : 0ull;
        if (lane == 62) stamps[62] = rt_entry; if (lane == 63) stamps[63] = (unsigned long long)wall_clock64(); }
#undef PG8_STAMP
#undef PG8_SA
#undef PG8_SB
#undef PG8_STAGE
#undef PG8_LDA
#undef PG8_LDB
#undef PG8_MMA
#undef PG8_WAIT_V
#undef PG8_WAIT_L
#undef PG8_BAR
#undef PG8_SCHED
}

__device__ __forceinline__ float silu_f(float v) { return v * __builtin_amdgcn_rcpf(1.f + __builtin_amdgcn_exp2f(v * -1.4426950408889634f)); }
__device__ __forceinline__ void xch_barrier() { asm volatile("s_waitcnt lgkmcnt(0)" ::: "memory"); __builtin_amdgcn_s_barrier(); asm volatile("" ::: "memory"); }
template <int XORL>
__device__ __forceinline__ void rot_lane8(float (&x)[8], const float2* tb, bool apply, bool first) {
    const f32x4 t0 = *(const f32x4*)(tb), t1 = *(const f32x4*)(tb + 2), t2 = *(const f32x4*)(tb + 4), t3 = *(const f32x4*)(tb + 6);
    const float c[8] = {t0[0], t0[2], t1[0], t1[2], t2[0], t2[2], t3[0], t3[2]}, s[8] = {t0[1], t0[3], t1[1], t1[3], t2[1], t2[3], t3[1], t3[3]};
#pragma unroll
    for (int k = 0; k < 8; ++k) { const float xp = __shfl_xor(x[k], XORL); const float r = first ? x[k] * c[k] - xp * s[k] : x[k] * c[k] + xp * s[k]; x[k] = apply ? r : x[k]; }
}
template <bool L1>
struct EpiIn {
    static constexpr bool PERM = true, AFTER_DRAIN = false;
    const Params& p; PG8_LAS float* xch;
    __device__ __forceinline__ void operator()(const f32x4 (&acc)[2][2][4][2], const Unit& u, int wr, int wc, int fr, int fq) const {
        constexpr int LDP = L1 ? NO : NE;
        asm volatile("" : "+v"(fr), "+v"(fq));
        int type[2]; const float* gp[2]; int hbs[2];
#pragma unroll
        for (int bj = 0; bj < 2; ++bj) {
            const int hb = (u.pn * 256 + bj * 128 + wc * 32) & ~63; hbs[bj] = hb; gp[bj] = p.gq_a; int t;
            if (!L1) { if (hb < 512) { t = 1; gp[bj] = p.gq_a; } else if (hb < 1024) { t = 1; gp[bj] = p.gk_a; } else if (hb < 1536) t = 0; else if (hb < 2048) { t = 2; gp[bj] = p.gq_b; }
                       else if (hb < 2176) { t = 2; gp[bj] = p.gk_b; } else if (hb < 2304) t = 0; else t = 3; }
            else     { if (hb < 256) t = 4; else if (hb < 384) t = 5; else if (hb < 896) { t = 2; gp[bj] = p.gq_d; } else if (hb < 1408) { t = 2; gp[bj] = p.gk_d; } else if (hb < 1920) t = 0; else if (hb < 2944) t = 3; else t = 0; }
            type[bj] = t;
        }
        const int w32 = (wc & 1) * 32, ch = w32 + 8 * fq;
        float rsv[2][4];
#pragma unroll
        for (int ai = 0; ai < 2; ++ai)
#pragma unroll
            for (int m = 0; m < 4; ++m) { const int T = u.pm * BM + ai * HALF + wr * 64 + m * 16 + fr; rsv[ai][m] = L1 ? p.ss1[T] : p.rs0[T]; }
        f32x4 gv[2][2];
#pragma unroll
        for (int bj = 0; bj < 2; ++bj) { gv[bj][0] = *(const f32x4*)(gp[bj] + ch); gv[bj][1] = *(const f32x4*)(gp[bj] + ch + 4); }
        if (L1) {
#pragma unroll
            for (int ai = 0; ai < 2; ++ai)
#pragma unroll
                for (int m = 0; m < 4; ++m) rsv[ai][m] = rsqrtf(rsv[ai][m] * (1.f / DM) + EPS);
        }
#pragma unroll
        for (int ai = 0; ai < 2; ++ai)
#pragma unroll
            for (int m = 0; m < 4; ++m) {
                const int rl = ai * HALF + wr * 64 + m * 16 + fr, T = u.pm * BM + rl;
                const float rs = rsv[ai][m];
#pragma unroll
                for (int bj = 0; bj < 2; ++bj) {
                    float s = 0.f;
                    if (type[bj] == 1 || type[bj] == 2 || type[bj] >= 4) {
#pragma unroll
                        for (int n = 0; n < 2; ++n)
#pragma unroll
                            for (int e = 0; e < 4; ++e) { const float x = acc[ai][bj][m][n][e] * rs; s = fmaf(x, x, s); }
                        s += __shfl_xor(s, 16); s += __shfl_xor(s, 32);
                        if (type[bj] >= 4) { if (fq == 0) atomicAdd((type[bj] == 4 ? p.sscq : p.ssckv) + T, s); }
                        else if (fq == 0) xch[rl * 8 + bj * 4 + wc] = s;
                    }
                }
            }
        xch_barrier();
#pragma unroll
        for (int ai = 0; ai < 2; ++ai)
#pragma unroll
            for (int m = 0; m < 4; ++m) {
                const int rl = ai * HALF + wr * 64 + m * 16 + fr, T = u.pm * BM + rl, t = T & 4095;
                const float rs = rsv[ai][m];
#pragma unroll
                for (int bj = 0; bj < 2; ++bj) {
                    float x[8];
#pragma unroll
                    for (int n = 0; n < 2; ++n)
#pragma unroll
                        for (int e = 0; e < 4; ++e) x[4 * n + e] = acc[ai][bj][m][n][e] * rs;
                    if (type[bj] == 1 || type[bj] == 2) {
                        const float tot = xch[rl * 8 + bj * 4 + wc] + xch[rl * 8 + bj * 4 + (wc ^ 1)];
                        const float ri = rsqrtf(tot * (1.f / 64) + EPS);
                        const f32x4 g0 = gv[bj][0], g1 = gv[bj][1];
#pragma unroll
                        for (int e = 0; e < 4; ++e) { x[e] *= ri * g0[e]; x[4 + e] *= ri * g1[e]; }
                        if (type[bj] == 2) {
                            if (!L1) { const int pos = w32 ? (t & 63) : (t >> 6); rot_lane8<32>(x, p.tab_ax + pos * 16 + 8 * (fq & 1), true, fq < 2); }
                            else     { rot_lane8<16>(x, p.tab_part + t * 8, w32 == 0 && fq < 2, fq == 0); }
                            const bool isq = L1 ? (hbs[bj] < 896) : (hbs[bj] < 2048);
                            if (isq) {
#pragma unroll
                                for (int k = 0; k < 8; ++k) x[k] *= 0.125f * LOG2E;
                            }
                        }
                    } else if (type[bj] == 3) {
#pragma unroll
                        for (int k = 0; k < 8; ++k) x[k] = silu_f(x[k]);
                    }
                    u32x4 w; w.x = cvt_pk_bf16(x[0], x[1]); w.y = cvt_pk_bf16(x[2], x[3]); w.z = cvt_pk_bf16(x[4], x[5]); w.w = cvt_pk_bf16(x[6], x[7]);
                    *(u32x4*)(p.proj + (size_t)T * LDP + u.pn * BM + bj * HALF + wc * 32 + 8 * fq) = w;
                    asm volatile("" ::: "memory");
                }
            }
    }
};
template <bool FIRST>
struct EpiRes {
    static constexpr bool PERM = false, AFTER_DRAIN = false;
    const Params& p; PG8_LAS float* xch;
    __device__ __forceinline__ void operator()(const f32x4 (&acc)[2][2][4][2], const Unit& u, int wr, int wc, int fr, int fq) const {
        const float* res = FIRST ? p.x : p.out;
        asm volatile("" : "+v"(fr), "+v"(fq));
#pragma unroll
        for (int ai = 0; ai < 2; ++ai)
#pragma unroll
            for (int m = 0; m < 4; ++m) {
                const int T = u.pm * BM + ai * HALF + wr * 64 + m * 16 + fr; float ss = 0.f;
#pragma unroll
                for (int bj = 0; bj < 2; ++bj)
#pragma unroll
                    for (int n = 0; n < 2; ++n) {
                        const size_t off = (size_t)T * DM + u.pn * BM + bj * HALF + wc * 32 + n * 16 + 4 * fq;
                        const f32x4 ov = *(const f32x4*)(res + off) + acc[ai][bj][m][n];
                        *(f32x4*)(p.out + off) = ov;
                        if (FIRST) { ss += ov[0] * ov[0] + ov[1] * ov[1] + ov[2] * ov[2] + ov[3] * ov[3];
                            u32x2 w; w.x = cvt_pk_bf16(ov[0], ov[1]); w.y = cvt_pk_bf16(ov[2], ov[3]); *(u32x2*)(p.xb + off) = w; }
                    }
                if (FIRST) { ss += __shfl_xor(ss, 16); ss += __shfl_xor(ss, 32); if (fq == 0) atomicAdd(p.ss1 + T, ss); }
            }
        xch_barrier();
    }
};
}
template <int WHICH>
DI void gemm_phase8(const Params& p, char* lds) {
  constexpr int N = WHICH == 0 ? NE : WHICH == 2 ? NO : 1024;
  pg8::Gemm g; g.A = (WHICH == 0 || WHICH == 2) ? p.xb : p.ob; g.Bt = WHICH == 0 ? p.wt_ine : WHICH == 1 ? p.wt_oute : WHICH == 2 ? p.wt_ino : p.wt_outo; g.M = NTOK; g.N = N; g.K = DM;
  pg8::StaticOrder S; S.init(NTOK, N, (int)gridDim.x, (int)blockIdx.x);
  PG8_LAS unsigned char* l3 = (PG8_LAS unsigned char*)lds;
  PG8_LAS float* xch = (PG8_LAS float*)(l3 + 131072);
  if constexpr (WHICH == 0) { pg8::EpiIn<false> e{p, xch}; pg8::gemm_phase(l3, g, S, e, nullptr); }
  else if constexpr (WHICH == 2) { pg8::EpiIn<true> e{p, xch}; pg8::gemm_phase(l3, g, S, e, nullptr); }
  else if constexpr (WHICH == 1) { pg8::EpiRes<true> e{p, xch}; pg8::gemm_phase(l3, g, S, e, nullptr); }
  else { pg8::EpiRes<false> e{p, xch}; pg8::gemm_phase(l3, g, S, e, nullptr); }
}

template <int KS> DI int kswz(int row, int chunk) { return KS == 128 ? row * 128 + ((chunk ^ ((row >> 1) & 7)) << 4) : row * 256 + ((chunk ^ (row & 7)) << 4); }
template <int DV> DI int v_st(int k, int c) { constexpr int NCS = DV / 32; const int kk = k; return ((kk >> 3) * NCS + (c >> 5)) * 512 + ((kk & 7) * 32 + (c & 31)) * 2; }
DI int v_rd_base(int lane) { return ((lane & 3) << 3) | (((lane >> 2) & 3) << 6) | (((lane >> 4) & 1) << 5) | (((lane >> 5) & 1) << 8); }
template <int OFF> DI s16x4 tr_read(int vb) { s16x4 r; asm volatile("ds_read_b64_tr_b16 %0, %1 offset:%2" : "=&v"(r) : "v"(vb), "i"(OFF) : "memory"); return r; }

template <int DQK, int KS>
DI void qkt(f32x16& p0, f32x16& p1, const char* Ks, const bf16x8* qr, int r32, int hi) {
#pragma unroll
  for (int r = 0; r < 16; ++r) { p0[r] = 0.f; p1[r] = 0.f; }
#pragma unroll
  for (int d0 = 0; d0 < DQK / 16; ++d0) {
    const bf16x8 b0 = *(const bf16x8*)(Ks + kswz<KS>(r32, d0 * 2 + hi));
    const bf16x8 b1 = *(const bf16x8*)(Ks + kswz<KS>(32 + r32, d0 * 2 + hi));
    p0 = MFMA32(b0, qr[d0], p0); p1 = MFMA32(b1, qr[d0], p1);
  }
}
template <int DV, int D0>
DI void pv_one(f32x16& od, int vb, bf16x8 pa0, bf16x8 pa1, bf16x8 pa2, bf16x8 pa3) {
  constexpr int NCS = DV / 32;
#define VOFF(ks, half) (D0 * 512 + (2 * (ks) + (half)) * NCS * 512)
  const s16x4 l0 = tr_read<VOFF(0, 0)>(vb), h0 = tr_read<VOFF(0, 1)>(vb), l1 = tr_read<VOFF(1, 0)>(vb), h1 = tr_read<VOFF(1, 1)>(vb);
  const s16x4 l2 = tr_read<VOFF(2, 0)>(vb), h2 = tr_read<VOFF(2, 1)>(vb), l3 = tr_read<VOFF(3, 0)>(vb), h3 = tr_read<VOFF(3, 1)>(vb);
#undef VOFF
  asm volatile("s_waitcnt lgkmcnt(0)" ::: "memory"); SBAR();
#define PK(L, H) (bf16x8){L[0], L[1], L[2], L[3], H[0], H[1], H[2], H[3]}
  od = MFMA32(PK(l0, h0), pa0, od); od = MFMA32(PK(l1, h1), pa1, od); od = MFMA32(PK(l2, h2), pa2, od); od = MFMA32(PK(l3, h3), pa3, od);
#undef PK
}
template <int DV>
DI void pv_all(f32x16 (&o)[DV / 32], int vb, bf16x8 pa0, bf16x8 pa1, bf16x8 pa2, bf16x8 pa3) {
  pv_one<DV, 0>(o[0], vb, pa0, pa1, pa2, pa3); pv_one<DV, 1>(o[1], vb, pa0, pa1, pa2, pa3);
  if constexpr (DV == 128) { pv_one<DV, 2>(o[2], vb, pa0, pa1, pa2, pa3); pv_one<DV, 3>(o[3], vb, pa0, pa1, pa2, pa3); }
}
#define PK4(P, BASE, OUT) do { u32x4 w = {cvtpk(P[BASE + 0], P[BASE + 1]), cvtpk(P[BASE + 2], P[BASE + 3]), cvtpk(P[BASE + 4], P[BASE + 5]), cvtpk(P[BASE + 6], P[BASE + 7])}; \
    OUT = *reinterpret_cast<bf16x8*>(&w); } while (0)

template <int ND0>
DI void softmax_step(f32x16& t0, f32x16& t1, float& m, float& l, f32x16 (&o)[ND0], bf16x8& pa0, bf16x8& pa1, bf16x8& pa2, bf16x8& pa3) {
  float pmax = t0[0];
#pragma unroll
  for (int r = 1; r < 16; ++r) pmax = fmaxf(pmax, t0[r]);
#pragma unroll
  for (int r = 0; r < 16; ++r) pmax = fmaxf(pmax, t1[r]);
  pmax = half_max(pmax);
  const float mn = fmaxf(m, pmax);
  const float alpha = __builtin_amdgcn_exp2f(m - mn);
  m = mn;
#pragma unroll
  for (int r = 0; r < 16; ++r) { t0[r] = __builtin_amdgcn_exp2f(t0[r] - mn); t1[r] = __builtin_amdgcn_exp2f(t1[r] - mn); }
  float ps = 0.f;
#pragma unroll
  for (int r = 0; r < 16; ++r) ps += t0[r] + t1[r];
  ps = half_sum(ps);
  l = l * alpha + ps;
  if (__any(alpha < 1.f)) {
#pragma unroll
    for (int d = 0; d < ND0; ++d) o[d] = o[d] * alpha;
  }
  PK4(t0, 0, pa0); PK4(t0, 8, pa1); PK4(t1, 0, pa2); PK4(t1, 8, pa3);
}

template <int DQK, int DV>
DI void flash(const u16* __restrict__ Qlane, const u16* __restrict__ Kb, const int ldk, const u16* __restrict__ Vb, const int ldv,
              const float C, const float nMc, f32x16 (&o)[DV / 32], float& l_out, char* lds) {
  constexpr int KS = DQK == 64 ? 128 : 256, KCR = DQK / 8, NKC = (KCR + 7) / 8, VCR = DV / 8, NVC = VCR / 8, ND0 = DV / 32, NQ = DQK / 16;
  constexpr int KBYTES = 64 * KS, ABUF = KBYTES + 64 * DV * 2, NTILE = SEQ / 64;
  const int tid = my_tid(), lane = tid & 63, r32 = lane & 31, hi = lane >> 5;
  bf16x8 qr[NQ];
#pragma unroll
  for (int d0 = 0; d0 < NQ; ++d0) qr[d0] = *(const bf16x8*)(Qlane + d0 * 16);
  int kg[NKC], kl[NKC], vg[NVC], vl[NVC];
#pragma unroll
  for (int i = 0; i < NKC; ++i) { const int c = min(tid + i * NTHR, 64 * KCR - 1), row = c / KCR, cc = c % KCR; kg[i] = row * ldk + cc * 8; kl[i] = kswz<KS>(row, cc); }
#pragma unroll
  for (int i = 0; i < NVC; ++i) { const int c = tid + i * NTHR, key = c / VCR, c8 = c % VCR; vg[i] = key * ldv + c8 * 8; vl[i] = KBYTES + v_st<DV>(key, c8 * 8); }
  const int vb0 = (int)(uintptr_t)lds + KBYTES + v_rd_base(lane);
  float lsum = 0.f;
#pragma unroll
  for (int d = 0; d < ND0; ++d)
#pragma unroll
    for (int r = 0; r < 16; ++r) o[d][r] = 0.f;
  bf16x8 ks[NKC], vs[NVC];
#pragma unroll
  for (int i = 0; i < NKC; ++i) ks[i] = *(const bf16x8*)(Kb + kg[i]);
#pragma unroll
  for (int i = 0; i < NVC; ++i) vs[i] = *(const bf16x8*)(Vb + vg[i]);
#pragma unroll
  for (int i = 0; i < NKC; ++i) *(bf16x8*)(lds + kl[i]) = ks[i];
#pragma unroll
  for (int i = 0; i < NVC; ++i) *(bf16x8*)(lds + vl[i]) = vs[i];
  __syncthreads();
  for (int j = 0; j < NTILE; ++j) {
    const int cur = j & 1;
    if (j + 1 < NTILE) {
      const u16* kn = Kb + (size_t)(j + 1) * 64 * ldk; const u16* vn = Vb + (size_t)(j + 1) * 64 * ldv;
#pragma unroll
      for (int i = 0; i < NKC; ++i) ks[i] = *(const bf16x8*)(kn + kg[i]);
#pragma unroll
      for (int i = 0; i < NVC; ++i) vs[i] = *(const bf16x8*)(vn + vg[i]);
    }
    f32x16 p0, p1; bf16x8 pa0, pa1, pa2, pa3;
    qkt<DQK, KS>(p0, p1, lds + cur * ABUF, qr, r32, hi);
#pragma unroll
    for (int r = 0; r < 16; ++r) { p0[r] = __builtin_amdgcn_exp2f(p0[r]); p1[r] = __builtin_amdgcn_exp2f(p1[r]); }
    { const f32x16 s_ = p0 + p1; lsum += ((s_[0] + s_[1]) + (s_[2] + s_[3])) + ((s_[4] + s_[5]) + (s_[6] + s_[7])) + ((s_[8] + s_[9]) + (s_[10] + s_[11])) + ((s_[12] + s_[13]) + (s_[14] + s_[15])); }
    PK4(p0, 0, pa0); PK4(p0, 8, pa1); PK4(p1, 0, pa2); PK4(p1, 8, pa3);
    pv_all<DV>(o, vb0 + cur * ABUF, pa0, pa1, pa2, pa3);
    if (j + 1 < NTILE) {
      char* nb = lds + (cur ^ 1) * ABUF;
#pragma unroll
      for (int i = 0; i < NKC; ++i) *(bf16x8*)(nb + kl[i]) = ks[i];
#pragma unroll
      for (int i = 0; i < NVC; ++i) *(bf16x8*)(nb + vl[i]) = vs[i];
    }
    __syncthreads();
  }
  l_out = half_sum(lsum);
}

template <int DQK, int DV>
DI void flash_pipe_v1(const u16* __restrict__ Qlane, const u16* __restrict__ Kb, const int ldk, const u16* __restrict__ Vb, const int ldv,
                   const float C, const float nMc, f32x16 (&o)[DV / 32], float& l_out, char* lds) {
  constexpr int KS = DQK == 64 ? 128 : 256, KCR = DQK / 8, NKC = (KCR + 7) / 8, VCR = DV / 8, NVC = VCR / 8, ND0 = DV / 32, NQ = DQK / 16;
  constexpr int KBYTES = 64 * KS, VBYTES = 64 * DV * 2, VOFF0 = 2 * KBYTES, NTILE = SEQ / 64;
  const int tid = my_tid(), lane = tid & 63, r32 = lane & 31, hi = lane >> 5;
  bf16x8 qr[NQ];
#pragma unroll
  for (int d0 = 0; d0 < NQ; ++d0) qr[d0] = *(const bf16x8*)(Qlane + d0 * 16);
  int kg[NKC], kl[NKC], vg[NVC], vl[NVC];
#pragma unroll
  for (int i = 0; i < NKC; ++i) { const int c = min(tid + i * NTHR, 64 * KCR - 1), row = c / KCR, cc = c % KCR; kg[i] = row * ldk + cc * 8; kl[i] = kswz<KS>(row, cc); }
#pragma unroll
  for (int i = 0; i < NVC; ++i) { const int c = tid + i * NTHR, key = c / VCR, c8 = c % VCR; vg[i] = key * ldv + c8 * 8; vl[i] = VOFF0 + v_st<DV>(key, c8 * 8); }
  const int vb0 = (int)(uintptr_t)lds + VOFF0 + v_rd_base(lane);
  float l = 0.f;
#pragma unroll
  for (int d = 0; d < ND0; ++d)
#pragma unroll
    for (int r = 0; r < 16; ++r) o[d][r] = 0.f;
  bf16x8 ks[NKC], vs[NVC];
#define FP_LOADK(J) do { const u16* kn = Kb + (size_t)(J) * 64 * ldk; _Pragma("unroll") for (int i = 0; i < NKC; ++i) ks[i] = *(const bf16x8*)(kn + kg[i]); } while (0)
#define FP_LOADV(J) do { const u16* vn = Vb + (size_t)(J) * 64 * ldv; _Pragma("unroll") for (int i = 0; i < NVC; ++i) vs[i] = *(const bf16x8*)(vn + vg[i]); } while (0)
#define FP_WRITEK(B) do { _Pragma("unroll") for (int i = 0; i < NKC; ++i) *(bf16x8*)(lds + (B) * KBYTES + kl[i]) = ks[i]; } while (0)
#define FP_WRITEV(B) do { _Pragma("unroll") for (int i = 0; i < NVC; ++i) *(bf16x8*)(lds + (B) * VBYTES + vl[i]) = vs[i]; } while (0)
#define FP_PARTIAL(P0) do { _Pragma("unroll") for (int r = 0; r < 16; ++r) P0[r] = __builtin_amdgcn_exp2f(P0[r]); } while (0)
#define FP_FINISH(P0, P1) do { _Pragma("unroll") for (int r = 0; r < 16; ++r) P1[r] = __builtin_amdgcn_exp2f(P1[r]); \
    { const f32x16 s_ = P0 + P1; lsum += ((s_[0] + s_[1]) + (s_[2] + s_[3])) + ((s_[4] + s_[5]) + (s_[6] + s_[7])) + ((s_[8] + s_[9]) + (s_[10] + s_[11])) + ((s_[12] + s_[13]) + (s_[14] + s_[15])); } \
    PK4(P0, 0, pa0); PK4(P0, 8, pa1); PK4(P1, 0, pa2); PK4(P1, 8, pa3); } while (0)
#define FP_STEP(PX0, PX1, PY0, PY1, JJ) do { \
    SBAR(); \
    if ((JJ) + 1 < NTILE) qkt<DQK, KS>(PY0, PY1, lds + (((JJ) + 1) & 1) * KBYTES, qr, r32, hi); \
    FP_FINISH(PX0, PX1); \
    SBAR(); \
    if ((JJ) + 2 < NTILE) FP_LOADK((JJ) + 2); \
    if ((JJ) + 1 < NTILE) FP_LOADV((JJ) + 1); \
    SBAR(); \
    pv_all<DV>(o, vb0 + ((JJ) & 1) * VBYTES, pa0, pa1, pa2, pa3); \
    if ((JJ) + 1 < NTILE) FP_PARTIAL(PY0); \
    SBAR(); \
    if ((JJ) + 2 < NTILE) FP_WRITEK((JJ) & 1); \
    if ((JJ) + 1 < NTILE) FP_WRITEV(((JJ) + 1) & 1); \
    __syncthreads(); } while (0)
  f32x16 pA0, pA1, pB0, pB1; bf16x8 pa0, pa1, pa2, pa3;
  float lsum = 0.f;
  FP_LOADK(0); FP_LOADV(0); FP_WRITEK(0); FP_WRITEV(0); FP_LOADK(1); FP_WRITEK(1);
  __syncthreads();
  qkt<DQK, KS>(pA0, pA1, lds, qr, r32, hi);
  FP_PARTIAL(pA0);
  __syncthreads();
  for (int j = 0; j < NTILE; j += 2) {
    FP_STEP(pA0, pA1, pB0, pB1, j);
    FP_STEP(pB0, pB1, pA0, pA1, j + 1);
  }
#undef FP_LOADK
#undef FP_LOADV
#undef FP_WRITEK
#undef FP_WRITEV
#undef FP_PARTIAL
#undef FP_FINISH
#undef FP_STEP
  l_out = half_sum(lsum);
}

template <int DQK, int DV, bool DEEP>
DI void flash_pipe(const u16* __restrict__ Qlane, const u16* __restrict__ Kb, const int ldk, const u16* __restrict__ Vb, const int ldv,
                   f32x16 (&o)[DV / 32], float& l_out, char* lds) {
  constexpr int KS = DQK == 64 ? 128 : 256, KCR = DQK / 8, NKC = (KCR + 7) / 8, VCR = DV / 8, NVC = VCR / 8, ND0 = DV / 32, NQ = DQK / 16;
  constexpr int KBYTES = 64 * KS, VBYTES = 64 * DV * 2, VOFF0 = 2 * KBYTES, NTILE = SEQ / 64;
  const int tid = my_tid(), lane = tid & 63, r32 = lane & 31, hi = lane >> 5;
  bf16x8 qr[NQ];
#pragma unroll
  for (int d0 = 0; d0 < NQ; ++d0) qr[d0] = *(const bf16x8*)(Qlane + d0 * 16);
  int kg[NKC], kl[NKC], vg[NVC], vl[NVC];
#pragma unroll
  for (int i = 0; i < NKC; ++i) { const int c = min(tid + i * NTHR, 64 * KCR - 1), row = c / KCR, cc = c % KCR; kg[i] = row * ldk + cc * 8; kl[i] = kswz<KS>(row, cc); }
#pragma unroll
  for (int i = 0; i < NVC; ++i) { const int c = tid + i * NTHR, key = c / VCR, c8 = c % VCR; vg[i] = key * ldv + c8 * 8; vl[i] = VOFF0 + v_st<DV>(key, c8 * 8); }
  const int vb0 = (int)(uintptr_t)lds + VOFF0 + v_rd_base(lane);
#pragma unroll
  for (int d = 0; d < ND0; ++d)
#pragma unroll
    for (int r = 0; r < 16; ++r) o[d][r] = 0.f;
  bf16x8 ksA[NKC], vsA[NVC], ksB[NKC], vsB[NVC];
#define FP_LOADK(KSR, J) do { const u16* kn = Kb + (size_t)(J) * 64 * ldk; _Pragma("unroll") for (int i = 0; i < NKC; ++i) KSR[i] = *(const bf16x8*)(kn + kg[i]); } while (0)
#define FP_LOADV(VSR, J) do { const u16* vn = Vb + (size_t)(J) * 64 * ldv; _Pragma("unroll") for (int i = 0; i < NVC; ++i) VSR[i] = *(const bf16x8*)(vn + vg[i]); } while (0)
#define FP_WRITEK(KSR, B) do { _Pragma("unroll") for (int i = 0; i < NKC; ++i) *(bf16x8*)(lds + (B) * KBYTES + kl[i]) = KSR[i]; } while (0)
#define FP_WRITEV(VSR, B) do { _Pragma("unroll") for (int i = 0; i < NVC; ++i) *(bf16x8*)(lds + (B) * VBYTES + vl[i]) = VSR[i]; } while (0)
#define FP_PARTIAL(P0) do { _Pragma("unroll") for (int r = 0; r < 16; ++r) P0[r] = __builtin_amdgcn_exp2f(P0[r]); } while (0)
#define FP_FINISH(P0, P1) do { _Pragma("unroll") for (int r = 0; r < 16; ++r) P1[r] = __builtin_amdgcn_exp2f(P1[r]); \
    { const f32x16 s_ = P0 + P1; lsum += ((s_[0] + s_[1]) + (s_[2] + s_[3])) + ((s_[4] + s_[5]) + (s_[6] + s_[7])) + ((s_[8] + s_[9]) + (s_[10] + s_[11])) + ((s_[12] + s_[13]) + (s_[14] + s_[15])); } \
    PK4(P0, 0, pa0); PK4(P0, 8, pa1); PK4(P1, 0, pa2); PK4(P1, 8, pa3); } while (0)
#define FP_STEP(PX0, PX1, PY0, PY1, KX, VX, KY, VY, JJ) do { \
    SBAR(); \
    if (DEEP) { if ((JJ) + 3 < NTILE) FP_LOADK(KY, (JJ) + 3); if ((JJ) + 2 < NTILE) FP_LOADV(VY, (JJ) + 2); } \
    SBAR(); \
    if ((JJ) + 1 < NTILE) qkt<DQK, KS>(PY0, PY1, lds + (((JJ) + 1) & 1) * KBYTES, qr, r32, hi); \
    FP_FINISH(PX0, PX1); \
    SBAR(); \
    if (!DEEP) { if ((JJ) + 2 < NTILE) FP_LOADK(KX, (JJ) + 2); if ((JJ) + 1 < NTILE) FP_LOADV(VX, (JJ) + 1); } \
    SBAR(); \
    pv_all<DV>(o, vb0 + ((JJ) & 1) * VBYTES, pa0, pa1, pa2, pa3); \
    if ((JJ) + 1 < NTILE) FP_PARTIAL(PY0); \
    SBAR(); \
    if ((JJ) + 2 < NTILE) FP_WRITEK(KX, (JJ) & 1); \
    if ((JJ) + 1 < NTILE) FP_WRITEV(VX, ((JJ) + 1) & 1); \
    __syncthreads(); } while (0)
  f32x16 pA0, pA1, pB0, pB1; bf16x8 pa0, pa1, pa2, pa3;
  float lsum = 0.f;
  FP_LOADK(ksA, 0); FP_LOADV(vsA, 0); FP_LOADK(ksB, 1);
  FP_WRITEK(ksA, 0); FP_WRITEV(vsA, 0); FP_WRITEK(ksB, 1);
  if (DEEP) { FP_LOADK(ksA, 2); FP_LOADV(vsA, 1); }
  __syncthreads();
  qkt<DQK, KS>(pA0, pA1, lds, qr, r32, hi);
  FP_PARTIAL(pA0);
  __syncthreads();
  for (int j = 0; j < NTILE; j += 2) {
    FP_STEP(pA0, pA1, pB0, pB1, ksA, vsA, ksB, vsB, j);
    FP_STEP(pB0, pB1, pA0, pA1, ksB, vsB, ksA, vsA, j + 1);
  }
#undef FP_LOADK
#undef FP_LOADV
#undef FP_WRITEK
#undef FP_WRITEV
#undef FP_PARTIAL
#undef FP_FINISH
#undef FP_STEP
  l_out = half_sum(lsum);
}

template <int DQK>
DI void flash_p2(const u16* __restrict__ Qlane, const u16* __restrict__ Kb, const int ldk, const u16* __restrict__ Vb, const int ldv,
                 f32x16 (&o)[2], float& l_out, char* lds) {
  constexpr int KS = DQK == 64 ? 128 : 256, KCR = DQK / 8, NKC = KCR / 4, NVC = 2, NQ = DQK / 16;
  constexpr int KST = 128 * KS, VST = 16384, VOFF0 = 3 * KST, NPAIR = SEQ / 128;
  const int tid = my_tid(), lane = tid & 63, r32 = lane & 31, hi = lane >> 5;
  bf16x8 qr[NQ];
#pragma unroll
  for (int d0 = 0; d0 < NQ; ++d0) qr[d0] = *(const bf16x8*)(Qlane + d0 * 16);
  int kg[NKC], kl[NKC], vg[NVC], vl[NVC];
#pragma unroll
  for (int i = 0; i < NKC; ++i) { const int c = tid + i * NTHR, row = c / KCR, cc = c % KCR; kg[i] = row * ldk + cc * 8; kl[i] = kswz<KS>(row, cc); }
#pragma unroll
  for (int i = 0; i < NVC; ++i) { const int c = tid + i * NTHR, key = c >> 3, c8 = c & 7; vg[i] = key * ldv + c8 * 8; vl[i] = VOFF0 + (key >> 6) * 8192 + v_st<64>(key & 63, c8 * 8); }
  const int vb0 = (int)(uintptr_t)lds + VOFF0 + v_rd_base(lane);
#pragma unroll
  for (int d = 0; d < 2; ++d)
#pragma unroll
    for (int r = 0; r < 16; ++r) o[d][r] = 0.f;
  bf16x8 ks[NKC], vs[NVC];
#define P2_LOADK(M) do { const u16* kn = Kb + (size_t)(M) * 128 * ldk; _Pragma("unroll") for (int i = 0; i < NKC; ++i) ks[i] = *(const bf16x8*)(kn + kg[i]); } while (0)
#define P2_LOADV(M) do { const u16* vn = Vb + (size_t)(M) * 128 * ldv; _Pragma("unroll") for (int i = 0; i < NVC; ++i) vs[i] = *(const bf16x8*)(vn + vg[i]); } while (0)
#define P2_WRITEK(OFF) do { _Pragma("unroll") for (int i = 0; i < NKC; ++i) *(bf16x8*)(lds + (OFF) + kl[i]) = ks[i]; } while (0)
#define P2_WRITEV(S) do { _Pragma("unroll") for (int i = 0; i < NVC; ++i) *(bf16x8*)(lds + (S) * VST + vl[i]) = vs[i]; } while (0)
#define P2_PARTIAL(P0) do { _Pragma("unroll") for (int r = 0; r < 16; ++r) P0[r] = __builtin_amdgcn_exp2f(P0[r]); } while (0)
#define P2_FINISH(P0, P1) do { _Pragma("unroll") for (int r = 0; r < 16; ++r) P1[r] = __builtin_amdgcn_exp2f(P1[r]); \
    { const f32x16 s_ = P0 + P1; lsum += ((s_[0] + s_[1]) + (s_[2] + s_[3])) + ((s_[4] + s_[5]) + (s_[6] + s_[7])) + ((s_[8] + s_[9]) + (s_[10] + s_[11])) + ((s_[12] + s_[13]) + (s_[14] + s_[15])); } \
    PK4(P0, 0, pa0); PK4(P0, 8, pa1); PK4(P1, 0, pa2); PK4(P1, 8, pa3); } while (0)
  f32x16 pA0, pA1, pB0, pB1; bf16x8 pa0, pa1, pa2, pa3;
  float lsum = 0.f;
  P2_LOADK(0); P2_WRITEK(0); P2_LOADK(1); P2_WRITEK(KST); P2_LOADV(0); P2_WRITEV(0);
  __syncthreads();
  qkt<DQK, KS>(pA0, pA1, lds, qr, r32, hi);
  P2_PARTIAL(pA0);
  __syncthreads();
  int k0 = 0, k1 = KST, k2 = 2 * KST;
  for (int m = 0; m < NPAIR; ++m) {
    const int s = m & 1;
    SBAR();
    if (m + 2 < NPAIR) P2_LOADK(m + 2);
    if (m + 1 < NPAIR) P2_LOADV(m + 1);
    SBAR();
    qkt<DQK, KS>(pB0, pB1, lds + k0 + 64 * KS, qr, r32, hi);
    P2_FINISH(pA0, pA1);
    SBAR();
    pv_all<64>(o, vb0 + s * VST, pa0, pa1, pa2, pa3);
    P2_PARTIAL(pB0);
    SBAR();
    if (m + 1 < NPAIR) qkt<DQK, KS>(pA0, pA1, lds + k1, qr, r32, hi);
    P2_FINISH(pB0, pB1);
    SBAR();
    pv_all<64>(o, vb0 + s * VST + 8192, pa0, pa1, pa2, pa3);
    if (m + 1 < NPAIR) P2_PARTIAL(pA0);
    SBAR();
    if (m + 2 < NPAIR) P2_WRITEK(k2);
    { const int t_ = k0; k0 = k1; k1 = k2; k2 = t_; }
    if (m + 1 < NPAIR) P2_WRITEV(s ^ 1);
    __syncthreads();
  }
#undef P2_LOADK
#undef P2_LOADV
#undef P2_WRITEK
#undef P2_WRITEV
#undef P2_PARTIAL
#undef P2_FINISH
  l_out = half_sum(lsum);
}

template <int ND0>
DI void store_gated(const f32x16 (&o)[ND0], const u16* gp, u16* op, int hi) {
#pragma unroll
  for (int d = 0; d < ND0; ++d) { f32x16 g; load_blk_bf16(gp + 32 * d, hi, g); f32x16 v = o[d] * g; store_blk_bf16(op + 32 * d, v, hi); }
}

template <int DV>
DI void store_gated_staged(const f32x16 (&o)[DV / 32], const u16* __restrict__ gate0, const int ldg, u16* __restrict__ out0, char* lds) {
  constexpr int STR = DV * 4 + 16, NCH = DV / 8;
  const int tid = my_tid(), wave = tid >> 6, lane = tid & 63, r32 = lane & 31, hi = lane >> 5;
  char* rowp = lds + (wave * 32 + r32) * STR;
#pragma unroll
  for (int d = 0; d < DV / 32; ++d)
#pragma unroll
    for (int q = 0; q < 4; ++q) { f32x4 v; v[0] = o[d][4 * q]; v[1] = o[d][4 * q + 1]; v[2] = o[d][4 * q + 2]; v[3] = o[d][4 * q + 3]; *(f32x4*)(rowp + (32 * d + 8 * q + 4 * hi) * 4) = v; }
  __syncthreads();
#pragma unroll
  for (int i = 0; i < (256 * NCH) / NTHR; ++i) {
    const int c = tid + i * NTHR, row = c / NCH, ch = c % NCH;
    const f32x4 a = *(const f32x4*)(lds + row * STR + ch * 32), b = *(const f32x4*)(lds + row * STR + ch * 32 + 16);
    const u32x4 g = *(const u32x4*)(gate0 + (size_t)row * ldg + ch * 8);
    u32x4 w;
    w.x = cvtpk(a[0] * bflo(g.x), a[1] * bfhi(g.x)); w.y = cvtpk(a[2] * bflo(g.y), a[3] * bfhi(g.y));
    w.z = cvtpk(b[0] * bflo(g.z), b[1] * bfhi(g.z)); w.w = cvtpk(b[2] * bflo(g.w), b[3] * bfhi(g.w));
    *(u32x4*)(out0 + (size_t)row * LDX + ch * 8) = w;
  }
  __syncthreads();
}

DI void na_item(const Params& p, int b, int h, int rp, char* lds) {
  constexpr int KBYTES = 8192, ABUF = 16384;
  const int tid = my_tid(), wave = tid >> 6, lane = tid & 63, r32 = lane & 31, hi = lane >> 5;
  float* tbl = (float*)(lds + 2 * ABUF);
  for (int i = tid; i < 465; i += NTHR) tbl[i] = p.rpb_a[h * 465 + i] * LOG2E;
  const int gr = 4 * rp + (wave >> 1), cq = (wave & 1) * 32 + r32;
  const int r0w = min(max(gr - 4, 0), 56), ra = min(max(4 * rp - 4, 0), 56), rb = min(max(4 * rp - 1, 0), 56) + 8;
  const int c0 = min(max(cq - 8, 0), 48);
  const size_t tb = (size_t)b * SEQ;
  const u16* Qlane = p.proj + (tb + gr * 64 + cq) * NE + h * 64 + hi * 8;
  const u16* Kb = p.proj + tb * NE + 512 + h * 64; const u16* Vb = p.proj + tb * NE + 1024 + h * 64;
  bf16x8 qr[4];
#pragma unroll
  for (int d0 = 0; d0 < 4; ++d0) qr[d0] = *(const bf16x8*)(Qlane + d0 * 16);
  int kg[1], kl[1], vl[1];
#pragma unroll
  for (int i = 0; i < 1; ++i) { const int c = tid, row = c >> 3, cc = c & 7; kg[i] = row * NE + cc * 8; kl[i] = kswz<128>(row, cc); vl[i] = KBYTES + v_st<64>(row, cc * 8); }
  const int vb0 = (int)(uintptr_t)lds + KBYTES + v_rd_base(lane);
  float m = -1e30f, l = 0.f; f32x16 o[2];
#pragma unroll
  for (int d = 0; d < 2; ++d)
#pragma unroll
    for (int r = 0; r < 16; ++r) o[d][r] = 0.f;
  bf16x8 ks[1], vs[1];
  {
    const u16* kn = Kb + (size_t)ra * 64 * NE; const u16* vn = Vb + (size_t)ra * 64 * NE;
#pragma unroll
    for (int i = 0; i < 1; ++i) { ks[i] = *(const bf16x8*)(kn + kg[i]); vs[i] = *(const bf16x8*)(vn + kg[i]); }
#pragma unroll
    for (int i = 0; i < 1; ++i) { *(bf16x8*)(lds + kl[i]) = ks[i]; *(bf16x8*)(lds + vl[i]) = vs[i]; }
  }
  __syncthreads();
  const float C = 0.125f * LOG2E;
  const int nt = rb - ra;
  for (int j = 0; j < nt; ++j) {
    const int cur = j & 1, kr = ra + j;
    if (j + 1 < nt) {
      const u16* kn = Kb + (size_t)(kr + 1) * 64 * NE; const u16* vn = Vb + (size_t)(kr + 1) * 64 * NE;
#pragma unroll
      for (int i = 0; i < 1; ++i) { ks[i] = *(const bf16x8*)(kn + kg[i]); vs[i] = *(const bf16x8*)(vn + kg[i]); }
    }
    if (kr >= r0w && kr < r0w + 8) {
      f32x16 p0, p1; bf16x8 pa0, pa1, pa2, pa3;
      qkt<64, 128>(p0, p1, lds + cur * ABUF, qr, r32, hi);
      const int rowoff = (kr - gr + 7) * 31 + 15 - cq;
#pragma unroll
      for (int r = 0; r < 16; ++r) {
        const int kc = crow(r, hi);
        const float b0 = tbl[rowoff + kc], b1 = tbl[rowoff + kc + 32];
        p0[r] = ((unsigned)(kc - c0) < 16u) ? fmaf(p0[r], C, b0) : -1e30f;
        p1[r] = ((unsigned)(kc + 32 - c0) < 16u) ? fmaf(p1[r], C, b1) : -1e30f;
      }
      softmax_step<2>(p0, p1, m, l, o, pa0, pa1, pa2, pa3);
      pv_all<64>(o, vb0 + cur * ABUF, pa0, pa1, pa2, pa3);
    }
    if (j + 1 < nt) {
      char* nb = lds + (cur ^ 1) * ABUF;
#pragma unroll
      for (int i = 0; i < 1; ++i) { *(bf16x8*)(nb + kl[i]) = ks[i]; *(bf16x8*)(nb + vl[i]) = vs[i]; }
    }
    __syncthreads();
  }
  const float inv = 1.f / l;
  o[0] = o[0] * inv; o[1] = o[1] * inv;
  const size_t T = tb + gr * 64 + cq;
  { const size_t T0 = tb + (size_t)rp * 256; store_gated_staged<64>(o, p.proj + T0 * NE + 2304 + h * 64, NE, p.ob + T0 * LDX + h * 64, lds); }
}

DI void attn_phase_even(const Params& p, char* lds) {
  const int wave = my_tid() >> 6, lane = my_tid() & 63, r32 = lane & 31, hi = lane >> 5;
  for (int t = blockIdx.x; t < 1024; t += gridDim.x) { const int b = t & 7, idx = t >> 3; na_item(p, b, idx >> 4, idx & 15, lds); }
  for (int t = blockIdx.x; t < 1024; t += gridDim.x) {
    const int b = t & 7, idx = t >> 3, h = idx >> 4, qb = idx & 15, kvh = h >> 2;
    const size_t tb = (size_t)b * SEQ, T = tb + qb * 256 + wave * 32 + r32;
    f32x16 o[2]; float l;
    flash_p2<64>(p.proj + T * NE + 1536 + h * 64 + hi * 8, p.proj + tb * NE + 2048 + kvh * 64, NE, p.proj + tb * NE + 2176 + kvh * 64, NE, o, l, lds);
    const float inv = 1.f / l; o[0] = o[0] * inv; o[1] = o[1] * inv;
    { const size_t T0 = tb + (size_t)qb * 256; store_gated_staged<64>(o, p.proj + T0 * NE + 2304 + 512 + h * 64, NE, p.ob + T0 * LDX + 512 + h * 64, lds); }
  }
}
DI void attn_phase_odd(const Params& p, char* lds) {
  const int wave = my_tid() >> 6, lane = my_tid() & 63, r32 = lane & 31, hi = lane >> 5;
  for (int t = blockIdx.x; t < 1024; t += gridDim.x) {
    const int b = t & 7, idx = t >> 3, h = idx >> 4, qb = idx & 15;
    const size_t tb = (size_t)b * SEQ, T = tb + qb * 256 + wave * 32 + r32;
    f32x16 o[2]; float l;
    flash_p2<96>(p.qc + T * 768 + h * 96 + hi * 8, p.kc + tb * 768 + h * 96, 768, p.vc + tb * 512 + h * 64, 512, o, l, lds);
    const float inv = 1.f / l; o[0] = o[0] * inv; o[1] = o[1] * inv;
    { const size_t T0 = tb + (size_t)qb * 256; store_gated_staged<64>(o, p.proj + T0 * NO + 1920 + h * 64, NO, p.ob + T0 * LDX + h * 64, lds); }
  }
  const float lam = p.lam[0], nMd = -p.lam[3] * LOG2E;
  for (int t = blockIdx.x; t < 512; t += gridDim.x) {
    const int b = t & 7, idx = t >> 3, h = idx >> 4, qb = idx & 15;
    const size_t tb = (size_t)b * SEQ, T = tb + qb * 256 + wave * 32 + r32;
    f32x16 o1[4]; float l1, l2;
    const u16* vb = p.proj + tb * NO + 1408 + h * 128;
    float* stash = (float*)p.xb + (size_t)blockIdx.x * 32768 + my_tid() * 64;
    flash<64, 128>(p.proj + T * NO + 384 + h * 128 + hi * 8, p.proj + tb * NO + 896 + h * 128, NO, vb, NO, 0.125f * LOG2E, nMd, o1, l1, lds);
    { const float inv = 1.f / l1;
#pragma unroll
      for (int d = 0; d < 4; ++d)
#pragma unroll
        for (int q = 0; q < 4; ++q) { f32x4 v; v[0] = o1[d][4 * q] * inv; v[1] = o1[d][4 * q + 1] * inv; v[2] = o1[d][4 * q + 2] * inv; v[3] = o1[d][4 * q + 3] * inv; *(f32x4*)(stash + (d * 4 + q) * 4) = v; } }
    flash<64, 128>(p.proj + T * NO + 384 + h * 128 + 64 + hi * 8, p.proj + tb * NO + 896 + h * 128 + 64, NO, vb, NO, 0.125f * LOG2E, nMd, o1, l2, lds);
    const float f = lam / l2; float ss = 0.f;
#pragma unroll
    for (int d = 0; d < 4; ++d) {
#pragma unroll
      for (int q = 0; q < 4; ++q) { const f32x4 v = *(const f32x4*)(stash + (d * 4 + q) * 4);
#pragma unroll
        for (int j = 0; j < 4; ++j) o1[d][4 * q + j] = v[j] - o1[d][4 * q + j] * f; }
      ss += sumsq16(o1[d]);
    }
    ss = half_sum(ss);
    const float ri = rsqrtf(ss * (1.f / 128) + EPS) * (1.f - LAM_INIT);
#pragma unroll
    for (int d = 0; d < 4; ++d) { f32x16 g; load_blk_f32(p.g_sub_d + 32 * d, hi, g); o1[d] = o1[d] * ri * g; }
    { const size_t T0 = tb + (size_t)qb * 256; store_gated_staged<128>(o1, p.proj + T0 * NO + 1920 + 512 + h * 128, NO, p.ob + T0 * LDX + 512 + h * 128, lds); }
  }
}

DI void grid_bar(unsigned* cnt, unsigned target) {
  asm volatile("s_waitcnt vmcnt(0)" ::: "memory");
  __syncthreads();
  if (threadIdx.x == 0) {
    __builtin_amdgcn_fence(__ATOMIC_RELEASE, "agent");
    asm volatile("s_waitcnt vmcnt(0)" ::: "memory");
    __hip_atomic_fetch_add(cnt, 1u, __ATOMIC_RELAXED, __HIP_MEMORY_SCOPE_AGENT);
    unsigned spins = 0;
    while (__hip_atomic_load(cnt, __ATOMIC_RELAXED, __HIP_MEMORY_SCOPE_AGENT) < target) { __builtin_amdgcn_s_sleep(2); if (++spins > (1u << 24)) break; }
    __builtin_amdgcn_fence(__ATOMIC_ACQUIRE, "agent");
    asm volatile("s_waitcnt vmcnt(0)" ::: "memory");
  }
  __syncthreads();
}

constexpr int LDS_BYTES = 147456;
__global__ void __launch_bounds__(512, 2) mega(Params p) {
  extern __shared__ __attribute__((aligned(16))) char lds[];
  cg::grid_group grid = cg::this_grid();
  const int lo = p.phase_lo, hi_ = p.phase_hi;
#ifndef PROBE_REPEAT
#define PROBE_REPEAT -1
#endif
#define PHASE(k, body) if (lo <= k && k <= hi_) { if (k > lo) { if (k == 1) grid.sync(); else grid_bar(p.bar, (unsigned)(k - 1) * gridDim.x); } body; if (k == PROBE_REPEAT) { grid.sync(); body; } }
  PHASE(0, phase0(p))
  PHASE(1, gemm_phase8<0>(p, lds))
  PHASE(2, attn_phase_even(p, lds))
  PHASE(3, gemm_phase8<1>(p, lds))
  PHASE(4, gemm_phase8<2>(p, lds))
  PHASE(5, upproj_phase(p, lds))
  PHASE(6, attn_phase_odd(p, lds))
  PHASE(7, gemm_phase8<3>(p, lds))
#undef PHASE
}

#ifndef NLAUNCH
#define NLAUNCH 1
#endif
extern "C" void kernel_launch(void* const* d_in, const int* in_sizes, int n_in, void* d_out, int out_size, void* d_ws, size_t ws_size, hipStream_t stream) {
  static int grid_blocks = 0;
  if (!grid_blocks) {
    int dev = 0, cus = 0, per_cu = 0;
    (void)hipGetDevice(&dev);
    (void)hipDeviceGetAttribute(&cus, hipDeviceAttributeMultiprocessorCount, dev);
    (void)hipFuncSetAttribute((const void*)mega, hipFuncAttributeMaxDynamicSharedMemorySize, LDS_BYTES);
    (void)hipOccupancyMaxActiveBlocksPerMultiprocessor(&per_cu, mega, NTHR, LDS_BYTES);
    if (per_cu > 1) per_cu = 1;
    if (per_cu < 1) per_cu = 1;
    grid_blocks = cus * per_cu;
  }
  Params p;
  memset(&p, 0, sizeof(p));
  const float** fp = (const float**)&p;
  for (int i = 0; i < 25; ++i) fp[i] = (const float*)d_in[i];
  p.out = (float*)d_out;
  char* w = (char*)d_ws; size_t off = 0;
  auto take = [&](size_t bytes) { char* r = w + off; off += (bytes + 255) & ~(size_t)255; return r; };
  p.xb = (u16*)take((size_t)NTOK * LDX * 2);
  p.proj = (u16*)take((size_t)NTOK * NE * 2);
  p.ob = (u16*)take((size_t)NTOK * LDX * 2);
  p.qc = (u16*)take((size_t)NTOK * 768 * 2);
  p.kc = (u16*)take((size_t)NTOK * 768 * 2);
  p.vc = (u16*)take((size_t)NTOK * 512 * 2);
  p.wt_ine = (u16*)take((size_t)NE * LDX * 2);
  p.wt_oute = (u16*)take((size_t)1024 * LDX * 2);
  p.wt_ino = (u16*)take((size_t)NO * LDX * 2);
  p.wt_cq = (u16*)take((size_t)768 * 256 * 2);
  p.wt_ckv = (u16*)take((size_t)1024 * 128 * 2);
  p.wt_outo = (u16*)take((size_t)1024 * LDX * 2);
  p.rs0 = (float*)take(NTOK * 4); p.ss1 = (float*)take(NTOK * 4); p.sscq = (float*)take(NTOK * 4); p.ssckv = (float*)take(NTOK * 4);
  p.lam = (float*)take(256);
  p.bar = (unsigned*)take(256);
  p.tab_ax = (float2*)take(64 * 16 * 8); p.tab_mla = (float2*)take(4096 * 16 * 8); p.tab_part = (float2*)take(4096 * 8 * 8);
  if (off > ws_size) { fprintf(stderr, "workspace too small: need %zu have %zu\n", off, ws_size); return; }
  for (int i = 0; i < 16; ++i) p.inv16[i] = (float)pow(10000.0, -(double)i / 16.0);
  for (int i = 0; i < 8; ++i) p.inv8[i] = (float)pow(500000.0, -(double)i / 8.0);
#if NLAUNCH == 1
  p.phase_lo = 0; p.phase_hi = 7;
  void* args[] = {&p};
  hipError_t e = hipLaunchCooperativeKernel((void*)mega, dim3(grid_blocks), dim3(NTHR), args, LDS_BYTES, stream);
  if (e != hipSuccess) fprintf(stderr, "cooperative launch failed: %s (grid %d)\n", hipGetErrorString(e), grid_blocks);
#else
  for (int ph = 0; ph < 8; ++ph) { p.phase_lo = ph; p.phase_hi = ph; hipLaunchKernelGGL(mega, dim3(grid_blocks), dim3(NTHR), LDS_BYTES, stream, p); }
#endif
}
```

```cpp
#include <hip/hip_runtime.h>
#include <hip/hip_cooperative_groups.h>
#include <cstdio>
#include <cstdint>
#include <cmath>
#include <cstring>
namespace cg = cooperative_groups;

typedef unsigned short u16;
using bf16x8 = __attribute__((ext_vector_type(8))) short;
using s16x4  = __attribute__((ext_vector_type(4))) short;
using f32x16 = __attribute__((ext_vector_type(16))) float;
using f32x4  = __attribute__((ext_vector_type(4))) float;
using u32x4  = __attribute__((ext_vector_type(4))) unsigned;
using u32x2  = __attribute__((ext_vector_type(2))) unsigned;

#define DI __device__ __forceinline__
#define MFMA32(a, b, c) __builtin_amdgcn_mfma_f32_32x32x16_bf16((a), (b), (c), 0, 0, 0)
#define SBAR() __builtin_amdgcn_sched_barrier(0)

constexpr int NTOK = 32768, SEQ = 4096, DM = 1024, NE = 3328, NO = 3072;
constexpr int NTHR = 512, NWAVE = 8;
constexpr int LDX = 1024;
constexpr float EPS = 1e-6f, LOG2E = 1.4426950408889634f;
constexpr float LAM_INIT = 0.35550906759096930f;

struct Params {
  const float *x, *norm_e, *w_in_e, *gq_a, *gk_a, *rpb_a, *gq_b, *gk_b, *w_out_e,
      *norm_o, *w_in_o, *g_cq, *w_cq_b, *g_ckv, *w_ckv_b, *gq_c, *gk_c, *gq_d, *gk_d,
      *lam_q1, *lam_k1, *lam_q2, *lam_k2, *g_sub_d, *w_out_o;
  float* out;
  u16 *xb, *proj, *ob, *qc, *kc, *vc, *wt_ine, *wt_oute, *wt_ino, *wt_cq, *wt_ckv, *wt_outo;
  float *rs0, *ss1, *sscq, *ssckv, *lam;
  unsigned* bar;
  float2 *tab_ax, *tab_mla, *tab_part;
  float inv16[16];
  float inv8[8];
  int phase_lo, phase_hi;
};

DI int my_tid() { int t = threadIdx.x; asm volatile("" : "+v"(t)); return t; }
DI int crow(int r, int hi) { return (r & 3) + 8 * (r >> 2) + 4 * hi; }
DI unsigned cvtpk(float lo, float hi) { unsigned r; asm volatile("v_cvt_pk_bf16_f32 %0, %1, %2" : "=v"(r) : "v"(lo), "v"(hi)); return r; }
DI float bflo(unsigned w) { return __uint_as_float(w << 16); }
DI float bfhi(unsigned w) { return __uint_as_float(w & 0xffff0000u); }
DI float half_sum(float v) {
  auto rr = __builtin_amdgcn_permlane32_swap(__float_as_uint(v), __float_as_uint(v), false, false);
  return __uint_as_float(rr[0]) + __uint_as_float(rr[1]);
}
DI float half_max(float v) {
  auto rr = __builtin_amdgcn_permlane32_swap(__float_as_uint(v), __float_as_uint(v), false, false);
  return fmaxf(__uint_as_float(rr[0]), __uint_as_float(rr[1]));
}
DI float wave_sum(float v) {
  v += __shfl_xor(v, 32); v += __shfl_xor(v, 16); v += __shfl_xor(v, 8); v += __shfl_xor(v, 4); v += __shfl_xor(v, 2); v += __shfl_xor(v, 1);
  return v;
}
DI void store_blk_bf16(u16* rowp, const f32x16& v, int hi) {
#pragma unroll
  for (int q = 0; q < 4; ++q) { u32x2 w; w.x = cvtpk(v[4 * q], v[4 * q + 1]); w.y = cvtpk(v[4 * q + 2], v[4 * q + 3]); *(u32x2*)(rowp + 8 * q + 4 * hi) = w; }
}
DI void load_blk_f32(const float* g, int hi, f32x16& o) {
#pragma unroll
  for (int q = 0; q < 4; ++q) { f32x4 t = *(const f32x4*)(g + 8 * q + 4 * hi); o[4 * q] = t[0]; o[4 * q + 1] = t[1]; o[4 * q + 2] = t[2]; o[4 * q + 3] = t[3]; }
}
DI void load_blk_bf16(const u16* g, int hi, f32x16& o) {
#pragma unroll
  for (int q = 0; q < 4; ++q) { u32x2 w = *(const u32x2*)(g + 8 * q + 4 * hi); o[4 * q] = bflo(w.x); o[4 * q + 1] = bfhi(w.x); o[4 * q + 2] = bflo(w.y); o[4 * q + 3] = bfhi(w.y); }
}
DI float sumsq16(const f32x16& v) { float s = 0;
#pragma unroll
  for (int r = 0; r < 16; ++r) s = fmaf(v[r], v[r], s); return s; }
DI void rot16(f32x16& v, const float2* tab, int hi) {
#pragma unroll
  for (int r = 0; r < 8; ++r) { const float2 cs = tab[crow(r, hi)]; const float a = v[r], b = v[r + 8]; v[r] = a * cs.x - b * cs.y; v[r + 8] = b * cs.x + a * cs.y; }
}
DI void rot8(f32x16& v, const float2* tab, int hi) {
#pragma unroll
  for (int r = 0; r < 4; ++r) { const float2 cs = tab[r + 4 * hi]; const float a = v[r], b = v[r + 4]; v[r] = a * cs.x - b * cs.y; v[r + 4] = b * cs.x + a * cs.y; }
}
DI float silu(float v) { return v / (1.f + __expf(-v)); }

DI void sincos_rev(double f, float& c, float& s) {
  const double q = floor(4.0 * f + 0.5), y = f - 0.25 * q, th = 6.283185307179586 * y, t2 = th * th;
  const double sn = th * (1.0 + t2 * (-1.0 / 6 + t2 * (1.0 / 120 + t2 * (-1.0 / 5040 + t2 * (1.0 / 362880 + t2 * (-1.0 / 39916800 + t2 * (1.0 / 6227020800.0)))))));
  const double cs = 1.0 + t2 * (-0.5 + t2 * (1.0 / 24 + t2 * (-1.0 / 720 + t2 * (1.0 / 40320 + t2 * (-1.0 / 3628800 + t2 * (1.0 / 479001600.0 + t2 * (-1.0 / 87178291200.0)))))));
  const int qi = ((int)q) & 3;
  const double cc = qi == 0 ? cs : qi == 1 ? -sn : qi == 2 ? -cs : sn;
  const double ss = qi == 0 ? sn : qi == 1 ? cs : qi == 2 ? -sn : -cs;
  c = (float)cc; s = (float)ss;
}
DI float2 angle_cs(float pos, float inv) {
  const float ang = __fmul_rn(pos, inv);
  double rev = (double)ang * 0.15915494309189535; rev -= floor(rev);
  float2 r; sincos_rev(rev, r.x, r.y); return r;
}
template <int MODE>
DI void wtrans(const float* __restrict__ W, int K, int N, int Npad, const float* __restrict__ gain, u16* __restrict__ Wt, int ldw, int gt, int gn) {
  const int total = (K / 8) * Npad;
  for (int idx = gt; idx < total; idx += gn) {
    const int n = idx % Npad, kc = idx / Npad;
    int src = n;
    if (MODE == 1) src = n < 384 ? n : (n < 2944 ? n + 32 : (n < 2976 ? n - 2944 + 384 : -1));
    u32x4 w;
#pragma unroll
    for (int j = 0; j < 4; ++j) {
      const int k = kc * 8 + 2 * j; float a = 0.f, b = 0.f;
      if (src >= 0) { a = W[(size_t)k * N + src]; b = W[(size_t)(k + 1) * N + src]; if (gain) { a *= gain[k]; b *= gain[k + 1]; } }
      w[j] = cvtpk(a, b);
    }
    *(u32x4*)(Wt + (size_t)n * ldw + kc * 8) = w;
  }
}
DI void phase0(const Params& p) {
  const int tid = my_tid(), gt = blockIdx.x * NTHR + tid, gn = gridDim.x * NTHR, wave = tid >> 6, lane = tid & 63;
  for (int i = gt; i < NTOK; i += gn) { p.ss1[i] = 0.f; p.sscq[i] = 0.f; p.ssckv[i] = 0.f; }
  for (int row = blockIdx.x * NWAVE + wave; row < NTOK; row += gridDim.x * NWAVE) {
    const float* xr = p.x + (size_t)row * DM; f32x4 v[4]; float ss = 0.f;
#pragma unroll
    for (int i = 0; i < 4; ++i) { v[i] = *(const f32x4*)(xr + i * 256 + lane * 4); ss += v[i][0] * v[i][0] + v[i][1] * v[i][1] + v[i][2] * v[i][2] + v[i][3] * v[i][3]; }
    ss = wave_sum(ss);
    if (lane == 0) p.rs0[row] = rsqrtf(ss * (1.f / DM) + EPS);
#pragma unroll
    for (int i = 0; i < 4; ++i) { u32x2 w; w.x = cvtpk(v[i][0], v[i][1]); w.y = cvtpk(v[i][2], v[i][3]); *(u32x2*)(p.xb + (size_t)row * LDX + i * 256 + lane * 4) = w; }
  }
  wtrans<0>(p.w_in_e, 1024, NE, NE, p.norm_e, p.wt_ine, LDX, gt, gn);
  wtrans<0>(p.w_out_e, 1024, 1024, 1024, nullptr, p.wt_oute, LDX, gt, gn);
  wtrans<1>(p.w_in_o, 1024, 2976, NO, p.norm_o, p.wt_ino, LDX, gt, gn);
  wtrans<0>(p.w_cq_b, 256, 768, 768, p.g_cq, p.wt_cq, 256, gt, gn);
  wtrans<0>(p.w_ckv_b, 128, 1024, 1024, p.g_ckv, p.wt_ckv, 128, gt, gn);
  wtrans<0>(p.w_out_o, 1024, 1024, 1024, nullptr, p.wt_outo, LDX, gt, gn);
  for (int idx = gt; idx < 4096 * 16; idx += gn) p.tab_mla[idx] = angle_cs((float)(idx >> 4), p.inv16[idx & 15]);
  for (int idx = gt; idx < 4096 * 8; idx += gn) p.tab_part[idx] = angle_cs((float)(idx >> 3), p.inv8[idx & 7]);
  for (int idx = gt; idx < 64 * 16; idx += gn) p.tab_ax[idx] = angle_cs((float)(idx >> 4), p.inv16[idx & 15]);
  if (blockIdx.x == 0 && wave == 0) {
    float a = wave_sum(p.lam_q1[lane] * p.lam_k1[lane]), b = wave_sum(p.lam_q2[lane] * p.lam_k2[lane]);
    if (lane == 0) p.lam[0] = expf(a) - expf(b) + LAM_INIT;
    if (lane == 0) __hip_atomic_store(p.bar, 0u, __ATOMIC_RELAXED, __HIP_MEMORY_SCOPE_AGENT);
    float gq = fabsf(p.gq_b[lane]), gk = fabsf(p.gk_b[lane]);
    float gcq = fmaxf(fabsf(p.gq_c[lane]), lane < 32 ? fabsf(p.gq_c[64 + lane]) : 0.f), gck = fmaxf(fabsf(p.gk_c[lane]), lane < 32 ? fabsf(p.gk_c[64 + lane]) : 0.f);
    float gdq = fabsf(p.gq_d[lane]), gdk = fabsf(p.gk_d[lane]);
#pragma unroll
    for (int s = 32; s >= 1; s >>= 1) { gq = fmaxf(gq, __shfl_xor(gq, s)); gk = fmaxf(gk, __shfl_xor(gk, s)); gcq = fmaxf(gcq, __shfl_xor(gcq, s)); gck = fmaxf(gck, __shfl_xor(gck, s));
      gdq = fmaxf(gdq, __shfl_xor(gdq, s)); gdk = fmaxf(gdk, __shfl_xor(gdk, s)); }
    if (lane == 0) { p.lam[1] = 8.f * gq * gk; p.lam[2] = 9.797958971132712f * gcq * gck; p.lam[3] = 8.f * gdq * gdk; }
  }
}

#define LAS3 __attribute__((address_space(3)))
DI void dma16(const void* g, char* lds_uniform) {
  __builtin_amdgcn_global_load_lds((const unsigned*)g, (LAS3 unsigned*)(LAS3 char*)lds_uniform, 16, 0, 0);
}
template <int WM, int WN, int MI, int NI>
DI void gemm_mainloop(const u16* __restrict__ A, const int lda, const u16* __restrict__ Bt, const int ldb, const int K, char* lds, f32x16 (&acc)[MI][NI]) {
  constexpr int BM = WM * MI * 32, BN = WN * NI * 32, BNS = (BN + 63) / 64 * 64, ACH = BM / 64, BCH = BNS / 64, ABYTES = BM * 128, BUF = (BM + BNS) * 128;
  const int tid = my_tid(), wave = __builtin_amdgcn_readfirstlane(tid >> 6), lane = tid & 63, r32 = lane & 31, hi = lane >> 5;
  const int wr = wave / WN, wc = wave % WN;
  const int srow = wave * 8 + (lane >> 3), spos = lane & 7, schunk = spos ^ ((srow >> 1) & 7);
  const u16* ag = A + (size_t)srow * lda + schunk * 8;
  const u16* bg = Bt + (size_t)srow * ldb + schunk * 8;
  const int sw = (r32 >> 1) & 7;
  const int abase = (wr * MI * 32 + r32) * 128, bbase = ABYTES + (wc * NI * 32 + r32) * 128;
#pragma unroll
  for (int mi = 0; mi < MI; ++mi)
#pragma unroll
    for (int ni = 0; ni < NI; ++ni)
#pragma unroll
      for (int r = 0; r < 16; ++r) acc[mi][ni][r] = 0.f;
#define G_DMA(BUFP, KT) do { _Pragma("unroll") for (int i = 0; i < ACH; ++i) dma16(ag + (size_t)i * 64 * lda + (KT) * 64, (BUFP) + i * 8192 + wave * 1024); \
    _Pragma("unroll") for (int i = 0; i < BCH; ++i) dma16(bg + (size_t)i * 64 * ldb + (KT) * 64, (BUFP) + ABYTES + i * 8192 + wave * 1024); } while (0)
#define G_COMPUTE(CUR) do { _Pragma("unroll") for (int kk = 0; kk < 4; ++kk) { const int xk = ((kk * 2 + hi) ^ sw) << 4; bf16x8 af[MI], bfr[NI]; \
    _Pragma("unroll") for (int mi = 0; mi < MI; ++mi) af[mi] = *(const bf16x8*)((CUR) + abase + mi * 4096 + xk); \
    _Pragma("unroll") for (int ni = 0; ni < NI; ++ni) bfr[ni] = *(const bf16x8*)((CUR) + bbase + ni * 4096 + xk); \
    _Pragma("unroll") for (int mi = 0; mi < MI; ++mi) _Pragma("unroll") for (int ni = 0; ni < NI; ++ni) acc[mi][ni] = MFMA32(bfr[ni], af[mi], acc[mi][ni]); } } while (0)
  const int nk = K >> 6;
  G_DMA(lds, 0);
  for (int kt = 0; kt < nk; ++kt) {
    asm volatile("s_waitcnt vmcnt(0)" ::: "memory");
    __syncthreads();
    char* cur = lds + (kt & 1) * BUF;
    if (kt + 1 < nk) G_DMA(lds + ((kt + 1) & 1) * BUF, kt + 1);
    G_COMPUTE(cur);
  }
  __syncthreads();
#undef G_DMA
#undef G_COMPUTE
}

DI void tile_of(int t, int NT, int& mt, int& nt) {
  const int xcd = t & 7, idx = t >> 3, g = idx / (8 * NT), rem = idx % (8 * NT);
  mt = xcd * 16 + g * 8 + (rem & 7); nt = rem >> 3;
}

DI void epi_in_e(const Params& p, f32x16& a00, f32x16& a01, f32x16& a10, f32x16& a11, int mrow0, int cb, int r32, int hi) {
  int type; const float* g = nullptr;
  if (cb < 512) { type = 1; g = p.gq_a; } else if (cb < 1024) { type = 1; g = p.gk_a; } else if (cb < 1536) type = 0;
  else if (cb < 2048) { type = 2; g = p.gq_b; } else if (cb < 2176) { type = 2; g = p.gk_b; } else if (cb < 2304) type = 0; else type = 3;
#pragma unroll
  for (int mi = 0; mi < 2; ++mi) {
    f32x16& r0 = mi ? a10 : a00; f32x16& r1 = mi ? a11 : a01;
    const int T = mrow0 + mi * 32 + r32; const float rs = p.rs0[T];
    f32x16 v0 = r0 * rs, v1 = r1 * rs;
    if (type == 1 || type == 2) {
      const float ss = half_sum(sumsq16(v0) + sumsq16(v1)); const float ri = rsqrtf(ss * (1.f / 64) + EPS);
      { f32x16 gg; load_blk_f32(g, hi, gg); v0 = v0 * ri * gg; load_blk_f32(g + 32, hi, gg); v1 = v1 * ri * gg; }
      if (type == 2) { const int t = T & 4095; rot16(v0, p.tab_ax + (t >> 6) * 16, hi); rot16(v1, p.tab_ax + (t & 63) * 16, hi); }
      if (cb >= 1536 && cb < 2048) { v0 = v0 * (0.125f * LOG2E); v1 = v1 * (0.125f * LOG2E); }
    } else if (type == 3) {
#pragma unroll
      for (int r = 0; r < 16; ++r) { v0[r] = silu(v0[r]); v1[r] = silu(v1[r]); }
    }
    r0 = v0; r1 = v1;
  }
}
DI void epi_in_o(const Params& p, f32x16& a00, f32x16& a01, f32x16& a10, f32x16& a11, int mrow0, int cb, int r32, int hi) {
  int type; const float* g = nullptr;
  if (cb < 256) type = 4; else if (cb < 384) type = 5; else if (cb < 896) { type = 2; g = p.gq_d; } else if (cb < 1408) { type = 2; g = p.gk_d; }
  else if (cb < 1920) type = 0; else if (cb < 2944) type = 3; else type = 0;
#pragma unroll
  for (int mi = 0; mi < 2; ++mi) {
    f32x16& r0 = mi ? a10 : a00; f32x16& r1 = mi ? a11 : a01;
    const int T = mrow0 + mi * 32 + r32; const float rs = rsqrtf(p.ss1[T] * (1.f / DM) + EPS);
    f32x16 v0 = r0 * rs, v1 = r1 * rs;
    if (type == 2) {
      const float ss = half_sum(sumsq16(v0) + sumsq16(v1)); const float ri = rsqrtf(ss * (1.f / 64) + EPS);
      { f32x16 gg; load_blk_f32(g, hi, gg); v0 = v0 * ri * gg; load_blk_f32(g + 32, hi, gg); v1 = v1 * ri * gg; }
      rot8(v0, p.tab_part + (T & 4095) * 8, hi);
      if (cb < 896) { v0 = v0 * (0.125f * LOG2E); v1 = v1 * (0.125f * LOG2E); }
    } else if (type == 3) {
#pragma unroll
      for (int r = 0; r < 16; ++r) { v0[r] = silu(v0[r]); v1[r] = silu(v1[r]); }
    } else if (type >= 4) {
      const float ss = half_sum(sumsq16(v0) + sumsq16(v1));
      if (hi == 0) atomicAdd((type == 4 ? p.sscq : p.ssckv) + T, ss);
    }
    r0 = v0; r1 = v1;
  }
}
DI void stage_out_bf16(f32x16 (&acc)[2][4], u16* dst, int ld, char* lds) {
  const int tid = my_tid(), wave = tid >> 6, lane = tid & 63, r32 = lane & 31, hi = lane >> 5, wr = wave >> 1, wc = wave & 1;
#pragma unroll
  for (int half = 0; half < 2; ++half) {
    if ((wr >> 1) == half) {
#pragma unroll
      for (int mi = 0; mi < 2; ++mi) {
        u16* rowp = (u16*)(lds + ((wr & 1) * 64 + mi * 32 + r32) * 520) + wc * 128;
#pragma unroll
        for (int ni = 0; ni < 4; ++ni) store_blk_bf16(rowp + 32 * ni, acc[mi][ni], hi);
      }
    }
    __syncthreads();
#pragma unroll
    for (int i = 0; i < 8; ++i) {
      const int c = tid + i * NTHR, row = c >> 5, ch = c & 31;
      const u32x2 a = *(const u32x2*)(lds + row * 520 + ch * 16), b = *(const u32x2*)(lds + row * 520 + ch * 16 + 8);
      u32x4 w; w.x = a.x; w.y = a.y; w.z = b.x; w.w = b.y;
      *(u32x4*)(dst + (size_t)(half * 128 + row) * ld + ch * 8) = w;
    }
    __syncthreads();
  }
}
template <bool FIRST>
DI void epi_out(const Params& p, f32x16 (&acc)[2][4], int m0, int n0, char* lds) {
  const float* res = FIRST ? p.x : p.out;
  const int tid = my_tid(), wave = tid >> 6, lane = tid & 63, r32 = lane & 31, hi = lane >> 5, wr = wave >> 1, wc = wave & 1;
#pragma unroll
  for (int mi = 0; mi < 2; ++mi)
#pragma unroll
    for (int half = 0; half < 2; ++half) {
      if ((wr >> 1) == half) {
        float* rowp = (float*)(lds + ((wr & 1) * 32 + r32) * 1040) + wc * 128;
#pragma unroll
        for (int ni = 0; ni < 4; ++ni)
#pragma unroll
          for (int q = 0; q < 4; ++q) { f32x4 v; v[0] = acc[mi][ni][4 * q]; v[1] = acc[mi][ni][4 * q + 1]; v[2] = acc[mi][ni][4 * q + 2]; v[3] = acc[mi][ni][4 * q + 3]; *(f32x4*)(rowp + 32 * ni + 8 * q + 4 * hi) = v; }
      }
      __syncthreads();
#pragma unroll
      for (int i = 0; i < 8; ++i) {
        const int c = tid + i * NTHR, row = c >> 6, ch = c & 63;
        const int T = m0 + half * 128 + (row >> 5) * 64 + mi * 32 + (row & 31);
        const size_t off = (size_t)T * DM + n0 + ch * 4;
        const f32x4 a = *(const f32x4*)(lds + row * 1040 + ch * 16), rv = *(const f32x4*)(res + off);
        f32x4 ov = a + rv;
        *(f32x4*)(p.out + off) = ov;
        if (FIRST) {
          float ss = ov[0] * ov[0] + ov[1] * ov[1] + ov[2] * ov[2] + ov[3] * ov[3];
          u32x2 w; w.x = cvtpk(ov[0], ov[1]); w.y = cvtpk(ov[2], ov[3]); *(u32x2*)(p.xb + (size_t)T * LDX + n0 + ch * 4) = w;
          ss = wave_sum(ss);
          if (ch == 0) atomicAdd(p.ss1 + T, ss);
        }
      }
      __syncthreads();
    }
}
template <int WHICH>
DI void gemm_phase(const Params& p, char* lds) {
  constexpr int NT = WHICH == 0 ? NE / 256 : WHICH == 2 ? NO / 256 : 4;
  const u16* A = (WHICH == 0 || WHICH == 2) ? p.xb : p.ob;
  const u16* Bt = WHICH == 0 ? p.wt_ine : WHICH == 1 ? p.wt_oute : WHICH == 2 ? p.wt_ino : p.wt_outo;
  const int wave = my_tid() >> 6, lane = my_tid() & 63, r32 = lane & 31, hi = lane >> 5, wr = wave >> 1, wc = wave & 1;
  for (int t = blockIdx.x; t < 128 * NT; t += gridDim.x) {
    int mt, nt; tile_of(t, NT, mt, nt);
    f32x16 acc[2][4];
    gemm_mainloop<4, 2, 2, 4>(A + (size_t)mt * 256 * LDX, LDX, Bt + (size_t)nt * 256 * LDX, LDX, DM, lds, acc);
    const int mrow0 = mt * 256 + wr * 64, cb = nt * 256 + wc * 128;
    if (WHICH == 0) {
      epi_in_e(p, acc[0][0], acc[0][1], acc[1][0], acc[1][1], mrow0, cb, r32, hi);
      epi_in_e(p, acc[0][2], acc[0][3], acc[1][2], acc[1][3], mrow0, cb + 64, r32, hi);
      stage_out_bf16(acc, p.proj + (size_t)mt * 256 * NE + nt * 256, NE, lds);
    } else if (WHICH == 2) {
      epi_in_o(p, acc[0][0], acc[0][1], acc[1][0], acc[1][1], mrow0, cb, r32, hi);
      epi_in_o(p, acc[0][2], acc[0][3], acc[1][2], acc[1][3], mrow0, cb + 64, r32, hi);
      stage_out_bf16(acc, p.proj + (size_t)mt * 256 * NO + nt * 256, NO, lds);
    } else if (WHICH == 1) epi_out<true>(p, acc, mt * 256, nt * 256, lds);
    else epi_out<false>(p, acc, mt * 256, nt * 256, lds);
  }
}
template <int NCH, int STR>
DI void copy_rows_bf16(const char* lds, u16* dst, int ld) {
  const int tid = my_tid();
#pragma unroll
  for (int i = 0; i < (256 * NCH) / NTHR; ++i) {
    const int c = tid + i * NTHR, row = c / NCH, ch = c % NCH;
    const u32x2 a = *(const u32x2*)(lds + row * STR + ch * 16), b = *(const u32x2*)(lds + row * STR + ch * 16 + 8);
    u32x4 w; w.x = a.x; w.y = a.y; w.z = b.x; w.w = b.y;
    *(u32x4*)(dst + (size_t)row * ld + ch * 8) = w;
  }
}
DI void upproj_phase(const Params& p, char* lds) {
  const int wave = my_tid() >> 6, lane = my_tid() & 63, r32 = lane & 31, hi = lane >> 5;
  for (int t = blockIdx.x; t < 128 * 8; t += gridDim.x) {
    int mt, hh; tile_of(t, 8, mt, hh);
    f32x16 acc[1][3];
    gemm_mainloop<8, 1, 1, 3>(p.proj + (size_t)mt * 256 * NO, NO, p.wt_cq + (size_t)hh * 96 * 256, 256, 256, lds, acc);
    const int T = mt * 256 + wave * 32 + r32;
    const float rcq = rsqrtf(p.sscq[T] * (1.f / 256) + EPS);
    f32x16 v0 = acc[0][0] * rcq, v1 = acc[0][1] * rcq, v2 = acc[0][2] * rcq;
    const float ss = half_sum(sumsq16(v0) + sumsq16(v1) + sumsq16(v2)); const float ri = rsqrtf(ss * (1.f / 96) + EPS);
    f32x16 g; load_blk_f32(p.gq_c, hi, g); v0 = v0 * ri * g; load_blk_f32(p.gq_c + 32, hi, g); v1 = v1 * ri * g; load_blk_f32(p.gq_c + 64, hi, g); v2 = v2 * ri * g;
    rot16(v2, p.tab_mla + (T & 4095) * 16, hi);
    { const float cs = 0.10206207261596575f * LOG2E; v0 = v0 * cs; v1 = v1 * cs; v2 = v2 * cs; }
    u16* rowp = (u16*)(lds + (wave * 32 + r32) * 200);
    store_blk_bf16(rowp, v0, hi); store_blk_bf16(rowp + 32, v1, hi); store_blk_bf16(rowp + 64, v2, hi);
    __syncthreads();
    copy_rows_bf16<12, 200>(lds, p.qc + (size_t)mt * 256 * 768 + hh * 96, 768);
    __syncthreads();
  }
  for (int t = blockIdx.x; t < 128 * 8; t += gridDim.x) {
    int mt, hh; tile_of(t, 8, mt, hh);
    f32x16 acc[1][4];
    gemm_mainloop<8, 1, 1, 4>(p.proj + (size_t)mt * 256 * NO + 256, NO, p.wt_ckv + (size_t)hh * 128 * 128, 128, 128, lds, acc);
    const int T = mt * 256 + wave * 32 + r32;
    const float rkv = rsqrtf(p.ssckv[T] * (1.f / 128) + EPS);
    f32x16 v0 = acc[0][0] * rkv, v1 = acc[0][1] * rkv, v2 = acc[0][2] * rkv, v3 = acc[0][3] * rkv, kp;
    load_blk_bf16(p.proj + (size_t)T * NO + 2944, hi, kp);
    const float ss = half_sum(sumsq16(v0) + sumsq16(v1) + sumsq16(kp)); const float ri = rsqrtf(ss * (1.f / 96) + EPS);
    f32x16 g; load_blk_f32(p.gk_c, hi, g); v0 = v0 * ri * g; load_blk_f32(p.gk_c + 32, hi, g); v1 = v1 * ri * g; load_blk_f32(p.gk_c + 64, hi, g); kp = kp * ri * g;
    rot16(kp, p.tab_mla + (T & 4095) * 16, hi);
    u16* rowp = (u16*)(lds + (wave * 32 + r32) * 200);
    store_blk_bf16(rowp, v0, hi); store_blk_bf16(rowp + 32, v1, hi); store_blk_bf16(rowp + 64, kp, hi);
    u16* vrow = (u16*)(lds + 51200 + (wave * 32 + r32) * 136);
    store_blk_bf16(vrow, v2, hi); store_blk_bf16(vrow + 32, v3, hi);
    __syncthreads();
    copy_rows_bf16<12, 200>(lds, p.kc + (size_t)mt * 256 * 768 + hh * 96, 768);
    copy_rows_bf16<8, 136>(lds + 51200, p.vc + (size_t)mt * 256 * 512 + hh * 64, 512);
    __syncthreads();
  }
}

namespace pg8 {
#define PG8_LAS __attribute__((address_space(3)))
typedef unsigned short bf16_t;
typedef short bf16x8 __attribute__((ext_vector_type(8)));
typedef float f32x4 __attribute__((ext_vector_type(4)));
typedef unsigned u32x4 __attribute__((ext_vector_type(4)));
constexpr int BM = 256, BK = 64, HALF = 128, HTB = HALF * BK * 2  , STAGE_BYTES = 8 * HTB, NXCD = 8, WGM = 8;

__host__ __device__ __forceinline__ int lds_byte(int r, int c) { const int st = (r >> 4) * 2 + (c >> 5), rr = r & 15, cc = c & 31, ob = rr * 64 + cc * 2; return st * 1024 + (ob ^ (((ob >> 9) & 1) << 5)); }
__host__ __device__ __forceinline__ void stage_rc(int b, int& R, int& C) { const int st = b / 1024, sb = b % 1024, swz = sb ^ (((sb >> 9) & 1) << 5); R = (st >> 1) * 16 + swz / 64; C = (st & 1) * 32 + (swz % 64) / 2; }
__host__ __device__ __forceinline__ int perm32(int rho) { const int n = rho >> 4, i = rho & 15; return 8 * (i >> 2) + 4 * n + (i & 3); }

struct Unit { int pm, pn; };
struct Gemm { const bf16_t* A; const bf16_t* Bt; int M, N, K; };

struct StaticOrder {
    int nM, nN, nwg, G, c;
    __host__ __device__ void init(int M, int N, int G_, int c_) { nM = M / BM; nN = N / BM; nwg = nM * nN; G = G_; c = c_; }
    __host__ __device__ bool next(int i, Unit& u) const {
        const long L = (long)i * G + c; if (L >= nwg) return false;
        int wgid = (int)L; { const int q = nwg / NXCD, r = nwg % NXCD, xcd = wgid % NXCD, off = wgid / NXCD; wgid = (xcd < r ? xcd * (q + 1) : r * (q + 1) + (xcd - r) * q) + off; }
        const int nig = WGM * nN, gid = wgid / nig, fm = gid * WGM, gsz = (nM - fm) < WGM ? (nM - fm) : WGM;
        u.pm = fm + ((wgid % nig) % gsz); u.pn = (wgid % nig) / gsz; return true;
    }
    __device__ __forceinline__ void a_ready(const Unit&) const {}
    __device__ __forceinline__ void done(const Unit&) const {}
};
__device__ __forceinline__ unsigned cvt_pk_bf16(float lo, float hi) { unsigned r; asm volatile("v_cvt_pk_bf16_f32 %0, %1, %2" : "=v"(r) : "v"(lo), "v"(hi)); return r; }
template <class Epi, class Sched, bool STAMP = false>
__device__ __forceinline__ void gemm_phase(PG8_LAS unsigned char* lds, const Gemm g, const Sched& S, const Epi& E, unsigned long long* stamps) {
    const int tid = my_tid(), wid = __builtin_amdgcn_readfirstlane(tid >> 6), lane = tid & 63, wr = wid >> 2, wc = wid & 3, fr = lane & 15, fq = lane >> 4;
    const int K = g.K, nt = K / BK;
    int ts_lo = 0, ts_hi = 0, nts = 0; const unsigned long long rt_entry = STAMP ? (unsigned long long)wall_clock64() : 0ull;
#define PG8_STAMP() do { if (STAMP && wid == 0 && nts < 64) { const unsigned long long _c = (unsigned long long)clock64(); \
        ts_lo = (lane == nts) ? (int)(unsigned)_c : ts_lo; ts_hi = (lane == nts) ? (int)(unsigned)(_c >> 32) : ts_hi; ++nts; } } while (0)
    PG8_STAMP();
    unsigned voffA[2], voffB[2];
#pragma unroll
    for (int i = 0; i < 2; ++i) { int R, C; stage_rc(tid * 16 + i * 8192, R, C); const int Rb = Epi::PERM ? ((R & ~31) + perm32(R & 31)) : R;
        voffA[i] = (unsigned)(R * K + C) * 2u; voffB[i] = (unsigned)(Rb * K + C) * 2u; }
    const size_t kstep = (size_t)(BK * 2);
    const size_t hstep = (size_t)HALF * K * 2;
    const size_t tstep = 2 * hstep;
    const unsigned ldsw = (unsigned)wid * 1024u;
    const int aoff = lds_byte(wr * 64 + fr, fq * 8), boff = lds_byte(wc * 32 + fr, fq * 8);
#define PG8_SA(b, h) (((b) * 2 + (h)) * HTB)
#define PG8_SB(b, h) ((4 + (b) * 2 + (h)) * HTB)
#define PG8_STAGE(bufoff, gbase, voff) do { _Pragma("unroll") for (int _i = 0; _i < 2; ++_i) \
        __builtin_amdgcn_global_load_lds((const unsigned*)((const char*)(gbase) + (voff)[_i]), (PG8_LAS unsigned*)(lds + (bufoff) + ldsw + _i * 8192), 16, 0, 0); } while (0)
#define PG8_LDA(dst, b, h) do { _Pragma("unroll") for (int m = 0; m < 4; ++m) _Pragma("unroll") for (int k = 0; k < 2; ++k) dst[m][k] = *(const PG8_LAS bf16x8*)(lds + PG8_SA(b, h) + aoff + m * 2048 + k * 1024); } while (0)
#define PG8_LDB(dst, b, h) do { _Pragma("unroll") for (int n = 0; n < 2; ++n) _Pragma("unroll") for (int k = 0; k < 2; ++k) dst[n][k] = *(const PG8_LAS bf16x8*)(lds + PG8_SB(b, h) + boff + n * 2048 + k * 1024); } while (0)
#define PG8_MMA(ai, bj, At, Bt) do { __builtin_amdgcn_s_setprio(1); _Pragma("unroll") for (int m = 0; m < 4; ++m) _Pragma("unroll") for (int n = 0; n < 2; ++n) _Pragma("unroll") for (int k = 0; k < 2; ++k) \
        acc[ai][bj][m][n] = __builtin_amdgcn_mfma_f32_16x16x32_bf16(Bt[n][k], At[m][k], acc[ai][bj][m][n], 0, 0, 0); __builtin_amdgcn_s_setprio(0); } while (0)
#define PG8_WAIT_V(n) asm volatile("s_waitcnt vmcnt(" #n ")" ::: "memory")
#define PG8_WAIT_L(n) asm volatile("s_waitcnt lgkmcnt(" #n ")" ::: "memory")
#define PG8_BAR __builtin_amdgcn_s_barrier()
#define PG8_SCHED __builtin_amdgcn_sched_barrier(0)
    Unit cur, nxt; int ui = 0;
    if (!S.next(0, cur)) return;
    f32x4 acc[2][2][4][2];
#pragma unroll
    for (int a = 0; a < 2; ++a)
#pragma unroll
        for (int b = 0; b < 2; ++b)
#pragma unroll
            for (int m = 0; m < 4; ++m)
#pragma unroll
                for (int n = 0; n < 2; ++n) acc[a][b][m][n] = (f32x4){0.f, 0.f, 0.f, 0.f};
    bf16x8 At[4][2], B0[2][2], B1[2][2];
    const char* cA = (const char*)g.A + (size_t)cur.pm * tstep; const char* cB = (const char*)g.Bt + (size_t)cur.pn * tstep;
    S.a_ready(cur);
    PG8_STAGE(PG8_SB(0, 0), cB, voffB); PG8_STAGE(PG8_SA(0, 0), cA, voffA); PG8_STAGE(PG8_SB(0, 1), cB + hstep, voffB); PG8_STAGE(PG8_SA(0, 1), cA + hstep, voffA);
    if (wr == 1) PG8_BAR;
    PG8_WAIT_V(4); PG8_BAR;
    PG8_STAGE(PG8_SB(1, 0), cB + kstep, voffB); PG8_STAGE(PG8_SA(1, 0), cA + kstep, voffA); PG8_STAGE(PG8_SB(1, 1), cB + hstep + kstep, voffB);
    PG8_WAIT_V(6); PG8_BAR;
    PG8_STAMP();
    for (;;) {
        const bool has_next = S.next(ui + 1, nxt);
        const char* nA = has_next ? (const char*)g.A + (size_t)nxt.pm * tstep : cA; const char* nB = has_next ? (const char*)g.Bt + (size_t)nxt.pn * tstep : cB;
        for (int t = 0; t < nt; t += 2) {
            const bool last = (t == nt - 2);
            const char* a1 = cA + (size_t)(t + 1) * kstep;
            const char* a2 = last ? nA : cA + (size_t)(t + 2) * kstep; const char* b2 = last ? nB : cB + (size_t)(t + 2) * kstep;
            const char* a3 = a2 + kstep; const char* b3 = b2 + kstep;
            if (last && has_next) S.a_ready(nxt);
            PG8_LDB(B0, 0, 0); PG8_SCHED; PG8_LDA(At, 0, 0); PG8_STAGE(PG8_SA(1, 1), a1 + hstep, voffA);
            PG8_WAIT_L(8); PG8_BAR; PG8_WAIT_L(0); PG8_MMA(0, 0, At, B0); PG8_BAR; PG8_SCHED;
            PG8_LDB(B1, 0, 1); PG8_STAGE(PG8_SB(0, 0), b2, voffB);
            PG8_BAR; PG8_WAIT_L(0); PG8_MMA(0, 1, At, B1); PG8_BAR;
            PG8_LDA(At, 0, 1); PG8_STAGE(PG8_SA(0, 0), a2, voffA);
            PG8_BAR; PG8_WAIT_L(0); PG8_MMA(1, 0, At, B0); PG8_BAR; PG8_SCHED;
            PG8_STAGE(PG8_SB(0, 1), b2 + hstep, voffB);
            PG8_WAIT_V(6); PG8_BAR; PG8_MMA(1, 1, At, B1); PG8_BAR;
            PG8_LDB(B0, 1, 0); PG8_SCHED; PG8_LDA(At, 1, 0); PG8_STAGE(PG8_SA(0, 1), a2 + hstep, voffA);
            PG8_WAIT_L(8); PG8_BAR; PG8_WAIT_L(0); PG8_MMA(0, 0, At, B0); PG8_BAR; PG8_SCHED;
            PG8_LDB(B1, 1, 1); PG8_STAGE(PG8_SB(1, 0), b3, voffB);
            PG8_BAR; PG8_WAIT_L(0); PG8_MMA(0, 1, At, B1); PG8_BAR;
            PG8_LDA(At, 1, 1); PG8_STAGE(PG8_SA(1, 0), a3, voffA);
            PG8_BAR; PG8_WAIT_L(0); PG8_MMA(1, 0, At, B0); PG8_BAR; PG8_SCHED;
            PG8_STAGE(PG8_SB(1, 1), b3 + hstep, voffB);
            PG8_WAIT_V(6); PG8_BAR; PG8_MMA(1, 1, At, B1); PG8_BAR;
        }
        PG8_STAMP();
        if constexpr (!Epi::AFTER_DRAIN) { E(acc, cur, wr, wc, fr, fq); S.done(cur); }
        PG8_STAMP();
        if (!has_next) break;
#pragma unroll
        for (int a = 0; a < 2; ++a)
#pragma unroll
            for (int b = 0; b < 2; ++b)
#pragma unroll
                for (int m = 0; m < 4; ++m)
#pragma unroll
                    for (int n = 0; n < 2; ++n) acc[a][b][m][n] = (f32x4){0.f, 0.f, 0.f, 0.f};
        cur = nxt; cA = nA; cB = nB; ++ui;
    }
    PG8_WAIT_V(0);
    if (wr == 0) PG8_BAR;
    PG8_BAR;
    if constexpr (Epi::AFTER_DRAIN) { E.fused(acc, cur, wr, wc, fr, fq, lds, wid, lane); S.done(cur); }
    PG8_STAMP();
    if (STAMP && wid == 0) { stamps[lane] = lane < nts ? (((unsigned long long)(unsigned)ts_hi << 32) | (unsigned)ts_lo) : 0ull;
        if (lane == 62) stamps[62] = rt_entry; if (lane == 63) stamps[63] = (unsigned long long)wall_clock64(); }
#undef PG8_STAMP
#undef PG8_SA
#undef PG8_SB
#undef PG8_STAGE
#undef PG8_LDA
#undef PG8_LDB
#undef PG8_MMA
#undef PG8_WAIT_V
#undef PG8_WAIT_L
#undef PG8_BAR
#undef PG8_SCHED
}

__device__ __forceinline__ float silu_f(float v) { return v * __builtin_amdgcn_rcpf(1.f + __builtin_amdgcn_exp2f(v * -1.4426950408889634f)); }
__device__ __forceinline__ void xch_barrier() { asm volatile("s_waitcnt lgkmcnt(0)" ::: "memory"); __builtin_amdgcn_s_barrier(); asm volatile("" ::: "memory"); }
template <int XORL>
__device__ __forceinline__ void rot_lane8(float (&x)[8], const float2* tb, bool apply, bool first) {
    const f32x4 t0 = *(const f32x4*)(tb), t1 = *(const f32x4*)(tb + 2), t2 = *(const f32x4*)(tb + 4), t3 = *(const f32x4*)(tb + 6);
    const float c[8] = {t0[0], t0[2], t1[0], t1[2], t2[0], t2[2], t3[0], t3[2]}, s[8] = {t0[1], t0[3], t1[1], t1[3], t2[1], t2[3], t3[1], t3[3]};
#pragma unroll
    for (int k = 0; k < 8; ++k) { const float xp = __shfl_xor(x[k], XORL); const float r = first ? x[k] * c[k] - xp * s[k] : x[k] * c[k] + xp * s[k]; x[k] = apply ? r : x[k]; }
}
template <bool L1>
struct EpiIn {
    static constexpr bool PERM = true, AFTER_DRAIN = false;
    const Params& p; PG8_LAS float* xch;
    __device__ __forceinline__ void operator()(const f32x4 (&acc)[2][2][4][2], const Unit& u, int wr, int wc, int fr, int fq) const {
        constexpr int LDP = L1 ? NO : NE;
        asm volatile("" : "+v"(fr), "+v"(fq));
        int type[2]; const float* gp[2]; int hbs[2];
#pragma unroll
        for (int bj = 0; bj < 2; ++bj) {
            const int hb = (u.pn * 256 + bj * 128 + wc * 32) & ~63; hbs[bj] = hb; gp[bj] = p.gq_a; int t;
            if (!L1) { if (hb < 512) { t = 1; gp[bj] = p.gq_a; } else if (hb < 1024) { t = 1; gp[bj] = p.gk_a; } else if (hb < 1536) t = 0; else if (hb < 2048) { t = 2; gp[bj] = p.gq_b; }
                       else if (hb < 2176) { t = 2; gp[bj] = p.gk_b; } else if (hb < 2304) t = 0; else t = 3; }
            else     { if (hb < 256) t = 4; else if (hb < 384) t = 5; else if (hb < 896) { t = 2; gp[bj] = p.gq_d; } else if (hb < 1408) { t = 2; gp[bj] = p.gk_d; } else if (hb < 1920) t = 0; else if (hb < 2944) t = 3; else t = 0; }
            type[bj] = t;
        }
        const int w32 = (wc & 1) * 32, ch = w32 + 8 * fq;
        float rsv[2][4];
#pragma unroll
        for (int ai = 0; ai < 2; ++ai)
#pragma unroll
            for (int m = 0; m < 4; ++m) { const int T = u.pm * BM + ai * HALF + wr * 64 + m * 16 + fr; rsv[ai][m] = L1 ? p.ss1[T] : p.rs0[T]; }
        f32x4 gv[2][2];
#pragma unroll
        for (int bj = 0; bj < 2; ++bj) { gv[bj][0] = *(const f32x4*)(gp[bj] + ch); gv[bj][1] = *(const f32x4*)(gp[bj] + ch + 4); }
        if (L1) {
#pragma unroll
            for (int ai = 0; ai < 2; ++ai)
#pragma unroll
                for (int m = 0; m < 4; ++m) rsv[ai][m] = rsqrtf(rsv[ai][m] * (1.f / DM) + EPS);
        }
#pragma unroll
        for (int ai = 0; ai < 2; ++ai)
#pragma unroll
            for (int m = 0; m < 4; ++m) {
                const int rl = ai * HALF + wr * 64 + m * 16 + fr, T = u.pm * BM + rl;
                const float rs = rsv[ai][m];
#pragma unroll
                for (int bj = 0; bj < 2; ++bj) {
                    float s = 0.f;
                    if (type[bj] == 1 || type[bj] == 2 || type[bj] >= 4) {
#pragma unroll
                        for (int n = 0; n < 2; ++n)
#pragma unroll
                            for (int e = 0; e < 4; ++e) { const float x = acc[ai][bj][m][n][e] * rs; s = fmaf(x, x, s); }
                        s += __shfl_xor(s, 16); s += __shfl_xor(s, 32);
                        if (type[bj] >= 4) { if (fq == 0) atomicAdd((type[bj] == 4 ? p.sscq : p.ssckv) + T, s); }
                        else if (fq == 0) xch[rl * 8 + bj * 4 + wc] = s;
                    }
                }
            }
        xch_barrier();
#pragma unroll
        for (int ai = 0; ai < 2; ++ai)
#pragma unroll
            for (int m = 0; m < 4; ++m) {
                const int rl = ai * HALF + wr * 64 + m * 16 + fr, T = u.pm * BM + rl, t = T & 4095;
                const float rs = rsv[ai][m];
#pragma unroll
                for (int bj = 0; bj < 2; ++bj) {
                    float x[8];
#pragma unroll
                    for (int n = 0; n < 2; ++n)
#pragma unroll
                        for (int e = 0; e < 4; ++e) x[4 * n + e] = acc[ai][bj][m][n][e] * rs;
                    if (type[bj] == 1 || type[bj] == 2) {
                        const float tot = xch[rl * 8 + bj * 4 + wc] + xch[rl * 8 + bj * 4 + (wc ^ 1)];
                        const float ri = rsqrtf(tot * (1.f / 64) + EPS);
                        const f32x4 g0 = gv[bj][0], g1 = gv[bj][1];
#pragma unroll
                        for (int e = 0; e < 4; ++e) { x[e] *= ri * g0[e]; x[4 + e] *= ri * g1[e]; }
                        if (type[bj] == 2) {
                            if (!L1) { const int pos = w32 ? (t & 63) : (t >> 6); rot_lane8<32>(x, p.tab_ax + pos * 16 + 8 * (fq & 1), true, fq < 2); }
                            else     { rot_lane8<16>(x, p.tab_part + t * 8, w32 == 0 && fq < 2, fq == 0); }
                            const bool isq = L1 ? (hbs[bj] < 896) : (hbs[bj] < 2048);
                            if (isq) {
#pragma unroll
                                for (int k = 0; k < 8; ++k) x[k] *= 0.125f * LOG2E;
                            }
                        }
                    } else if (type[bj] == 3) {
#pragma unroll
                        for (int k = 0; k < 8; ++k) x[k] = silu_f(x[k]);
                    }
                    u32x4 w; w.x = cvt_pk_bf16(x[0], x[1]); w.y = cvt_pk_bf16(x[2], x[3]); w.z = cvt_pk_bf16(x[4], x[5]); w.w = cvt_pk_bf16(x[6], x[7]);
                    *(u32x4*)(p.proj + (size_t)T * LDP + u.pn * BM + bj * HALF + wc * 32 + 8 * fq) = w;
                    asm volatile("" ::: "memory");
                }
            }
    }
};
template <bool FIRST>
struct EpiRes {
    static constexpr bool PERM = false, AFTER_DRAIN = false;
    const Params& p; PG8_LAS float* xch;
    __device__ __forceinline__ void operator()(const f32x4 (&acc)[2][2][4][2], const Unit& u, int wr, int wc, int fr, int fq) const {
        const float* res = FIRST ? p.x : p.out;
        asm volatile("" : "+v"(fr), "+v"(fq));
#pragma unroll
        for (int ai = 0; ai < 2; ++ai)
#pragma unroll
            for (int m = 0; m < 4; ++m) {
                const int T = u.pm * BM + ai * HALF + wr * 64 + m * 16 + fr; float ss = 0.f;
#pragma unroll
                for (int bj = 0; bj < 2; ++bj)
#pragma unroll
                    for (int n = 0; n < 2; ++n) {
                        const size_t off = (size_t)T * DM + u.pn * BM + bj * HALF + wc * 32 + n * 16 + 4 * fq;
                        const f32x4 ov = *(const f32x4*)(res + off) + acc[ai][bj][m][n];
                        *(f32x4*)(p.out + off) = ov;
                        if (FIRST) { ss += ov[0] * ov[0] + ov[1] * ov[1] + ov[2] * ov[2] + ov[3] * ov[3];
                            u32x2 w; w.x = cvt_pk_bf16(ov[0], ov[1]); w.y = cvt_pk_bf16(ov[2], ov[3]); *(u32x2*)(p.xb + off) = w; }
                    }
                if (FIRST) { ss += __shfl_xor(ss, 16); ss += __shfl_xor(ss, 32); if (fq == 0) atomicAdd(p.ss1 + T, ss); }
            }
        xch_barrier();
    }
};
}
template <int WHICH>
DI void gemm_phase8(const Params& p, char* lds) {
  constexpr int N = WHICH == 0 ? NE : WHICH == 2 ? NO : 1024;
  pg8::Gemm g; g.A = (WHICH == 0 || WHICH == 2) ? p.xb : p.ob; g.Bt = WHICH == 0 ? p.wt_ine : WHICH == 1 ? p.wt_oute : WHICH == 2 ? p.wt_ino : p.wt_outo; g.M = NTOK; g.N = N; g.K = DM;
  pg8::StaticOrder S; S.init(NTOK, N, (int)gridDim.x, (int)blockIdx.x);
  PG8_LAS unsigned char* l3 = (PG8_LAS unsigned char*)lds;
  PG8_LAS float* xch = (PG8_LAS float*)(l3 + 131072);
  if constexpr (WHICH == 0) { pg8::EpiIn<false> e{p, xch}; pg8::gemm_phase(l3, g, S, e, nullptr); }
  else if constexpr (WHICH == 2) { pg8::EpiIn<true> e{p, xch}; pg8::gemm_phase(l3, g, S, e, nullptr); }
  else if constexpr (WHICH == 1) { pg8::EpiRes<true> e{p, xch}; pg8::gemm_phase(l3, g, S, e, nullptr); }
  else { pg8::EpiRes<false> e{p, xch}; pg8::gemm_phase(l3, g, S, e, nullptr); }
}

template <int KS> DI int kswz(int row, int chunk) { return KS == 128 ? row * 128 + ((chunk ^ ((row >> 1) & 7)) << 4) : row * 256 + ((chunk ^ (row & 7)) << 4); }
template <int DV> DI int v_st(int k, int c) { constexpr int NCS = DV / 32; const int kk = k; return ((kk >> 3) * NCS + (c >> 5)) * 512 + ((kk & 7) * 32 + (c & 31)) * 2; }
DI int v_rd_base(int lane) { return ((lane & 3) << 3) | (((lane >> 2) & 3) << 6) | (((lane >> 4) & 1) << 5) | (((lane >> 5) & 1) << 8); }
template <int OFF> DI s16x4 tr_read(int vb) { s16x4 r; asm volatile("ds_read_b64_tr_b16 %0, %1 offset:%2" : "=&v"(r) : "v"(vb), "i"(OFF) : "memory"); return r; }

template <int DQK, int KS>
DI void qkt(f32x16& p0, f32x16& p1, const char* Ks, const bf16x8* qr, int r32, int hi) {
#pragma unroll
  for (int r = 0; r < 16; ++r) { p0[r] = 0.f; p1[r] = 0.f; }
#pragma unroll
  for (int d0 = 0; d0 < DQK / 16; ++d0) {
    const bf16x8 b0 = *(const bf16x8*)(Ks + kswz<KS>(r32, d0 * 2 + hi));
    const bf16x8 b1 = *(const bf16x8*)(Ks + kswz<KS>(32 + r32, d0 * 2 + hi));
    p0 = MFMA32(b0, qr[d0], p0); p1 = MFMA32(b1, qr[d0], p1);
  }
}
template <int DV, int D0>
DI void pv_one(f32x16& od, int vb, bf16x8 pa0, bf16x8 pa1, bf16x8 pa2, bf16x8 pa3) {
  constexpr int NCS = DV / 32;
#define VOFF(ks, half) (D0 * 512 + (2 * (ks) + (half)) * NCS * 512)
  const s16x4 l0 = tr_read<VOFF(0, 0)>(vb), h0 = tr_read<VOFF(0, 1)>(vb), l1 = tr_read<VOFF(1, 0)>(vb), h1 = tr_read<VOFF(1, 1)>(vb);
  const s16x4 l2 = tr_read<VOFF(2, 0)>(vb), h2 = tr_read<VOFF(2, 1)>(vb), l3 = tr_read<VOFF(3, 0)>(vb), h3 = tr_read<VOFF(3, 1)>(vb);
#undef VOFF
  asm volatile("s_waitcnt lgkmcnt(0)" ::: "memory"); SBAR();
#define PK(L, H) (bf16x8){L[0], L[1], L[2], L[3], H[0], H[1], H[2], H[3]}
  od = MFMA32(PK(l0, h0), pa0, od); od = MFMA32(PK(l1, h1), pa1, od); od = MFMA32(PK(l2, h2), pa2, od); od = MFMA32(PK(l3, h3), pa3, od);
#undef PK
}
template <int DV>
DI void pv_all(f32x16 (&o)[DV / 32], int vb, bf16x8 pa0, bf16x8 pa1, bf16x8 pa2, bf16x8 pa3) {
  pv_one<DV, 0>(o[0], vb, pa0, pa1, pa2, pa3); pv_one<DV, 1>(o[1], vb, pa0, pa1, pa2, pa3);
  if constexpr (DV == 128) { pv_one<DV, 2>(o[2], vb, pa0, pa1, pa2, pa3); pv_one<DV, 3>(o[3], vb, pa0, pa1, pa2, pa3); }
}
#define PK4(P, BASE, OUT) do { u32x4 w = {cvtpk(P[BASE + 0], P[BASE + 1]), cvtpk(P[BASE + 2], P[BASE + 3]), cvtpk(P[BASE + 4], P[BASE + 5]), cvtpk(P[BASE + 6], P[BASE + 7])}; \
    OUT = *reinterpret_cast<bf16x8*>(&w); } while (0)

template <int ND0>
DI void softmax_step(f32x16& t0, f32x16& t1, float& m, float& l, f32x16 (&o)[ND0], bf16x8& pa0, bf16x8& pa1, bf16x8& pa2, bf16x8& pa3) {
  float pmax = t0[0];
#pragma unroll
  for (int r = 1; r < 16; ++r) pmax = fmaxf(pmax, t0[r]);
#pragma unroll
  for (int r = 0; r < 16; ++r) pmax = fmaxf(pmax, t1[r]);
  pmax = half_max(pmax);
  const float mn = fmaxf(m, pmax);
  const float alpha = __builtin_amdgcn_exp2f(m - mn);
  m = mn;
#pragma unroll
  for (int r = 0; r < 16; ++r) { t0[r] = __builtin_amdgcn_exp2f(t0[r] - mn); t1[r] = __builtin_amdgcn_exp2f(t1[r] - mn); }
  float ps = 0.f;
#pragma unroll
  for (int r = 0; r < 16; ++r) ps += t0[r] + t1[r];
  ps = half_sum(ps);
  l = l * alpha + ps;
  if (__any(alpha < 1.f)) {
#pragma unroll
    for (int d = 0; d < ND0; ++d) o[d] = o[d] * alpha;
  }
  PK4(t0, 0, pa0); PK4(t0, 8, pa1); PK4(t1, 0, pa2); PK4(t1, 8, pa3);
}

template <int DQK, int DV>
DI void flash(const u16* __restrict__ Qlane, const u16* __restrict__ Kb, const int ldk, const u16* __restrict__ Vb, const int ldv,
              const float C, const float nMc, f32x16 (&o)[DV / 32], float& l_out, char* lds) {
  constexpr int KS = DQK == 64 ? 128 : 256, KCR = DQK / 8, NKC = (KCR + 7) / 8, VCR = DV / 8, NVC = VCR / 8, ND0 = DV / 32, NQ = DQK / 16;
  constexpr int KBYTES = 64 * KS, ABUF = KBYTES + 64 * DV * 2, NTILE = SEQ / 64;
  const int tid = my_tid(), lane = tid & 63, r32 = lane & 31, hi = lane >> 5;
  bf16x8 qr[NQ];
#pragma unroll
  for (int d0 = 0; d0 < NQ; ++d0) qr[d0] = *(const bf16x8*)(Qlane + d0 * 16);
  int kg[NKC], kl[NKC], vg[NVC], vl[NVC];
#pragma unroll
  for (int i = 0; i < NKC; ++i) { const int c = min(tid + i * NTHR, 64 * KCR - 1), row = c / KCR, cc = c % KCR; kg[i] = row * ldk + cc * 8; kl[i] = kswz<KS>(row, cc); }
#pragma unroll
  for (int i = 0; i < NVC; ++i) { const int c = tid + i * NTHR, key = c / VCR, c8 = c % VCR; vg[i] = key * ldv + c8 * 8; vl[i] = KBYTES + v_st<DV>(key, c8 * 8); }
  const int vb0 = (int)(uintptr_t)lds + KBYTES + v_rd_base(lane);
  float lsum = 0.f;
#pragma unroll
  for (int d = 0; d < ND0; ++d)
#pragma unroll
    for (int r = 0; r < 16; ++r) o[d][r] = 0.f;
  bf16x8 ks[NKC], vs[NVC];
#pragma unroll
  for (int i = 0; i < NKC; ++i) ks[i] = *(const bf16x8*)(Kb + kg[i]);
#pragma unroll
  for (int i = 0; i < NVC; ++i) vs[i] = *(const bf16x8*)(Vb + vg[i]);
#pragma unroll
  for (int i = 0; i < NKC; ++i) *(bf16x8*)(lds + kl[i]) = ks[i];
#pragma unroll
  for (int i = 0; i < NVC; ++i) *(bf16x8*)(lds + vl[i]) = vs[i];
  __syncthreads();
  for (int j = 0; j < NTILE; ++j) {
    const int cur = j & 1;
    if (j + 1 < NTILE) {
      const u16* kn = Kb + (size_t)(j + 1) * 64 * ldk; const u16* vn = Vb + (size_t)(j + 1) * 64 * ldv;
#pragma unroll
      for (int i = 0; i < NKC; ++i) ks[i] = *(const bf16x8*)(kn + kg[i]);
#pragma unroll
      for (int i = 0; i < NVC; ++i) vs[i] = *(const bf16x8*)(vn + vg[i]);
    }
    f32x16 p0, p1; bf16x8 pa0, pa1, pa2, pa3;
    qkt<DQK, KS>(p0, p1, lds + cur * ABUF, qr, r32, hi);
#pragma unroll
    for (int r = 0; r < 16; ++r) { p0[r] = __builtin_amdgcn_exp2f(p0[r]); p1[r] = __builtin_amdgcn_exp2f(p1[r]); }
    { const f32x16 s_ = p0 + p1; lsum += ((s_[0] + s_[1]) + (s_[2] + s_[3])) + ((s_[4] + s_[5]) + (s_[6] + s_[7])) + ((s_[8] + s_[9]) + (s_[10] + s_[11])) + ((s_[12] + s_[13]) + (s_[14] + s_[15])); }
    PK4(p0, 0, pa0); PK4(p0, 8, pa1); PK4(p1, 0, pa2); PK4(p1, 8, pa3);
    pv_all<DV>(o, vb0 + cur * ABUF, pa0, pa1, pa2, pa3);
    if (j + 1 < NTILE) {
      char* nb = lds + (cur ^ 1) * ABUF;
#pragma unroll
      for (int i = 0; i < NKC; ++i) *(bf16x8*)(nb + kl[i]) = ks[i];
#pragma unroll
      for (int i = 0; i < NVC; ++i) *(bf16x8*)(nb + vl[i]) = vs[i];
    }
    __syncthreads();
  }
  l_out = half_sum(lsum);
}

template <int DQK, int DV>
DI void flash_pipe_v1(const u16* __restrict__ Qlane, const u16* __restrict__ Kb, const int ldk, const u16* __restrict__ Vb, const int ldv,
                   const float C, const float nMc, f32x16 (&o)[DV / 32], float& l_out, char* lds) {
  constexpr int KS = DQK == 64 ? 128 : 256, KCR = DQK / 8, NKC = (KCR + 7) / 8, VCR = DV / 8, NVC = VCR / 8, ND0 = DV / 32, NQ = DQK / 16;
  constexpr int KBYTES = 64 * KS, VBYTES = 64 * DV * 2, VOFF0 = 2 * KBYTES, NTILE = SEQ / 64;
  const int tid = my_tid(), lane = tid & 63, r32 = lane & 31, hi = lane >> 5;
  bf16x8 qr[NQ];
#pragma unroll
  for (int d0 = 0; d0 < NQ; ++d0) qr[d0] = *(const bf16x8*)(Qlane + d0 * 16);
  int kg[NKC], kl[NKC], vg[NVC], vl[NVC];
#pragma unroll
  for (int i = 0; i < NKC; ++i) { const int c = min(tid + i * NTHR, 64 * KCR - 1), row = c / KCR, cc = c % KCR; kg[i] = row * ldk + cc * 8; kl[i] = kswz<KS>(row, cc); }
#pragma unroll
  for (int i = 0; i < NVC; ++i) { const int c = tid + i * NTHR, key = c / VCR, c8 = c % VCR; vg[i] = key * ldv + c8 * 8; vl[i] = VOFF0 + v_st<DV>(key, c8 * 8); }
  const int vb0 = (int)(uintptr_t)lds + VOFF0 + v_rd_base(lane);
  float l = 0.f;
#pragma unroll
  for (int d = 0; d < ND0; ++d)
#pragma unroll
    for (int r = 0; r < 16; ++r) o[d][r] = 0.f;
  bf16x8 ks[NKC], vs[NVC];
#define FP_LOADK(J) do { const u16* kn = Kb + (size_t)(J) * 64 * ldk; _Pragma("unroll") for (int i = 0; i < NKC; ++i) ks[i] = *(const bf16x8*)(kn + kg[i]); } while (0)
#define FP_LOADV(J) do { const u16* vn = Vb + (size_t)(J) * 64 * ldv; _Pragma("unroll") for (int i = 0; i < NVC; ++i) vs[i] = *(const bf16x8*)(vn + vg[i]); } while (0)
#define FP_WRITEK(B) do { _Pragma("unroll") for (int i = 0; i < NKC; ++i) *(bf16x8*)(lds + (B) * KBYTES + kl[i]) = ks[i]; } while (0)
#define FP_WRITEV(B) do { _Pragma("unroll") for (int i = 0; i < NVC; ++i) *(bf16x8*)(lds + (B) * VBYTES + vl[i]) = vs[i]; } while (0)
#define FP_PARTIAL(P0) do { _Pragma("unroll") for (int r = 0; r < 16; ++r) P0[r] = __builtin_amdgcn_exp2f(P0[r]); } while (0)
#define FP_FINISH(P0, P1) do { _Pragma("unroll") for (int r = 0; r < 16; ++r) P1[r] = __builtin_amdgcn_exp2f(P1[r]); \
    { const f32x16 s_ = P0 + P1; lsum += ((s_[0] + s_[1]) + (s_[2] + s_[3])) + ((s_[4] + s_[5]) + (s_[6] + s_[7])) + ((s_[8] + s_[9]) + (s_[10] + s_[11])) + ((s_[12] + s_[13]) + (s_[14] + s_[15])); } \
    PK4(P0, 0, pa0); PK4(P0, 8, pa1); PK4(P1, 0, pa2); PK4(P1, 8, pa3); } while (0)
#define FP_STEP(PX0, PX1, PY0, PY1, JJ) do { \
    SBAR(); \
    if ((JJ) + 1 < NTILE) qkt<DQK, KS>(PY0, PY1, lds + (((JJ) + 1) & 1) * KBYTES, qr, r32, hi); \
    FP_FINISH(PX0, PX1); \
    SBAR(); \
    if ((JJ) + 2 < NTILE) FP_LOADK((JJ) + 2); \
    if ((JJ) + 1 < NTILE) FP_LOADV((JJ) + 1); \
    SBAR(); \
    pv_all<DV>(o, vb0 + ((JJ) & 1) * VBYTES, pa0, pa1, pa2, pa3); \
    if ((JJ) + 1 < NTILE) FP_PARTIAL(PY0); \
    SBAR(); \
    if ((JJ) + 2 < NTILE) FP_WRITEK((JJ) & 1); \
    if ((JJ) + 1 < NTILE) FP_WRITEV(((JJ) + 1) & 1); \
    __syncthreads(); } while (0)
  f32x16 pA0, pA1, pB0, pB1; bf16x8 pa0, pa1, pa2, pa3;
  float lsum = 0.f;
  FP_LOADK(0); FP_LOADV(0); FP_WRITEK(0); FP_WRITEV(0); FP_LOADK(1); FP_WRITEK(1);
  __syncthreads();
  qkt<DQK, KS>(pA0, pA1, lds, qr, r32, hi);
  FP_PARTIAL(pA0);
  __syncthreads();
  for (int j = 0; j < NTILE; j += 2) {
    FP_STEP(pA0, pA1, pB0, pB1, j);
    FP_STEP(pB0, pB1, pA0, pA1, j + 1);
  }
#undef FP_LOADK
#undef FP_LOADV
#undef FP_WRITEK
#undef FP_WRITEV
#undef FP_PARTIAL
#undef FP_FINISH
#undef FP_STEP
  l_out = half_sum(lsum);
}

template <int DQK, int DV, bool DEEP>
DI void flash_pipe(const u16* __restrict__ Qlane, const u16* __restrict__ Kb, const int ldk, const u16* __restrict__ Vb, const int ldv,
                   f32x16 (&o)[DV / 32], float& l_out, char* lds) {
  constexpr int KS = DQK == 64 ? 128 : 256, KCR = DQK / 8, NKC = (KCR + 7) / 8, VCR = DV / 8, NVC = VCR / 8, ND0 = DV / 32, NQ = DQK / 16;
  constexpr int KBYTES = 64 * KS, VBYTES = 64 * DV * 2, VOFF0 = 2 * KBYTES, NTILE = SEQ / 64;
  const int tid = my_tid(), lane = tid & 63, r32 = lane & 31, hi = lane >> 5;
  bf16x8 qr[NQ];
#pragma unroll
  for (int d0 = 0; d0 < NQ; ++d0) qr[d0] = *(const bf16x8*)(Qlane + d0 * 16);
  int kg[NKC], kl[NKC], vg[NVC], vl[NVC];
#pragma unroll
  for (int i = 0; i < NKC; ++i) { const int c = min(tid + i * NTHR, 64 * KCR - 1), row = c / KCR, cc = c % KCR; kg[i] = row * ldk + cc * 8; kl[i] = kswz<KS>(row, cc); }
#pragma unroll
  for (int i = 0; i < NVC; ++i) { const int c = tid + i * NTHR, key = c / VCR, c8 = c % VCR; vg[i] = key * ldv + c8 * 8; vl[i] = VOFF0 + v_st<DV>(key, c8 * 8); }
  const int vb0 = (int)(uintptr_t)lds + VOFF0 + v_rd_base(lane);
#pragma unroll
  for (int d = 0; d < ND0; ++d)
#pragma unroll
    for (int r = 0; r < 16; ++r) o[d][r] = 0.f;
  bf16x8 ksA[NKC], vsA[NVC], ksB[NKC], vsB[NVC];
#define FP_LOADK(KSR, J) do { const u16* kn = Kb + (size_t)(J) * 64 * ldk; _Pragma("unroll") for (int i = 0; i < NKC; ++i) KSR[i] = *(const bf16x8*)(kn + kg[i]); } while (0)
#define FP_LOADV(VSR, J) do { const u16* vn = Vb + (size_t)(J) * 64 * ldv; _Pragma("unroll") for (int i = 0; i < NVC; ++i) VSR[i] = *(const bf16x8*)(vn + vg[i]); } while (0)
#define FP_WRITEK(KSR, B) do { _Pragma("unroll") for (int i = 0; i < NKC; ++i) *(bf16x8*)(lds + (B) * KBYTES + kl[i]) = KSR[i]; } while (0)
#define FP_WRITEV(VSR, B) do { _Pragma("unroll") for (int i = 0; i < NVC; ++i) *(bf16x8*)(lds + (B) * VBYTES + vl[i]) = VSR[i]; } while (0)
#define FP_PARTIAL(P0) do { _Pragma("unroll") for (int r = 0; r < 16; ++r) P0[r] = __builtin_amdgcn_exp2f(P0[r]); } while (0)
#define FP_FINISH(P0, P1) do { _Pragma("unroll") for (int r = 0; r < 16; ++r) P1[r] = __builtin_amdgcn_exp2f(P1[r]); \
    { const f32x16 s_ = P0 + P1; lsum += ((s_[0] + s_[1]) + (s_[2] + s_[3])) + ((s_[4] + s_[5]) + (s_[6] + s_[7])) + ((s_[8] + s_[9]) + (s_[10] + s_[11])) + ((s_[12] + s_[13]) + (s_[14] + s_[15])); } \
    PK4(P0, 0, pa0); PK4(P0, 8, pa1); PK4(P1, 0, pa2); PK4(P1, 8, pa3); } while (0)
#define FP_STEP(PX0, PX1, PY0, PY1, KX, VX, KY, VY, JJ) do { \
    SBAR(); \
    if (DEEP) { if ((JJ) + 3 < NTILE) FP_LOADK(KY, (JJ) + 3); if ((JJ) + 2 < NTILE) FP_LOADV(VY, (JJ) + 2); } \
    SBAR(); \
    if ((JJ) + 1 < NTILE) qkt<DQK, KS>(PY0, PY1, lds + (((JJ) + 1) & 1) * KBYTES, qr, r32, hi); \
    FP_FINISH(PX0, PX1); \
    SBAR(); \
    if (!DEEP) { if ((JJ) + 2 < NTILE) FP_LOADK(KX, (JJ) + 2); if ((JJ) + 1 < NTILE) FP_LOADV(VX, (JJ) + 1); } \
    SBAR(); \
    pv_all<DV>(o, vb0 + ((JJ) & 1) * VBYTES, pa0, pa1, pa2, pa3); \
    if ((JJ) + 1 < NTILE) FP_PARTIAL(PY0); \
    SBAR(); \
    if ((JJ) + 2 < NTILE) FP_WRITEK(KX, (JJ) & 1); \
    if ((JJ) + 1 < NTILE) FP_WRITEV(VX, ((JJ) + 1) & 1); \
    __syncthreads(); } while (0)
  f32x16 pA0, pA1, pB0, pB1; bf16x8 pa0, pa1, pa2, pa3;
  float lsum = 0.f;
  FP_LOADK(ksA, 0); FP_LOADV(vsA, 0); FP_LOADK(ksB, 1);
  FP_WRITEK(ksA, 0); FP_WRITEV(vsA, 0); FP_WRITEK(ksB, 1);
  if (DEEP) { FP_LOADK(ksA, 2); FP_LOADV(vsA, 1); }
  __syncthreads();
  qkt<DQK, KS>(pA0, pA1, lds, qr, r32, hi);
  FP_PARTIAL(pA0);
  __syncthreads();
  for (int j = 0; j < NTILE; j += 2) {
    FP_STEP(pA0, pA1, pB0, pB1, ksA, vsA, ksB, vsB, j);
    FP_STEP(pB0, pB1, pA0, pA1, ksB, vsB, ksA, vsA, j + 1);
  }
#undef FP_LOADK
#undef FP_LOADV
#undef FP_WRITEK
#undef FP_WRITEV
#undef FP_PARTIAL
#undef FP_FINISH
#undef FP_STEP
  l_out = half_sum(lsum);
}

template <int DQK>
DI void flash_p2(const u16* __restrict__ Qlane, const u16* __restrict__ Kb, const int ldk, const u16* __restrict__ Vb, const int ldv,
                 f32x16 (&o)[2], float& l_out, char* lds) {
  constexpr int KS = DQK == 64 ? 128 : 256, KCR = DQK / 8, NKC = KCR / 4, NVC = 2, NQ = DQK / 16;
  constexpr int KST = 128 * KS, VST = 16384, VOFF0 = 3 * KST, NPAIR = SEQ / 128;
  const int tid = my_tid(), lane = tid & 63, r32 = lane & 31, hi = lane >> 5;
  bf16x8 qr[NQ];
#pragma unroll
  for (int d0 = 0; d0 < NQ; ++d0) qr[d0] = *(const bf16x8*)(Qlane + d0 * 16);
  int kg[NKC], kl[NKC], vg[NVC], vl[NVC];
#pragma unroll
  for (int i = 0; i < NKC; ++i) { const int c = tid + i * NTHR, row = c / KCR, cc = c % KCR; kg[i] = row * ldk + cc * 8; kl[i] = kswz<KS>(row, cc); }
#pragma unroll
  for (int i = 0; i < NVC; ++i) { const int c = tid + i * NTHR, key = c >> 3, c8 = c & 7; vg[i] = key * ldv + c8 * 8; vl[i] = VOFF0 + (key >> 6) * 8192 + v_st<64>(key & 63, c8 * 8); }
  const int vb0 = (int)(uintptr_t)lds + VOFF0 + v_rd_base(lane);
#pragma unroll
  for (int d = 0; d < 2; ++d)
#pragma unroll
    for (int r = 0; r < 16; ++r) o[d][r] = 0.f;
  bf16x8 ks[NKC], vs[NVC];
#define P2_LOADK(M) do { const u16* kn = Kb + (size_t)(M) * 128 * ldk; _Pragma("unroll") for (int i = 0; i < NKC; ++i) ks[i] = *(const bf16x8*)(kn + kg[i]); } while (0)
#define P2_LOADV(M) do { const u16* vn = Vb + (size_t)(M) * 128 * ldv; _Pragma("unroll") for (int i = 0; i < NVC; ++i) vs[i] = *(const bf16x8*)(vn + vg[i]); } while (0)
#define P2_WRITEK(OFF) do { _Pragma("unroll") for (int i = 0; i < NKC; ++i) *(bf16x8*)(lds + (OFF) + kl[i]) = ks[i]; } while (0)
#define P2_WRITEV(S) do { _Pragma("unroll") for (int i = 0; i < NVC; ++i) *(bf16x8*)(lds + (S) * VST + vl[i]) = vs[i]; } while (0)
#define P2_PARTIAL(P0) do { _Pragma("unroll") for (int r = 0; r < 16; ++r) P0[r] = __builtin_amdgcn_exp2f(P0[r]); } while (0)
#define P2_FINISH(P0, P1) do { _Pragma("unroll") for (int r = 0; r < 16; ++r) P1[r] = __builtin_amdgcn_exp2f(P1[r]); \
    { const f32x16 s_ = P0 + P1; lsum += ((s_[0] + s_[1]) + (s_[2] + s_[3])) + ((s_[4] + s_[5]) + (s_[6] + s_[7])) + ((s_[8] + s_[9]) + (s_[10] + s_[11])) + ((s_[12] + s_[13]) + (s_[14] + s_[15])); } \
    PK4(P0, 0, pa0); PK4(P0, 8, pa1); PK4(P1, 0, pa2); PK4(P1, 8, pa3); } while (0)
  f32x16 pA0, pA1, pB0, pB1; bf16x8 pa0, pa1, pa2, pa3;
  float lsum = 0.f;
  {
    bf16x8 ks1[NKC];
    P2_LOADK(0); P2_LOADV(0);
    { const u16* kn = Kb + (size_t)128 * ldk;
#pragma unroll
      for (int i = 0; i < NKC; ++i) ks1[i] = *(const bf16x8*)(kn + kg[i]); }
    P2_WRITEK(0); P2_WRITEV(0);
#pragma unroll
    for (int i = 0; i < NKC; ++i) *(bf16x8*)(lds + KST + kl[i]) = ks1[i];
  }
  __syncthreads();
  qkt<DQK, KS>(pA0, pA1, lds, qr, r32, hi);
  P2_PARTIAL(pA0);
  __syncthreads();
  int k0 = 0, k1 = KST, k2 = 2 * KST;
  for (int m = 0; m < NPAIR; ++m) {
    const int s = m & 1;
    SBAR();
    if (m + 2 < NPAIR) P2_LOADK(m + 2);
    if (m + 1 < NPAIR) P2_LOADV(m + 1);
    SBAR();
    qkt<DQK, KS>(pB0, pB1, lds + k0 + 64 * KS, qr, r32, hi);
    P2_FINISH(pA0, pA1);
    SBAR();
    pv_all<64>(o, vb0 + s * VST, pa0, pa1, pa2, pa3);
    P2_PARTIAL(pB0);
    SBAR();
    if (m + 1 < NPAIR) qkt<DQK, KS>(pA0, pA1, lds + k1, qr, r32, hi);
    P2_FINISH(pB0, pB1);
    SBAR();
    pv_all<64>(o, vb0 + s * VST + 8192, pa0, pa1, pa2, pa3);
    if (m + 1 < NPAIR) P2_PARTIAL(pA0);
    SBAR();
    if (m + 2 < NPAIR) P2_WRITEK(k2);
    { const int t_ = k0; k0 = k1; k1 = k2; k2 = t_; }
    if (m + 1 < NPAIR) P2_WRITEV(s ^ 1);
    __syncthreads();
  }
#undef P2_LOADK
#undef P2_LOADV
#undef P2_WRITEK
#undef P2_WRITEV
#undef P2_PARTIAL
#undef P2_FINISH
  l_out = half_sum(lsum);
}

template <int ND0>
DI void store_gated(const f32x16 (&o)[ND0], const u16* gp, u16* op, int hi) {
#pragma unroll
  for (int d = 0; d < ND0; ++d) { f32x16 g; load_blk_bf16(gp + 32 * d, hi, g); f32x16 v = o[d] * g; store_blk_bf16(op + 32 * d, v, hi); }
}

template <int DV>
DI void store_gated_staged(const f32x16 (&o)[DV / 32], const u16* __restrict__ gate0, const int ldg, u16* __restrict__ out0, char* lds) {
  constexpr int STR = DV * 4 + 16, NCH = DV / 8;
  const int tid = my_tid(), wave = tid >> 6, lane = tid & 63, r32 = lane & 31, hi = lane >> 5;
  char* rowp = lds + (wave * 32 + r32) * STR;
#pragma unroll
  for (int d = 0; d < DV / 32; ++d)
#pragma unroll
    for (int q = 0; q < 4; ++q) { f32x4 v; v[0] = o[d][4 * q]; v[1] = o[d][4 * q + 1]; v[2] = o[d][4 * q + 2]; v[3] = o[d][4 * q + 3]; *(f32x4*)(rowp + (32 * d + 8 * q + 4 * hi) * 4) = v; }
  __syncthreads();
#pragma unroll
  for (int i = 0; i < (256 * NCH) / NTHR; ++i) {
    const int c = tid + i * NTHR, row = c / NCH, ch = c % NCH;
    const f32x4 a = *(const f32x4*)(lds + row * STR + ch * 32), b = *(const f32x4*)(lds + row * STR + ch * 32 + 16);
    const u32x4 g = *(const u32x4*)(gate0 + (size_t)row * ldg + ch * 8);
    u32x4 w;
    w.x = cvtpk(a[0] * bflo(g.x), a[1] * bfhi(g.x)); w.y = cvtpk(a[2] * bflo(g.y), a[3] * bfhi(g.y));
    w.z = cvtpk(b[0] * bflo(g.z), b[1] * bfhi(g.z)); w.w = cvtpk(b[2] * bflo(g.w), b[3] * bfhi(g.w));
    *(u32x4*)(out0 + (size_t)row * LDX + ch * 8) = w;
  }
  __syncthreads();
}

DI void na_item(const Params& p, int b, int h, int rp, char* lds) {
  constexpr int KBYTES = 8192, ABUF = 16384;
  const int tid = my_tid(), wave = tid >> 6, lane = tid & 63, r32 = lane & 31, hi = lane >> 5;
  float* tbl = (float*)(lds + 2 * ABUF);
  for (int i = tid; i < 465; i += NTHR) tbl[i] = p.rpb_a[h * 465 + i] * LOG2E;
  const int gr = 4 * rp + (wave >> 1), cq = (wave & 1) * 32 + r32;
  const int r0w = min(max(gr - 4, 0), 56), ra = min(max(4 * rp - 4, 0), 56), rb = min(max(4 * rp - 1, 0), 56) + 8;
  const int c0 = min(max(cq - 8, 0), 48);
  const size_t tb = (size_t)b * SEQ;
  const u16* Qlane = p.proj + (tb + gr * 64 + cq) * NE + h * 64 + hi * 8;
  const u16* Kb = p.proj + tb * NE + 512 + h * 64; const u16* Vb = p.proj + tb * NE + 1024 + h * 64;
  bf16x8 qr[4];
#pragma unroll
  for (int d0 = 0; d0 < 4; ++d0) qr[d0] = *(const bf16x8*)(Qlane + d0 * 16);
  int kg[1], kl[1], vl[1];
#pragma unroll
  for (int i = 0; i < 1; ++i) { const int c = tid, row = c >> 3, cc = c & 7; kg[i] = row * NE + cc * 8; kl[i] = kswz<128>(row, cc); vl[i] = KBYTES + v_st<64>(row, cc * 8); }
  const int vb0 = (int)(uintptr_t)lds + KBYTES + v_rd_base(lane);
  float m = -1e30f, l = 0.f; f32x16 o[2];
#pragma unroll
  for (int d = 0; d < 2; ++d)
#pragma unroll
    for (int r = 0; r < 16; ++r) o[d][r] = 0.f;
  bf16x8 ks[1], vs[1];
  {
    const u16* kn = Kb + (size_t)ra * 64 * NE; const u16* vn = Vb + (size_t)ra * 64 * NE;
#pragma unroll
    for (int i = 0; i < 1; ++i) { ks[i] = *(const bf16x8*)(kn + kg[i]); vs[i] = *(const bf16x8*)(vn + kg[i]); }
#pragma unroll
    for (int i = 0; i < 1; ++i) { *(bf16x8*)(lds + kl[i]) = ks[i]; *(bf16x8*)(lds + vl[i]) = vs[i]; }
  }
  __syncthreads();
  const float C = 0.125f * LOG2E;
  const int nt = rb - ra;
  for (int j = 0; j < nt; ++j) {
    const int cur = j & 1, kr = ra + j;
    if (j + 1 < nt) {
      const u16* kn = Kb + (size_t)(kr + 1) * 64 * NE; const u16* vn = Vb + (size_t)(kr + 1) * 64 * NE;
#pragma unroll
      for (int i = 0; i < 1; ++i) { ks[i] = *(const bf16x8*)(kn + kg[i]); vs[i] = *(const bf16x8*)(vn + kg[i]); }
    }
    if (kr >= r0w && kr < r0w + 8) {
      f32x16 p0, p1; bf16x8 pa0, pa1, pa2, pa3;
      qkt<64, 128>(p0, p1, lds + cur * ABUF, qr, r32, hi);
      const int rowoff = (kr - gr + 7) * 31 + 15 - cq;
#pragma unroll
      for (int r = 0; r < 16; ++r) {
        const int kc = crow(r, hi);
        const float b0 = tbl[rowoff + kc], b1 = tbl[rowoff + kc + 32];
        p0[r] = ((unsigned)(kc - c0) < 16u) ? fmaf(p0[r], C, b0) : -1e30f;
        p1[r] = ((unsigned)(kc + 32 - c0) < 16u) ? fmaf(p1[r], C, b1) : -1e30f;
      }
      softmax_step<2>(p0, p1, m, l, o, pa0, pa1, pa2, pa3);
      pv_all<64>(o, vb0 + cur * ABUF, pa0, pa1, pa2, pa3);
    }
    if (j + 1 < nt) {
      char* nb = lds + (cur ^ 1) * ABUF;
#pragma unroll
      for (int i = 0; i < 1; ++i) { *(bf16x8*)(nb + kl[i]) = ks[i]; *(bf16x8*)(nb + vl[i]) = vs[i]; }
    }
    __syncthreads();
  }
  const float inv = 1.f / l;
  o[0] = o[0] * inv; o[1] = o[1] * inv;
  const size_t T = tb + gr * 64 + cq;
  { const size_t T0 = tb + (size_t)rp * 256; store_gated_staged<64>(o, p.proj + T0 * NE + 2304 + h * 64, NE, p.ob + T0 * LDX + h * 64, lds); }
}

DI void attn_phase_even(const Params& p, char* lds) {
  const int wave = my_tid() >> 6, lane = my_tid() & 63, r32 = lane & 31, hi = lane >> 5;
  for (int t = blockIdx.x; t < 1024; t += gridDim.x) { const int b = t & 7, idx = t >> 3; na_item(p, b, idx >> 4, idx & 15, lds); }
  for (int t = blockIdx.x; t < 1024; t += gridDim.x) {
    const int b = t & 7, idx = t >> 3, h = idx >> 4, qb = idx & 15, kvh = h >> 2;
    const size_t tb = (size_t)b * SEQ, T = tb + qb * 256 + wave * 32 + r32;
    f32x16 o[2]; float l;
    flash_p2<64>(p.proj + T * NE + 1536 + h * 64 + hi * 8, p.proj + tb * NE + 2048 + kvh * 64, NE, p.proj + tb * NE + 2176 + kvh * 64, NE, o, l, lds);
    const float inv = 1.f / l; o[0] = o[0] * inv; o[1] = o[1] * inv;
    { const size_t T0 = tb + (size_t)qb * 256; store_gated_staged<64>(o, p.proj + T0 * NE + 2304 + 512 + h * 64, NE, p.ob + T0 * LDX + 512 + h * 64, lds); }
  }
}
DI void attn_phase_odd(const Params& p, char* lds) {
  const int wave = my_tid() >> 6, lane = my_tid() & 63, r32 = lane & 31, hi = lane >> 5;
  for (int t = blockIdx.x; t < 1024; t += gridDim.x) {
    const int b = t & 7, idx = t >> 3, h = idx >> 4, qb = idx & 15;
    const size_t tb = (size_t)b * SEQ, T = tb + qb * 256 + wave * 32 + r32;
    f32x16 o[2]; float l;
    flash_p2<96>(p.qc + T * 768 + h * 96 + hi * 8, p.kc + tb * 768 + h * 96, 768, p.vc + tb * 512 + h * 64, 512, o, l, lds);
    const float inv = 1.f / l; o[0] = o[0] * inv; o[1] = o[1] * inv;
    { const size_t T0 = tb + (size_t)qb * 256; store_gated_staged<64>(o, p.proj + T0 * NO + 1920 + h * 64, NO, p.ob + T0 * LDX + h * 64, lds); }
  }
  const float lam = p.lam[0], nMd = -p.lam[3] * LOG2E;
  for (int t = blockIdx.x; t < 512; t += gridDim.x) {
    const int b = t & 7, idx = t >> 3, h = idx >> 4, qb = idx & 15;
    const size_t tb = (size_t)b * SEQ, T = tb + qb * 256 + wave * 32 + r32;
    f32x16 o1[4]; float l1, l2;
    const u16* vb = p.proj + tb * NO + 1408 + h * 128;
    float* stash = (float*)p.xb + (size_t)blockIdx.x * 32768 + my_tid() * 64;
    flash<64, 128>(p.proj + T * NO + 384 + h * 128 + hi * 8, p.proj + tb * NO + 896 + h * 128, NO, vb, NO, 0.125f * LOG2E, nMd, o1, l1, lds);
    { const float inv = 1.f / l1;
#pragma unroll
      for (int d = 0; d < 4; ++d)
#pragma unroll
        for (int q = 0; q < 4; ++q) { f32x4 v; v[0] = o1[d][4 * q] * inv; v[1] = o1[d][4 * q + 1] * inv; v[2] = o1[d][4 * q + 2] * inv; v[3] = o1[d][4 * q + 3] * inv; *(f32x4*)(stash + (d * 4 + q) * 4) = v; } }
    flash<64, 128>(p.proj + T * NO + 384 + h * 128 + 64 + hi * 8, p.proj + tb * NO + 896 + h * 128 + 64, NO, vb, NO, 0.125f * LOG2E, nMd, o1, l2, lds);
    const float f = lam / l2; float ss = 0.f;
#pragma unroll
    for (int d = 0; d < 4; ++d) {
#pragma unroll
      for (int q = 0; q < 4; ++q) { const f32x4 v = *(const f32x4*)(stash + (d * 4 + q) * 4);
#pragma unroll
        for (int j = 0; j < 4; ++j) o1[d][4 * q + j] = v[j] - o1[d][4 * q + j] * f; }
      ss += sumsq16(o1[d]);
    }
    ss = half_sum(ss);
    const float ri = rsqrtf(ss * (1.f / 128) + EPS) * (1.f - LAM_INIT);
#pragma unroll
    for (int d = 0; d < 4; ++d) { f32x16 g; load_blk_f32(p.g_sub_d + 32 * d, hi, g); o1[d] = o1[d] * ri * g; }
    { const size_t T0 = tb + (size_t)qb * 256; store_gated_staged<128>(o1, p.proj + T0 * NO + 1920 + 512 + h * 128, NO, p.ob + T0 * LDX + 512 + h * 128, lds); }
  }
}

DI void grid_bar(unsigned* cnt, unsigned target) {
  asm volatile("s_waitcnt vmcnt(0)" ::: "memory");
  __syncthreads();
  if (threadIdx.x == 0) {
    __builtin_amdgcn_fence(__ATOMIC_RELEASE, "agent");
    asm volatile("s_waitcnt vmcnt(0)" ::: "memory");
    __hip_atomic_fetch_add(cnt, 1u, __ATOMIC_RELAXED, __HIP_MEMORY_SCOPE_AGENT);
    unsigned spins = 0;
    while (__hip_atomic_load(cnt, __ATOMIC_RELAXED, __HIP_MEMORY_SCOPE_AGENT) < target) { __builtin_amdgcn_s_sleep(2); if (++spins > (1u << 24)) break; }
    __builtin_amdgcn_fence(__ATOMIC_ACQUIRE, "agent");
    asm volatile("s_waitcnt vmcnt(0)" ::: "memory");
  }
  __syncthreads();
}

constexpr int LDS_BYTES = 147456;
__global__ void __launch_bounds__(512, 2) mega(Params p) {
  extern __shared__ __attribute__((aligned(16))) char lds[];
  cg::grid_group grid = cg::this_grid();
  const int lo = p.phase_lo, hi_ = p.phase_hi;
#ifndef PROBE_REPEAT
#define PROBE_REPEAT -1
#endif
#define PHASE(k, body) if (lo <= k && k <= hi_) { if (k > lo) { if (k == 1) grid.sync(); else grid_bar(p.bar, (unsigned)(k - 1) * gridDim.x); } body; if (k == PROBE_REPEAT) { grid.sync(); body; } }
  PHASE(0, phase0(p))
  PHASE(1, gemm_phase8<0>(p, lds))
  PHASE(2, attn_phase_even(p, lds))
  PHASE(3, gemm_phase8<1>(p, lds))
  PHASE(4, gemm_phase8<2>(p, lds))
  PHASE(5, upproj_phase(p, lds))
  PHASE(6, attn_phase_odd(p, lds))
  PHASE(7, gemm_phase8<3>(p, lds))
#undef PHASE
}

#ifndef NLAUNCH
#define NLAUNCH 1
#endif
extern "C" void kernel_launch(void* const* d_in, const int* in_sizes, int n_in, void* d_out, int out_size, void* d_ws, size_t ws_size, hipStream_t stream) {
  static int grid_blocks = 0;
  if (!grid_blocks) {
    int dev = 0, cus = 0, per_cu = 0;
    (void)hipGetDevice(&dev);
    (void)hipDeviceGetAttribute(&cus, hipDeviceAttributeMultiprocessorCount, dev);
    (void)hipFuncSetAttribute((const void*)mega, hipFuncAttributeMaxDynamicSharedMemorySize, LDS_BYTES);
    (void)hipOccupancyMaxActiveBlocksPerMultiprocessor(&per_cu, mega, NTHR, LDS_BYTES);
    if (per_cu > 1) per_cu = 1;
    if (per_cu < 1) per_cu = 1;
    grid_blocks = cus * per_cu;
  }
  Params p;
  memset(&p, 0, sizeof(p));
  const float** fp = (const float**)&p;
  for (int i = 0; i < 25; ++i) fp[i] = (const float*)d_in[i];
  p.out = (float*)d_out;
  char* w = (char*)d_ws; size_t off = 0;
  auto take = [&](size_t bytes) { char* r = w + off; off += (bytes + 255) & ~(size_t)255; return r; };
  p.xb = (u16*)take((size_t)NTOK * LDX * 2);
  p.proj = (u16*)take((size_t)NTOK * NE * 2);
  p.ob = (u16*)take((size_t)NTOK * LDX * 2);
  p.qc = (u16*)take((size_t)NTOK * 768 * 2);
  p.kc = (u16*)take((size_t)NTOK * 768 * 2);
  p.vc = (u16*)take((size_t)NTOK * 512 * 2);
  p.wt_ine = (u16*)take((size_t)NE * LDX * 2);
  p.wt_oute = (u16*)take((size_t)1024 * LDX * 2);
  p.wt_ino = (u16*)take((size_t)NO * LDX * 2);
  p.wt_cq = (u16*)take((size_t)768 * 256 * 2);
  p.wt_ckv = (u16*)take((size_t)1024 * 128 * 2);
  p.wt_outo = (u16*)take((size_t)1024 * LDX * 2);
  p.rs0 = (float*)take(NTOK * 4); p.ss1 = (float*)take(NTOK * 4); p.sscq = (float*)take(NTOK * 4); p.ssckv = (float*)take(NTOK * 4);
  p.lam = (float*)take(256);
  p.bar = (unsigned*)take(256);
  p.tab_ax = (float2*)take(64 * 16 * 8); p.tab_mla = (float2*)take(4096 * 16 * 8); p.tab_part = (float2*)take(4096 * 8 * 8);
  if (off > ws_size) { fprintf(stderr, "workspace too small: need %zu have %zu\n", off, ws_size); return; }
  for (int i = 0; i < 16; ++i) p.inv16[i] = (float)pow(10000.0, -(double)i / 16.0);
  for (int i = 0; i < 8; ++i) p.inv8[i] = (float)pow(500000.0, -(double)i / 8.0);
#if NLAUNCH == 1
  p.phase_lo = 0; p.phase_hi = 7;
  void* args[] = {&p};
  hipError_t e = hipLaunchCooperativeKernel((void*)mega, dim3(grid_blocks), dim3(NTHR), args, LDS_BYTES, stream);
  if (e != hipSuccess) fprintf(stderr, "cooperative launch failed: %s (grid %d)\n", hipGetErrorString(e), grid_blocks);
#else
  for (int ph = 0; ph < 8; ++ph) { p.phase_lo = ph; p.phase_hi = ph; hipLaunchKernelGGL(mega, dim3(grid_blocks), dim3(NTHR), LDS_BYTES, stream, p); }
#endif
}
```
